# Optimizing an MI355X kernel written in HIP

```python
import math
import jax, jax.numpy as jnp
from jax import lax
import numpy as np

D_MODEL = 1024
BATCH = 16
SEQ = 2048
DEPTH = 2

CTX_LEN = 256
GRID_W = 64
W_FOURIER = D_MODEL // 2
N_FOURIER_GROUPS = 4
W_SSM = D_MODEL // 2
SSM_GROUP = 16
N_SSM_GROUPS = W_SSM // SSM_GROUP
SSM_STATE = 64
DT_MIN = 1e-3
DT_MAX = 1e-1
D_FF = ((8 * D_MODEL // 3 + 255) // 256) * 256
N_EXPERTS = 8
TOP_K = 2
D_FF_EXPERT = 7 * D_MODEL // 2
N_DENSE = (DEPTH + 1) // 2
N_MOE = DEPTH // 2
OFF_SSM = W_FOURIER
OFF_GA = W_FOURIER + W_SSM
OFF_GB = OFF_GA + D_MODEL
IN_COLS = OFF_GB + D_MODEL
EPS = 1e-6
POS_BASE = 10000.0

kernel_name = 'fourier_s5_gated_moe_diffusion_block'


def rmsnorm(x, g):
    xf = x.astype(jnp.float32)
    y = xf * lax.rsqrt(jnp.mean(xf * xf, axis=-1, keepdims=True) + EPS)
    return (y * g.astype(jnp.float32)).astype(x.dtype)


def sincos_2d(rows, dim, dtype):
    t = jnp.arange(rows * GRID_W)
    r = (t // GRID_W).astype(jnp.float32)
    col = (t % GRID_W).astype(jnp.float32)
    quarter = dim // 4
    omega = 1.0 / (POS_BASE ** (jnp.arange(quarter, dtype=jnp.float32) / quarter))
    ar = r[:, None] * omega
    ac = col[:, None] * omega
    return jnp.concatenate([jnp.sin(ar), jnp.cos(ar), jnp.sin(ac), jnp.cos(ac)], axis=-1).astype(dtype)


def adaln(cond, w_mod, b_mod):
    return jnp.split(jax.nn.silu(cond) @ w_mod + b_mod, 6, axis=-1)


def fourier_mix(u):
    b, n, _ = u.shape
    ug = u.reshape(b, n, N_FOURIER_GROUPS, W_FOURIER // N_FOURIER_GROUPS).astype(jnp.float32)
    y = jnp.fft.fft2(ug, axes=(1, 3), norm='ortho').real
    return y.reshape(b, n, W_FOURIER).astype(u.dtype)


def zoh_discretise(a_re, a_im, log_dt, b_re, b_im):
    lam = lax.complex(a_re.astype(jnp.float32), a_im.astype(jnp.float32))
    dt = jnp.exp(log_dt.astype(jnp.float32))[:, None]
    lam_dt = lam * dt
    lam_bar = jnp.exp(lam_dt)
    b_mat = lax.complex(b_re.astype(jnp.float32), b_im.astype(jnp.float32))
    b_bar = ((lam_bar - 1.0) / lam)[..., None] * b_mat
    return lam_dt, lam_bar, b_bar


def _scan_op(e1, e2):
    a1, b1 = e1
    a2, b2 = e2
    return a1 * a2, a2 * b1 + b2


def diag_scan(bu, lam_bar, lam_dt, h0):
    n = bu.shape[1]
    a = jnp.broadcast_to(lam_bar, bu.shape)
    _, h = lax.associative_scan(_scan_op, (a, bu), axis=1)
    if h0 is not None:
        steps = jnp.arange(1, n + 1, dtype=jnp.float32)[:, None, None]
        h = h + jnp.exp(lam_dt[None] * steps)[None] * h0[:, None]
    return h


def s5_branch(u_ctx, u_lat, a_re, a_im, log_dt, b_re, b_im, c_re, c_im, d_skip, need_ctx):
    dtype = u_lat.dtype

    def groups(u):
        return u.reshape(u.shape[0], u.shape[1], N_SSM_GROUPS, SSM_GROUP).astype(jnp.float32)

    uc = groups(u_ctx)
    ul = groups(u_lat)
    d = d_skip.astype(jnp.float32).reshape(N_SSM_GROUPS, SSM_GROUP)
    y_lat = d * ul
    y_ctx = d * uc
    for direction in range(2):
        rev = direction == 1
        flip = (lambda t: jnp.flip(t, axis=1)) if rev else (lambda t: t)
        lam_dt, lam_bar, b_bar = zoh_discretise(a_re[direction], a_im[direction], log_dt[direction],
                                                b_re[direction], b_im[direction])
        c_mat = lax.complex(c_re[direction].astype(jnp.float32), c_im[direction].astype(jnp.float32))
        bu_c = jnp.einsum('blgh,gph->blgp', flip(uc).astype(jnp.complex64), b_bar)
        h_c = diag_scan(bu_c, lam_bar, lam_dt, None)
        bu_l = jnp.einsum('blgh,gph->blgp', flip(ul).astype(jnp.complex64), b_bar)
        h_l = diag_scan(bu_l, lam_bar, lam_dt, h_c[:, -1])
        y_lat = y_lat + flip(jnp.einsum('blgp,ghp->blgh', h_l, c_mat).real)
        if need_ctx:
            y_ctx = y_ctx + flip(jnp.einsum('blgp,ghp->blgh', h_c, c_mat).real)

    def finish(y):
        return jax.nn.gelu(y).reshape(y.shape[0], y.shape[1], W_SSM).astype(dtype)

    return (finish(y_ctx) if need_ctx else None), finish(y_lat)


def merge_branches(p, y_s, w_four, w_glu_a, w_glu_b, w_out):
    g_a = jax.nn.sigmoid(p[..., OFF_GA:OFF_GB])
    g_b = jax.nn.sigmoid(p[..., OFF_GB:])
    y_a = fourier_mix(p[..., :OFF_SSM]) @ w_four
    y_b = (y_s @ w_glu_a) * jax.nn.sigmoid(y_s @ w_glu_b)
    return (g_a * y_a + g_b * y_b) @ w_out


def token_mixer(a_ctx, a_lat, w_in, w_four, a_re, a_im, log_dt, b_re, b_im, c_re, c_im,
                d_skip, w_glu_a, w_glu_b, w_out, need_ctx):
    p_lat = a_lat @ w_in
    if need_ctx:
        p_ctx = a_ctx @ w_in
        s_ctx = p_ctx[..., OFF_SSM:OFF_GA]
    else:
        p_ctx = None
        s_ctx = a_ctx @ w_in[:, OFF_SSM:OFF_GA]
    y_ctx, y_lat = s5_branch(s_ctx, p_lat[..., OFF_SSM:OFF_GA], a_re, a_im, log_dt,
                             b_re, b_im, c_re, c_im, d_skip, need_ctx)
    out_lat = merge_branches(p_lat, y_lat, w_four, w_glu_a, w_glu_b, w_out)
    out_ctx = merge_branches(p_ctx, y_ctx, w_four, w_glu_a, w_glu_b, w_out) if need_ctx else None
    return out_ctx, out_lat


def swiglu(t, w_gate, w_up, w_down):
    return (jax.nn.silu(t @ w_gate) * (t @ w_up)) @ w_down


def moe_swiglu(t, w_router, b_router, w_gate, w_up, w_down):
    b, n, d = t.shape
    tok = t.reshape(b * n, d)
    logits = (tok @ w_router).astype(jnp.float32) + b_router.astype(jnp.float32)
    top_v, top_i = lax.top_k(logits, TOP_K)
    top_w = jax.nn.softmax(top_v, axis=-1)
    combine = jnp.sum(jax.nn.one_hot(top_i, N_EXPERTS, dtype=jnp.float32) * top_w[..., None], axis=1)
    combine = combine.astype(tok.dtype)
    out = jnp.zeros_like(tok)
    for e in range(N_EXPERTS):
        out = out + combine[:, e:e + 1] * swiglu(tok, w_gate[e], w_up[e], w_down[e])
    return out.reshape(b, n, d)


def channel_mixer(l, t, ffn_w_gate, ffn_w_up, ffn_w_down,
                  moe_w_router, moe_b_router, moe_w_gate, moe_w_up, moe_w_down):
    i = l // 2
    if l % 2 == 0:
        return swiglu(t, ffn_w_gate[i], ffn_w_up[i], ffn_w_down[i])
    return moe_swiglu(t, moe_w_router[i], moe_b_router[i], moe_w_gate[i], moe_w_up[i], moe_w_down[i])


def setup_inputs(seed: int = 0) -> dict:
    key = jax.random.key(seed)
    ks = jax.random.split(key, 32)
    f32 = jnp.float32

    def nrm(k, shape, scale):
        return scale * jax.random.normal(k, shape, f32)

    G, P, H = N_SSM_GROUPS, SSM_STATE, SSM_GROUP
    a_im_init = math.pi * jnp.arange(P, dtype=f32)
    return {
        'x': nrm(ks[0], (BATCH, SEQ, D_MODEL), 1.0),
        'c': nrm(ks[1], (BATCH, D_MODEL), 1.0),
        'ctx': nrm(ks[2], (BATCH, CTX_LEN, D_MODEL), 1.0),
        'c_ctx': nrm(ks[3], (D_MODEL,), 1.0),
        'w_mod': nrm(ks[4], (DEPTH, D_MODEL, 6 * D_MODEL), 0.5 * D_MODEL ** -0.5),
        'b_mod': nrm(ks[5], (DEPTH, 6 * D_MODEL), 0.02),
        'norm1_g': 1.0 + nrm(ks[6], (DEPTH, D_MODEL), 0.02),
        'norm2_g': 1.0 + nrm(ks[7], (DEPTH, D_MODEL), 0.02),
        'w_in': nrm(ks[8], (DEPTH, D_MODEL, IN_COLS), D_MODEL ** -0.5),
        'w_four': nrm(ks[9], (DEPTH, W_FOURIER, D_MODEL), W_FOURIER ** -0.5),
        'ssm_a_re': -0.5 + nrm(ks[10], (DEPTH, 2, G, P), 0.01),
        'ssm_a_im': a_im_init + nrm(ks[11], (DEPTH, 2, G, P), 0.01),
        'ssm_log_dt': jax.random.uniform(ks[12], (DEPTH, 2, G), f32, math.log(DT_MIN), math.log(DT_MAX)),
        'ssm_b_re': nrm(ks[13], (DEPTH, 2, G, P, H), (2 * H) ** -0.5),
        'ssm_b_im': nrm(ks[14], (DEPTH, 2, G, P, H), (2 * H) ** -0.5),
        'ssm_c_re': nrm(ks[15], (DEPTH, 2, G, H, P), (2 * P) ** -0.5),
        'ssm_c_im': nrm(ks[16], (DEPTH, 2, G, H, P), (2 * P) ** -0.5),
        'ssm_d': nrm(ks[17], (DEPTH, W_SSM), 1.0),
        'w_glu_a': nrm(ks[18], (DEPTH, W_SSM, D_MODEL), W_SSM ** -0.5),
        'w_glu_b': nrm(ks[19], (DEPTH, W_SSM, D_MODEL), W_SSM ** -0.5),
        'w_out': nrm(ks[20], (DEPTH, D_MODEL, D_MODEL), D_MODEL ** -0.5),
        'ffn_w_gate': nrm(ks[21], (N_DENSE, D_MODEL, D_FF), D_MODEL ** -0.5),
        'ffn_w_up': nrm(ks[22], (N_DENSE, D_MODEL, D_FF), D_MODEL ** -0.5),
        'ffn_w_down': nrm(ks[23], (N_DENSE, D_FF, D_MODEL), D_FF ** -0.5),
        'moe_w_router': nrm(ks[24], (N_MOE, D_MODEL, N_EXPERTS), D_MODEL ** -0.5),
        'moe_b_router': nrm(ks[25], (N_MOE, N_EXPERTS), 0.01),
        'moe_w_gate': nrm(ks[26], (N_MOE, N_EXPERTS, D_MODEL, D_FF_EXPERT), D_MODEL ** -0.5),
        'moe_w_up': nrm(ks[27], (N_MOE, N_EXPERTS, D_MODEL, D_FF_EXPERT), D_MODEL ** -0.5),
        'moe_w_down': nrm(ks[28], (N_MOE, N_EXPERTS, D_FF_EXPERT, D_MODEL), D_FF_EXPERT ** -0.5),
        'final_g': 1.0 + nrm(ks[29], (D_MODEL,), 0.02),
    }


def reference(x, c, ctx, c_ctx, w_mod, b_mod, norm1_g, norm2_g, w_in, w_four,
              ssm_a_re, ssm_a_im, ssm_log_dt, ssm_b_re, ssm_b_im, ssm_c_re, ssm_c_im, ssm_d,
              w_glu_a, w_glu_b, w_out, ffn_w_gate, ffn_w_up, ffn_w_down,
              moe_w_router, moe_b_router, moe_w_gate, moe_w_up, moe_w_down, final_g):
    rows = x.shape[1] // GRID_W
    h = x + sincos_2d(rows, D_MODEL, x.dtype)[None]
    z = ctx
    for l in range(DEPTH):
        need_ctx = l < DEPTH - 1
        sh1, sc1, g1, sh2, sc2, g2 = [m[:, None, :] for m in adaln(c, w_mod[l], b_mod[l])]
        csh1, csc1, cg1, csh2, csc2, cg2 = adaln(c_ctx, w_mod[l], b_mod[l])
        a_lat = rmsnorm(h, norm1_g[l]) * (1.0 + sc1) + sh1
        a_ctx = rmsnorm(z, norm1_g[l]) * (1.0 + csc1) + csh1
        o_ctx, o_lat = token_mixer(a_ctx, a_lat, w_in[l], w_four[l],
                                   ssm_a_re[l], ssm_a_im[l], ssm_log_dt[l],
                                   ssm_b_re[l], ssm_b_im[l], ssm_c_re[l], ssm_c_im[l], ssm_d[l],
                                   w_glu_a[l], w_glu_b[l], w_out[l], need_ctx)
        h = h + g1 * o_lat
        f_lat = rmsnorm(h, norm2_g[l]) * (1.0 + sc2) + sh2
        h = h + g2 * channel_mixer(l, f_lat, ffn_w_gate, ffn_w_up, ffn_w_down,
                                   moe_w_router, moe_b_router, moe_w_gate, moe_w_up, moe_w_down)
        if need_ctx:
            z = z + cg1 * o_ctx
            f_ctx = rmsnorm(z, norm2_g[l]) * (1.0 + csc2) + csh2
            z = z + cg2 * channel_mixer(l, f_ctx, ffn_w_gate, ffn_w_up, ffn_w_down,
                                        moe_w_router, moe_b_router, moe_w_gate, moe_w_up, moe_w_down)
    return rmsnorm(h, final_g)
```

```cpp
#include <hip/hip_runtime.h>
#include <stdint.h>
#include <math.h>

namespace {
typedef unsigned short bf16_t;
constexpr int D = 1024, NB = 16, L = 2048, LC = 256, TL = NB * L, TC = NB * LC, TT = TL + TC;
constexpr int INC = 3072, DFF = 2816, NE = 8, DFE = 3584, MOEROWS = 2 * TL + NE * 256, MOETILES = MOEROWS / 256;
constexpr float EPS = 1e-6f;

__device__ __forceinline__ float bf2f(bf16_t b) { return __uint_as_float(((unsigned)b) << 16); }
__device__ __forceinline__ bf16_t f2bf(float f) { unsigned u = __float_as_uint(f); u += 0x7FFFu + ((u >> 16) & 1u); return (bf16_t)(u >> 16); }
__device__ __forceinline__ float sigmoidf_(float v) { return 1.f / (1.f + expf(-v)); }
__device__ __forceinline__ float siluf_(float v) { return v / (1.f + expf(-v)); }
__device__ __forceinline__ float geluf_(float v) { return 0.5f * v * (1.f + tanhf(0.7978845608028654f * (v + 0.044715f * v * v * v))); }
__device__ __forceinline__ float wave_sum(float v) {
#pragma unroll
    for (int o = 32; o >= 1; o >>= 1) v += __shfl_xor(v, o);
    return v;
}

template <class LA, class LB, class EP>
__global__ __launch_bounds__(256) void ngemm(int K, int kpad, LA la, LB lb, EP ep) {
    __shared__ float As[16][68], Bs[16][68];
    const int tx = threadIdx.x & 15, ty = threadIdx.x >> 4;
    const int m0 = blockIdx.y * 64, n0 = blockIdx.x * 64, z = blockIdx.z;
    if (!la.active(z, m0)) return;
    float acc[4][4];
#pragma unroll
    for (int i = 0; i < 4; ++i)
#pragma unroll
        for (int j = 0; j < 4; ++j) acc[i][j] = 0.f;
    for (int k0 = 0; k0 < K; k0 += 16) {
#pragma unroll
        for (int i = 0; i < 4; ++i) { const int e = threadIdx.x + i * 256; const int mm = e >> 4, kk = e & 15; As[kk][mm] = la(z, m0 + mm, k0 + kk); }
#pragma unroll
        for (int i = 0; i < 4; ++i) { const int e = threadIdx.x + i * 256; const int kk = e >> 6, nn = e & 63; Bs[kk][nn] = lb(z, m0, k0 + kk, n0 + nn); }
        __syncthreads();
#pragma unroll
        for (int kk = 0; kk < 16; ++kk) {
            float a[4], b[4];
#pragma unroll
            for (int i = 0; i < 4; ++i) { a[i] = As[kk][ty * 4 + i]; b[i] = Bs[kk][tx * 4 + i]; }
#pragma unroll
            for (int i = 0; i < 4; ++i)
#pragma unroll
                for (int j = 0; j < 4; ++j) acc[i][j] += a[i] * b[j];
        }
        __syncthreads();
    }
#pragma unroll
    for (int i = 0; i < 4; ++i)
#pragma unroll
        for (int j = 0; j < 4; ++j) ep(z, m0 + ty * 4 + i, n0 + tx * 4 + j, acc[i][j]);
}

struct LAbf { const bf16_t* p; int ld; int pad; __device__ bool active(int, int) const { return true; } __device__ float operator()(int, int m, int k) const { return bf2f(p[(size_t)m * ld + k]); } };
struct LAbfZ { const bf16_t* p; int ld; int zoff; __device__ bool active(int, int) const { return true; } __device__ float operator()(int z, int m, int k) const { return bf2f(p[(size_t)m * ld + z * zoff + k]); } };
struct LBw { const float* p; int ld; int pad; __device__ float operator()(int, int, int k, int n) const { return p[(size_t)k * ld + n]; } };
struct LBdft128 { const float* cosT; const float* sinT; __device__ float operator()(int, int, int k, int n) const { const int nn = n & 127; const int idx = ((k * nn) & 127) * 16; return n < 128 ? cosT[idx] : sinT[idx]; } };
template <int LL> struct LAdftL { const float* cosT; const float* sinT; __device__ bool active(int, int) const { return true; }
    __device__ float operator()(int, int m, int k) const { const int kk = k & (LL - 1); const int idx = ((m * kk) & (LL - 1)) * (2048 / LL); return k < LL ? cosT[idx] : -sinT[idx]; } };
template <int LL> struct LBdftL { const bf16_t* Zc; const bf16_t* Zs; int rowbase; int pad; __device__ float operator()(int z, int, int k, int n) const { const int kk = k & (LL - 1); const size_t row = (size_t)rowbase + z * LL + kk; return bf2f((k < LL ? Zc : Zs)[row * 512 + n]); } };
struct LAgather { const bf16_t* A; const int* rowtok; const int* tile_e; __device__ bool active(int, int m0) const { return tile_e[m0 >> 8] >= 0; }
    __device__ float operator()(int, int m, int k) const { const int t = rowtok[m]; return t < 0 ? 0.f : bf2f(A[(size_t)t * D + k]); } };
struct LAmoeh { const bf16_t* H; const int* tile_e; __device__ bool active(int, int m0) const { return tile_e[m0 >> 8] >= 0; }
    __device__ float operator()(int, int m, int k) const { return bf2f(H[(size_t)m * 896 + k]); } };
struct LBmoe { const float* w; const int* tile_e; size_t estride; int ld; int coff; int roff; int pad; __device__ float operator()(int, int m0, int k, int n) const { const int e = tile_e[m0 >> 8]; return w[(size_t)e * estride + (size_t)(k + roff) * ld + coff + n]; } };

struct EPbf { bf16_t* o; int ld; int pad; __device__ void operator()(int, int m, int n, float v) const { o[(size_t)m * ld + n] = f2bf(v); } };
struct EPzdft { bf16_t* Zc; bf16_t* Zs; __device__ void operator()(int z, int m, int n, float v) const { (n < 128 ? Zc : Zs)[(size_t)m * 512 + z * 128 + (n & 127)] = f2bf(v); } };
template <int LL> struct EPfour { bf16_t* F; int rowbase; float scale; __device__ void operator()(int z, int m, int n, float v) const { F[((size_t)rowbase + z * LL + m) * 512 + n] = f2bf(v * scale); } };
struct EPmerge { const bf16_t* P; const bf16_t* T1; const bf16_t* T2; bf16_t* M; __device__ void operator()(int, int m, int n, float v) const {
    const float ga = sigmoidf_(bf2f(P[(size_t)m * INC + 1024 + n])), gb = sigmoidf_(bf2f(P[(size_t)m * INC + 2048 + n]));
    const size_t o = (size_t)m * D + n; M[o] = f2bf(ga * bf2f(T1[o]) + gb * bf2f(T2[o]) * sigmoidf_(v)); } };
struct EPres { float* h; float* z; const float* mod; int gidx; int rowoff; __device__ void operator()(int, int m, int n, float v) const {
    const int r = m + rowoff; float* dst = r < TC ? z + (size_t)r * D + n : h + (size_t)(r - TC) * D + n; const int cond = r < TC ? 16 : (r - TC) / L;
    *dst += mod[(size_t)cond * 6144 + gidx * 1024 + n] * v; } };
struct EPswi { bf16_t* G; int ld; int pad; __device__ void operator()(int, int m, int n, float v) const { const size_t o = (size_t)m * ld + n; G[o] = f2bf(siluf_(bf2f(G[o])) * v); } };
struct EPacc { float* O; int first; int pad; __device__ void operator()(int, int m, int n, float v) const { const size_t o = (size_t)m * D + n; O[o] = first ? v : O[o] + v; } };

__global__ void k_tables(float* cosT, float* sinT) { const int i = blockIdx.x * blockDim.x + threadIdx.x; if (i < 2048) { cosT[i] = cospif(i / 1024.f); sinT[i] = sinpif(i / 1024.f); } }
__global__ void k_mod(const float* c, const float* cctx, const float* wmod, const float* bmod, float* mod) {
    const int col = blockIdx.x * 256 + threadIdx.x, r = blockIdx.y, l = blockIdx.z;
    const float* cond = r < 16 ? c + r * D : cctx; const float* w = wmod + (size_t)l * D * 6144;
    float acc = 0.f;
    for (int k = 0; k < D; ++k) acc += siluf_(cond[k]) * w[(size_t)k * 6144 + col];
    mod[((size_t)l * 17 + r) * 6144 + col] = acc + bmod[l * 6144 + col];
}
__global__ void k_init(const float* x, const float* ctx, float* h, float* z) {
    const size_t i = (size_t)blockIdx.x * blockDim.x + threadIdx.x;
    if (i < (size_t)TL * D) { const int d = (int)(i & 1023); const int t = (int)(i >> 10); const int n = t & (L - 1); const int r = n >> 6, col = n & 63; const int q = d >> 8, ii = d & 255;
        const float omega = 1.0f / powf(10000.f, (float)ii / 256.f); const float ang = (q < 2 ? (float)r : (float)col) * omega; h[i] = x[i] + ((q & 1) ? cosf(ang) : sinf(ang)); }
    if (i < (size_t)TC * D) z[i] = ctx[i];
}
template <bool ROUTE>
__global__ __launch_bounds__(256) void k_norm(const float* h, const float* z, const float* g, const float* mod, int shi, int sci, bf16_t* A, int row0, int nrows,
                                              const float* wr, const float* br, int* tok_e, float* tok_w) {
    const int lane = threadIdx.x & 63; const int r = row0 + blockIdx.x * 4 + (threadIdx.x >> 6); if (r >= row0 + nrows) return;
    const float* src = r < TC ? z + (size_t)r * D : h + (size_t)(r - TC) * D; const int cond = r < TC ? 16 : (r - TC) / L;
    const float* sh = mod + (size_t)cond * 6144 + shi * 1024; const float* sc = mod + (size_t)cond * 6144 + sci * 1024;
    float4 v[4]; float ss = 0.f;
#pragma unroll
    for (int j = 0; j < 4; ++j) { v[j] = *(const float4*)(src + j * 256 + lane * 4); ss += v[j].x * v[j].x + v[j].y * v[j].y + v[j].z * v[j].z + v[j].w * v[j].w; }
    ss = wave_sum(ss); const float rstd = rsqrtf(ss * (1.f / D) + EPS);
    float lg[8];
#pragma unroll
    for (int e = 0; e < 8; ++e) lg[e] = 0.f;
#pragma unroll
    for (int j = 0; j < 4; ++j) { const int k = j * 256 + lane * 4; const float4 gg = *(const float4*)(g + k), s1 = *(const float4*)(sc + k), s0 = *(const float4*)(sh + k);
        float a0 = v[j].x * rstd * gg.x * (1.f + s1.x) + s0.x, a1 = v[j].y * rstd * gg.y * (1.f + s1.y) + s0.y, a2 = v[j].z * rstd * gg.z * (1.f + s1.z) + s0.z, a3 = v[j].w * rstd * gg.w * (1.f + s1.w) + s0.w;
        ushort4 o; o.x = f2bf(a0); o.y = f2bf(a1); o.z = f2bf(a2); o.w = f2bf(a3); *(ushort4*)(A + (size_t)r * D + k) = o;
        if (ROUTE) {
#pragma unroll
            for (int e = 0; e < 8; ++e) lg[e] += a0 * wr[(k + 0) * 8 + e] + a1 * wr[(k + 1) * 8 + e] + a2 * wr[(k + 2) * 8 + e] + a3 * wr[(k + 3) * 8 + e]; } }
    if (ROUTE) {
#pragma unroll
        for (int e = 0; e < 8; ++e) lg[e] = wave_sum(lg[e]) + br[e];
        if (lane == 0) { int e1 = 0; float v1 = lg[0];
#pragma unroll
            for (int e = 1; e < 8; ++e) if (lg[e] > v1) { v1 = lg[e]; e1 = e; }
            int e2 = -1; float v2 = -3.0e38f;
#pragma unroll
            for (int e = 0; e < 8; ++e) if (e != e1 && lg[e] > v2) { v2 = lg[e]; e2 = e; }
            const float w1 = 1.f / (1.f + expf(v2 - v1)); const int t = r - TC;
            tok_e[t * 2] = e1; tok_e[t * 2 + 1] = e2; tok_w[t * 2] = w1; tok_w[t * 2 + 1] = 1.f - w1; }
    }
}
__global__ __launch_bounds__(64) void k_s5_naive(const bf16_t* P, const float* are, const float* aim, const float* logdt, const float* bre, const float* bim, const float* cre, const float* cim,
                                                  const float* dsk, float* Yacc, bf16_t* YS) {
    const int b = blockIdx.x >> 5, g = blockIdx.x & 31, p = threadIdx.x, lane = p;
    const int hh = ((lane >> 5) & 1) * 8 + ((lane >> 4) & 1) * 4 + ((lane >> 3) & 1) * 2 + ((lane >> 2) & 1);
    for (int dir = 0; dir < 2; ++dir) {
        const int gp = (dir * 32 + g) * 64 + p;
        const float ar = are[gp], ai = aim[gp], dt = expf(logdt[dir * 32 + g]);
        const float er = expf(ar * dt), lbr = er * cosf(ai * dt), lbi = er * sinf(ai * dt);
        const float nr = lbr - 1.f, ni = lbi, den = ar * ar + ai * ai, qr = (nr * ar + ni * ai) / den, qi = (ni * ar - nr * ai) / den;
        float Br[16], Bi[16], Cr[16], Ci[16];
#pragma unroll
        for (int h = 0; h < 16; ++h) { const float x0 = bre[(size_t)gp * 16 + h], x1 = bim[(size_t)gp * 16 + h]; Br[h] = qr * x0 - qi * x1; Bi[h] = qr * x1 + qi * x0;
            Cr[h] = cre[((size_t)(dir * 32 + g) * 16 + h) * 64 + p]; Ci[h] = cim[((size_t)(dir * 32 + g) * 16 + h) * 64 + p]; }
        float xr = 0.f, xi = 0.f;
        for (int s = 0; s < LC + L; ++s) {
            int row; if (dir == 0) row = s < LC ? b * LC + s : TC + b * L + (s - LC); else row = s < LC ? b * LC + (LC - 1 - s) : TC + b * L + (L - 1 - (s - LC));
            const bf16_t* up = P + (size_t)row * INC + 512 + g * 16;
            float u[16];
#pragma unroll
            for (int h = 0; h < 16; ++h) u[h] = bf2f(up[h]);
            float bur = 0.f, bui = 0.f;
#pragma unroll
            for (int h = 0; h < 16; ++h) { bur += Br[h] * u[h]; bui += Bi[h] * u[h]; }
            const float nxr = lbr * xr - lbi * xi + bur, nxi = lbr * xi + lbi * xr + bui; xr = nxr; xi = nxi;
            float v[16];
#pragma unroll
            for (int h = 0; h < 16; ++h) v[h] = Cr[h] * xr - Ci[h] * xi;
#pragma unroll
            for (int st = 0; st < 4; ++st) { const int n = 8 >> st, off = 32 >> st; const bool hi = (lane & off) != 0;
#pragma unroll
                for (int j = 0; j < 8; ++j) if (j < n) { const float mine = hi ? v[j + n] : v[j]; const float other = hi ? v[j] : v[j + n]; v[j] = mine + __shfl_xor(other, off); } }
            float val = v[0]; val += __shfl_xor(val, 2); val += __shfl_xor(val, 1);
            if ((lane & 3) == 0) { const size_t o = (size_t)row * 512 + g * 16 + hh;
                if (dir == 0) Yacc[o] = val; else { const float y = Yacc[o] + val + dsk[g * 16 + hh] * bf2f(up[hh]); YS[o] = f2bf(geluf_(y)); } }
        }
    }
}
__global__ void k_moe_zero(int* cnt, int* rowtok) { const int i = blockIdx.x * blockDim.x + threadIdx.x; if (i < 16) cnt[i] = 0; if (i < MOEROWS) rowtok[i] = -1; }
__global__ __launch_bounds__(256) void k_moe_count(const int* tok_e, int* cnt, int* tok_pos) {
    __shared__ int lc[8], lb[8];
    if (threadIdx.x < 8) lc[threadIdx.x] = 0; __syncthreads();
    const int i = blockIdx.x * 256 + threadIdx.x;
    const int e = tok_e[i]; const int lp = atomicAdd(&lc[e], 1); __syncthreads();
    if (threadIdx.x < 8) lb[threadIdx.x] = atomicAdd(&cnt[threadIdx.x], lc[threadIdx.x]); __syncthreads();
    tok_pos[i] = lb[e] + lp;
}
__global__ __launch_bounds__(256) void k_moe_place(const int* tok_e, const int* cnt, const int* tok_pos, int* tok_row, int* rowtok, int* tile_e) {
    int base[9]; base[0] = 0;
#pragma unroll
    for (int e = 0; e < 8; ++e) base[e + 1] = base[e] + ((cnt[e] + 255) & ~255);
    const int i = blockIdx.x * 256 + threadIdx.x; const int e = tok_e[i];
    int bs = 0;
#pragma unroll
    for (int k = 0; k < 8; ++k) if (k == e) bs = base[k];
    const int row = bs + tok_pos[i]; tok_row[i] = row; rowtok[row] = i >> 1;
    if (i < MOETILES) { int te = -1;
#pragma unroll
        for (int k = 0; k < 8; ++k) if (i * 256 >= base[k] && i * 256 < base[k + 1]) te = k;
        tile_e[i] = te; }
}
__global__ __launch_bounds__(256) void k_final(float* h, const float* mod, const float* O, const int* tok_row, const float* tok_w, const float* fg, float* out) {
    const int lane = threadIdx.x & 63; const int t = blockIdx.x * 4 + (threadIdx.x >> 6); const int cond = t / L;
    const float* g2 = mod + (size_t)cond * 6144 + 5 * 1024; const int r1 = tok_row[t * 2], r2 = tok_row[t * 2 + 1]; const float w1 = tok_w[t * 2], w2 = tok_w[t * 2 + 1];
    float4 v[4]; float ss = 0.f;
#pragma unroll
    for (int j = 0; j < 4; ++j) { const int k = j * 256 + lane * 4; const float4 hv = *(const float4*)(h + (size_t)t * D + k), a = *(const float4*)(O + (size_t)r1 * D + k), b = *(const float4*)(O + (size_t)r2 * D + k), gg = *(const float4*)(g2 + k);
        v[j].x = hv.x + gg.x * (w1 * a.x + w2 * b.x); v[j].y = hv.y + gg.y * (w1 * a.y + w2 * b.y); v[j].z = hv.z + gg.z * (w1 * a.z + w2 * b.z); v[j].w = hv.w + gg.w * (w1 * a.w + w2 * b.w);
        ss += v[j].x * v[j].x + v[j].y * v[j].y + v[j].z * v[j].z + v[j].w * v[j].w; }
    ss = wave_sum(ss); const float rstd = rsqrtf(ss * (1.f / D) + EPS);
#pragma unroll
    for (int j = 0; j < 4; ++j) { const int k = j * 256 + lane * 4; const float4 gg = *(const float4*)(fg + k); float4 o; o.x = v[j].x * rstd * gg.x; o.y = v[j].y * rstd * gg.y; o.z = v[j].z * rstd * gg.z; o.w = v[j].w * rstd * gg.w;
        *(float4*)(out + (size_t)t * D + k) = o; }
}
}

extern "C" void kernel_launch(void* const* d_in, const int* in_sizes, int n_in, void* d_out, int out_size, void* d_ws, size_t ws_size, hipStream_t stream) {
    const float* x = (const float*)d_in[0]; const float* c = (const float*)d_in[1]; const float* ctx = (const float*)d_in[2]; const float* cctx = (const float*)d_in[3];
    const float* wmod = (const float*)d_in[4]; const float* bmod = (const float*)d_in[5]; const float* n1g = (const float*)d_in[6]; const float* n2g = (const float*)d_in[7];
    const float* win = (const float*)d_in[8]; const float* wfour = (const float*)d_in[9];
    const float* are = (const float*)d_in[10]; const float* aim = (const float*)d_in[11]; const float* logdt = (const float*)d_in[12];
    const float* bre = (const float*)d_in[13]; const float* bim = (const float*)d_in[14]; const float* cre = (const float*)d_in[15]; const float* cim = (const float*)d_in[16];
    const float* ssmd = (const float*)d_in[17]; const float* glua = (const float*)d_in[18]; const float* glub = (const float*)d_in[19]; const float* wout = (const float*)d_in[20];
    const float* fgw = (const float*)d_in[21]; const float* fuw = (const float*)d_in[22]; const float* fdw = (const float*)d_in[23];
    const float* mrw = (const float*)d_in[24]; const float* mrb = (const float*)d_in[25]; const float* mgw = (const float*)d_in[26]; const float* muw = (const float*)d_in[27]; const float* mdw = (const float*)d_in[28];
    const float* finalg = (const float*)d_in[29];
    float* h = (float*)d_out;
    char* ws = (char*)d_ws; size_t off = 0;
    auto alloc = [&](size_t bytes) { void* p = ws + off; off += (bytes + 255) & ~(size_t)255; return p; };
    float* mod = (float*)alloc((size_t)2 * 17 * 6144 * 4);
    float* cosT = (float*)alloc(2048 * 4); float* sinT = (float*)alloc(2048 * 4);
    int* cnt = (int*)alloc(64); int* tok_e = (int*)alloc((size_t)TL * 2 * 4); float* tok_w = (float*)alloc((size_t)TL * 2 * 4); int* tok_pos = (int*)alloc((size_t)TL * 2 * 4); int* tok_row = (int*)alloc((size_t)TL * 2 * 4);
    int* rowtok = (int*)alloc((size_t)MOEROWS * 4); int* tile_e = (int*)alloc((size_t)MOETILES * 4);
    float* z = (float*)alloc((size_t)TC * D * 4);
    bf16_t* A = (bf16_t*)alloc((size_t)TT * D * 2);
    const size_t big0 = off;
    bf16_t* P = (bf16_t*)alloc((size_t)TT * INC * 2);
    bf16_t* Zc = (bf16_t*)alloc((size_t)TT * 512 * 2); bf16_t* Zs = (bf16_t*)alloc((size_t)TT * 512 * 2); bf16_t* T1 = Zc;
    bf16_t* F = (bf16_t*)alloc((size_t)TT * 512 * 2);
    float* Yacc = (float*)alloc((size_t)TT * 512 * 4); bf16_t* T2 = (bf16_t*)Yacc;
    bf16_t* YS = (bf16_t*)alloc((size_t)TT * 512 * 2);
    bf16_t* HID = P;
    float* O = (float*)(ws + big0); bf16_t* HQ = (bf16_t*)(ws + big0 + (((size_t)MOEROWS * D * 4 + 255) & ~(size_t)255));

    hipLaunchKernelGGL(k_tables, dim3(8), dim3(256), 0, stream, cosT, sinT);
    hipLaunchKernelGGL(k_mod, dim3(24, 17, 2), dim3(256), 0, stream, c, cctx, wmod, bmod, mod);
    hipLaunchKernelGGL(k_init, dim3(TL * D / 256), dim3(256), 0, stream, x, ctx, h, z);
    for (int l = 0; l < 2; ++l) {
        const float* modl = mod + (size_t)l * 17 * 6144; const bool need_ctx = (l == 0);
        hipLaunchKernelGGL(k_norm<false>, dim3(TT / 4), dim3(256), 0, stream, h, z, n1g + l * D, modl, 0, 1, A, 0, TT, nullptr, nullptr, nullptr, nullptr);
        { LAbf la{A, D, 0}; LBw lb{win + (size_t)l * D * INC, INC, 0}; EPbf ep{P, INC, 0}; hipLaunchKernelGGL((ngemm<LAbf, LBw, EPbf>), dim3(INC / 64, TT / 64, 1), dim3(256), 0, stream, D, 0, la, lb, ep); }
        { LAbfZ la{P, INC, 128}; LBdft128 lb{cosT, sinT}; EPzdft ep{Zc, Zs}; hipLaunchKernelGGL((ngemm<LAbfZ, LBdft128, EPzdft>), dim3(256 / 64, TT / 64, 4), dim3(256), 0, stream, 128, 0, la, lb, ep); }
        { LAdftL<L> la{cosT, sinT}; LBdftL<L> lb{Zc, Zs, TC, 0}; EPfour<L> ep{F, TC, 1.0f / sqrtf((float)L * 128.f)}; hipLaunchKernelGGL((ngemm<LAdftL<L>, LBdftL<L>, EPfour<L>>), dim3(512 / 64, L / 64, NB), dim3(256), 0, stream, 2 * L, 0, la, lb, ep); }
        if (need_ctx) { LAdftL<LC> la{cosT, sinT}; LBdftL<LC> lb{Zc, Zs, 0, 0}; EPfour<LC> ep{F, 0, 1.0f / sqrtf((float)LC * 128.f)}; hipLaunchKernelGGL((ngemm<LAdftL<LC>, LBdftL<LC>, EPfour<LC>>), dim3(512 / 64, LC / 64, NB), dim3(256), 0, stream, 2 * LC, 0, la, lb, ep); }
        hipLaunchKernelGGL(k_s5_naive, dim3(NB * 32), dim3(64), 0, stream, P, are + l * 4096, aim + l * 4096, logdt + l * 64, bre + (size_t)l * 65536, bim + (size_t)l * 65536, cre + (size_t)l * 65536, cim + (size_t)l * 65536, ssmd + l * 512, Yacc, YS);
        const int r0 = need_ctx ? 0 : TC, nr = TT - r0;
        { LAbf la{F + (size_t)r0 * 512, 512, 0}; LBw lb{wfour + (size_t)l * 512 * D, D, 0}; EPbf ep{T1 + (size_t)r0 * D, D, 0}; hipLaunchKernelGGL((ngemm<LAbf, LBw, EPbf>), dim3(D / 64, nr / 64, 1), dim3(256), 0, stream, 512, 0, la, lb, ep); }
        { LAbf la{YS + (size_t)r0 * 512, 512, 0}; LBw lb{glua + (size_t)l * 512 * D, D, 0}; EPbf ep{T2 + (size_t)r0 * D, D, 0}; hipLaunchKernelGGL((ngemm<LAbf, LBw, EPbf>), dim3(D / 64, nr / 64, 1), dim3(256), 0, stream, 512, 0, la, lb, ep); }
        { LAbf la{YS + (size_t)r0 * 512, 512, 0}; LBw lb{glub + (size_t)l * 512 * D, D, 0}; EPmerge ep{P + (size_t)r0 * INC, T1 + (size_t)r0 * D, T2 + (size_t)r0 * D, T1 + (size_t)r0 * D}; hipLaunchKernelGGL((ngemm<LAbf, LBw, EPmerge>), dim3(D / 64, nr / 64, 1), dim3(256), 0, stream, 512, 0, la, lb, ep); }
        { LAbf la{T1 + (size_t)r0 * D, D, 0}; LBw lb{wout + (size_t)l * D * D, D, 0}; EPres ep{h, z, modl, 2, r0}; hipLaunchKernelGGL((ngemm<LAbf, LBw, EPres>), dim3(D / 64, nr / 64, 1), dim3(256), 0, stream, D, 0, la, lb, ep); }
        if (l == 0) {
            hipLaunchKernelGGL(k_norm<false>, dim3(TT / 4), dim3(256), 0, stream, h, z, n2g + l * D, modl, 3, 4, A, 0, TT, nullptr, nullptr, nullptr, nullptr);
            { LAbf la{A, D, 0}; LBw lb{fgw, DFF, 0}; EPbf ep{HID, DFF, 0}; hipLaunchKernelGGL((ngemm<LAbf, LBw, EPbf>), dim3(DFF / 64, TT / 64, 1), dim3(256), 0, stream, D, 0, la, lb, ep); }
            { LAbf la{A, D, 0}; LBw lb{fuw, DFF, 0}; EPswi ep{HID, DFF, 0}; hipLaunchKernelGGL((ngemm<LAbf, LBw, EPswi>), dim3(DFF / 64, TT / 64, 1), dim3(256), 0, stream, D, 0, la, lb, ep); }
            { LAbf la{HID, DFF, 0}; LBw lb{fdw, D, 0}; EPres ep{h, z, modl, 5, 0}; hipLaunchKernelGGL((ngemm<LAbf, LBw, EPres>), dim3(D / 64, TT / 64, 1), dim3(256), 0, stream, DFF, 0, la, lb, ep); }
        } else {
            hipLaunchKernelGGL(k_moe_zero, dim3((MOEROWS + 255) / 256), dim3(256), 0, stream, cnt, rowtok);
            hipLaunchKernelGGL(k_norm<true>, dim3(TL / 4), dim3(256), 0, stream, h, z, n2g + l * D, modl, 3, 4, A, TC, TL, mrw, mrb, tok_e, tok_w);
            hipLaunchKernelGGL(k_moe_count, dim3(TL * 2 / 256), dim3(256), 0, stream, tok_e, cnt, tok_pos);
            hipLaunchKernelGGL(k_moe_place, dim3(TL * 2 / 256), dim3(256), 0, stream, tok_e, cnt, tok_pos, tok_row, rowtok, tile_e);
            for (int q = 0; q < 4; ++q) {
                { LAgather la{A + (size_t)TC * D, rowtok, tile_e}; LBmoe lb{mgw, tile_e, (size_t)D * DFE, DFE, q * 896, 0, 0}; EPbf ep{HQ, 896, 0}; hipLaunchKernelGGL((ngemm<LAgather, LBmoe, EPbf>), dim3(896 / 64, MOEROWS / 64, 1), dim3(256), 0, stream, D, 0, la, lb, ep); }
                { LAgather la{A + (size_t)TC * D, rowtok, tile_e}; LBmoe lb{muw, tile_e, (size_t)D * DFE, DFE, q * 896, 0, 0}; EPswi ep{HQ, 896, 0}; hipLaunchKernelGGL((ngemm<LAgather, LBmoe, EPswi>), dim3(896 / 64, MOEROWS / 64, 1), dim3(256), 0, stream, D, 0, la, lb, ep); }
                { LAmoeh la{HQ, tile_e}; LBmoe lb{mdw, tile_e, (size_t)DFE * D, D, 0, q * 896, 0}; EPacc ep{O, q == 0, 0}; hipLaunchKernelGGL((ngemm<LAmoeh, LBmoe, EPacc>), dim3(D / 64, MOEROWS / 64, 1), dim3(256), 0, stream, 896, 0, la, lb, ep); }
            }
            hipLaunchKernelGGL(k_final, dim3(TL / 4), dim3(256), 0, stream, h, modl, O, tok_row, tok_w, finalg, (float*)d_out);
        }
    }
}
```

```cpp
#define FASTMASK 0x1FF
#define ONE_LAUNCH 0
#include <hip/hip_runtime.h>
#include <stdint.h>
#include <math.h>

#ifndef FASTMASK
#define FASTMASK 0x0
#endif
#ifndef ONE_LAUNCH
#define ONE_LAUNCH 0
#endif

namespace {
typedef unsigned short bf16_t;
constexpr int D = 1024, NB = 16, L = 2048, LC = 256, TL = NB * L, TC = NB * LC, TT = TL + TC;
constexpr int INC = 3072, DFF = 2816, NE = 8, DFE = 3584, MOEROWS = 2 * TL + NE * 256, MOETILES = MOEROWS / 256;
constexpr int CHR = TT / 16;
constexpr float EPS = 1e-6f;
constexpr int F_PRO = 1, F_INPROJ = 2, F_FOUR = 4, F_S5 = 8, F_GLU = 16, F_OUT = 32, F_FFN = 64, F_MOE = 128, F_NORM = 256;

constexpr size_t MiB = (size_t)1 << 20, KiB = 1024;
constexpr size_t WS_CTL = 0, CTL_BYTES = 64 * KiB;
constexpr size_t WS_MOD = 128 * KiB;
constexpr size_t WS_LAMQ = 1 * MiB;
constexpr size_t WS_COST = 1 * MiB + 64 * KiB;
constexpr size_t WS_TOKE = 1 * MiB + 256 * KiB, WS_TOKW = WS_TOKE + 256 * KiB, WS_TOKPOS = WS_TOKW + 256 * KiB, WS_TOKROW = WS_TOKPOS + 256 * KiB;
constexpr size_t WS_TILEE = WS_TOKROW + 256 * KiB, WS_ROWTOK = WS_TILEE + 4 * KiB;
constexpr size_t WS_Z = 4 * MiB;
constexpr size_t WS_DFTL = 20 * MiB, WS_DFTC = 36 * MiB;
constexpr size_t WS_S5E = 37 * MiB, WS_S5TG = 41 * MiB, S5_LSTRIDE = 12 * MiB;
constexpr size_t WS_MIXW = 61 * MiB, MIXW_LSTRIDE = 12 * MiB;
constexpr size_t WS_WGU = 85 * MiB, WS_WDN = 96 * MiB;
constexpr size_t WS_UX = 102 * MiB, WS_GT = 174 * MiB, WS_S = 318 * MiB, WS_VT2L = 390 * MiB, WS_VT2C = 454 * MiB, WS_TM = 390 * MiB, WS_XA = 535 * MiB, WS_YS = 535 * MiB;
constexpr size_t WS_PF = 462 * MiB, WS_T1 = 462 * MiB, WS_YACC = 318 * MiB, WS_T2 = 318 * MiB;
constexpr size_t WS_HID = 102 * MiB;
constexpr size_t WS_WMOE = 4 * MiB, WS_XS = 172 * MiB, WS_HIDM = 304 * MiB;
constexpr int MOE_TP = 132;
constexpr size_t WS_NO = 102 * MiB, WS_NHQ = 366 * MiB;
constexpr size_t WS_END = 607 * MiB;
constexpr int CW_BAR = 0, CW_CNT = 4096, CW_NT = 4096 + 64;

__device__ __forceinline__ float bf2f(bf16_t b) { return __uint_as_float(((unsigned)b) << 16); }
__device__ __forceinline__ bf16_t f2bf(float f) { unsigned u = __float_as_uint(f); u += 0x7FFFu + ((u >> 16) & 1u); return (bf16_t)(u >> 16); }
__device__ __forceinline__ float sigmoidf_(float v) { return 1.f / (1.f + expf(-v)); }
__device__ __forceinline__ float siluf_(float v) { return v / (1.f + expf(-v)); }
__device__ __forceinline__ float geluf_(float v) { return 0.5f * v * (1.f + tanhf(0.7978845608028654f * (v + 0.044715f * v * v * v))); }
__device__ __forceinline__ float wave_sum(float v) {
#pragma unroll
    for (int o = 32; o >= 1; o >>= 1) v += __shfl_xor(v, o);
    return v;
}
__device__ __forceinline__ size_t ux_index(int g, int row, int h) { return ((size_t)g * CHR + (row >> 4)) * 512 + (row & 15) * 16 + h; }
__device__ __forceinline__ size_t vt2_index(int row, int gk, int type) {
    if (row < TC) { const int b = row >> 8, n = row & 255; return ((size_t)(b * 512 + gk)) * 512 + type * 256 + n; }
    const int t = row - TC, b = t >> 11, n = t & 2047; return ((size_t)(b * 512 + gk)) * 4096 + type * 2048 + n;
}

template <class LA, class LB, class EP>
__global__ __launch_bounds__(256) void ngemm(int K, int kpad, LA la, LB lb, EP ep) {
    __shared__ float As[16][68], Bs[16][68];
    const int tx = threadIdx.x & 15, ty = threadIdx.x >> 4;
    const int m0 = blockIdx.y * 64, n0 = blockIdx.x * 64, z = blockIdx.z;
    if (!la.active(z, m0)) return;
    float acc[4][4];
#pragma unroll
    for (int i = 0; i < 4; ++i)
#pragma unroll
        for (int j = 0; j < 4; ++j) acc[i][j] = 0.f;
    for (int k0 = 0; k0 < K; k0 += 16) {
#pragma unroll
        for (int i = 0; i < 4; ++i) { const int e = threadIdx.x + i * 256; const int mm = e >> 4, kk = e & 15; As[kk][mm] = la(z, m0 + mm, k0 + kk); }
#pragma unroll
        for (int i = 0; i < 4; ++i) { const int e = threadIdx.x + i * 256; const int kk = e >> 6, nn = e & 63; Bs[kk][nn] = lb(z, m0, k0 + kk, n0 + nn); }
        __syncthreads();
#pragma unroll
        for (int kk = 0; kk < 16; ++kk) {
            float a[4], b[4];
#pragma unroll
            for (int i = 0; i < 4; ++i) { a[i] = As[kk][ty * 4 + i]; b[i] = Bs[kk][tx * 4 + i]; }
#pragma unroll
            for (int i = 0; i < 4; ++i)
#pragma unroll
                for (int j = 0; j < 4; ++j) acc[i][j] += a[i] * b[j];
        }
        __syncthreads();
    }
#pragma unroll
    for (int i = 0; i < 4; ++i)
#pragma unroll
        for (int j = 0; j < 4; ++j) ep(z, m0 + ty * 4 + i, n0 + tx * 4 + j, acc[i][j]);
}
struct LAbf { const bf16_t* p; int ld; int pad; __device__ bool active(int, int) const { return true; } __device__ float operator()(int, int m, int k) const { return bf2f(p[(size_t)m * ld + k]); } };
struct LAbfZ { const bf16_t* p; int ld; int zoff; __device__ bool active(int, int) const { return true; } __device__ float operator()(int z, int m, int k) const { return bf2f(p[(size_t)m * ld + z * zoff + k]); } };
struct LBw { const float* p; int ld; int pad; __device__ float operator()(int, int, int k, int n) const { return p[(size_t)k * ld + n]; } };
struct LBdft128 { const float* cosT; const float* sinT; __device__ float operator()(int, int, int k, int n) const { const int nn = n & 127; const int idx = ((k * nn) & 127) * 16; return n < 128 ? cosT[idx] : sinT[idx]; } };
template <int LL> struct LAdftL { const float* cosT; const float* sinT; __device__ bool active(int, int) const { return true; }
    __device__ float operator()(int, int m, int k) const { const int kk = k & (LL - 1); const int idx = ((m * kk) & (LL - 1)) * (2048 / LL); return k < LL ? cosT[idx] : -sinT[idx]; } };
template <int LL> struct LBvt2 { const bf16_t* V; __device__ float operator()(int z, int, int k, int n) const { return bf2f(V[((size_t)(z * 512 + n)) * (2 * LL) + k]); } };
struct LAgather { const bf16_t* A; const int* rowtok; const int* tile_e; __device__ bool active(int, int m0) const { return tile_e[m0 >> 8] >= 0; }
    __device__ float operator()(int, int m, int k) const { const int t = rowtok[m]; return t < 0 ? 0.f : bf2f(A[(size_t)t * D + k]); } };
struct LAmoeh { const bf16_t* H; const int* tile_e; __device__ bool active(int, int m0) const { return tile_e[m0 >> 8] >= 0; }
    __device__ float operator()(int, int m, int k) const { return bf2f(H[(size_t)m * 896 + k]); } };
struct LBmoe { const float* w; const int* tile_e; size_t estride; int ld; int coff; int roff; int pad; __device__ float operator()(int, int m0, int k, int n) const { const int e = tile_e[m0 >> 8]; return w[(size_t)e * estride + (size_t)(k + roff) * ld + coff + n]; } };

struct EPbf { bf16_t* o; int ld; int pad; __device__ void operator()(int, int m, int n, float v) const { o[(size_t)m * ld + n] = f2bf(v); } };
struct EPinproj { bf16_t* PF; bf16_t* UX; bf16_t* GT; __device__ void operator()(int, int m, int n, float v) const {
    if (n < 512) PF[(size_t)m * 512 + n] = f2bf(v); else if (n < 1024) { const int c = n - 512; UX[ux_index(c >> 4, m, c & 15)] = f2bf(v); } else GT[(size_t)m * 2048 + (n - 1024)] = f2bf(sigmoidf_(v)); } };
struct EPzdft { bf16_t* VL; bf16_t* VC; __device__ void operator()(int z, int m, int n, float v) const { (m < TC ? VC : VL)[vt2_index(m, z * 128 + (n & 127), n >> 7)] = f2bf(v); } };
template <int LL> struct EPfour { bf16_t* YS; int rowbase; float scale; __device__ void operator()(int z, int m, int n, float v) const { YS[((size_t)rowbase + z * LL + m) * 1024 + n] = f2bf(v * scale); } };
struct EPmerge { const bf16_t* GT; const bf16_t* T1; const bf16_t* T2; bf16_t* M; __device__ void operator()(int, int m, int n, float v) const {
    const float ga = bf2f(GT[(size_t)m * 2048 + n]), gb = bf2f(GT[(size_t)m * 2048 + 1024 + n]);
    const size_t o = (size_t)m * D + n; M[o] = f2bf(ga * bf2f(T1[o]) + gb * bf2f(T2[o]) * sigmoidf_(v)); } };
struct EPres { float* h; float* z; const float* mod; int gidx; int rowoff; __device__ void operator()(int, int m, int n, float v) const {
    const int r = m + rowoff; float* dst = r < TC ? z + (size_t)r * D + n : h + (size_t)(r - TC) * D + n; const int cond = r < TC ? 16 : (r - TC) / L;
    *dst += mod[(size_t)cond * 6144 + gidx * 1024 + n] * v; } };
struct EPswi { bf16_t* G; int ld; int pad; __device__ void operator()(int, int m, int n, float v) const { const size_t o = (size_t)m * ld + n; G[o] = f2bf(siluf_(bf2f(G[o])) * v); } };
struct EPacc { float* O; int first; int pad; __device__ void operator()(int, int m, int n, float v) const { const size_t o = (size_t)m * D + n; O[o] = first ? v : O[o] + v; } };

__global__ void k_tables(float* cosT, float* sinT) { const int i = blockIdx.x * blockDim.x + threadIdx.x; if (i < 2048) { cosT[i] = cospif(i / 1024.f); sinT[i] = sinpif(i / 1024.f); } }
__global__ void k_mod(const float* c, const float* cctx, const float* wmod, const float* bmod, float* mod) {
    const int col = blockIdx.x * 256 + threadIdx.x, r = blockIdx.y, l = blockIdx.z;
    const float* cond = r < 16 ? c + r * D : cctx; const float* w = wmod + (size_t)l * D * 6144;
    float acc = 0.f;
    for (int k = 0; k < D; ++k) acc += siluf_(cond[k]) * w[(size_t)k * 6144 + col];
    mod[((size_t)l * 17 + r) * 6144 + col] = acc + bmod[l * 6144 + col];
}
__global__ void k_init(const float* x, const float* ctx, float* h, float* z) {
    const size_t i = (size_t)blockIdx.x * blockDim.x + threadIdx.x;
    if (i < (size_t)TL * D) { const int d = (int)(i & 1023); const int t = (int)(i >> 10); const int n = t & (L - 1); const int r = n >> 6, col = n & 63; const int q = d >> 8, ii = d & 255;
        const float omega = 1.0f / powf(10000.f, (float)ii / 256.f); const float ang = (q < 2 ? (float)r : (float)col) * omega; h[i] = x[i] + ((q & 1) ? cosf(ang) : sinf(ang)); }
    if (i < (size_t)TC * D) z[i] = ctx[i];
}
template <bool ROUTE>
__global__ __launch_bounds__(256) void k_norm(const float* h, const float* z, const float* g, const float* mod, int shi, int sci, bf16_t* A, int row0, int nrows,
                                              const float* wr, const float* br, int* tok_e, float* tok_w) {
    const int lane = threadIdx.x & 63; const int r = row0 + blockIdx.x * 4 + (threadIdx.x >> 6); if (r >= row0 + nrows) return;
    const float* src = r < TC ? z + (size_t)r * D : h + (size_t)(r - TC) * D; const int cond = r < TC ? 16 : (r - TC) / L;
    const float* sh = mod + (size_t)cond * 6144 + shi * 1024; const float* sc = mod + (size_t)cond * 6144 + sci * 1024;
    float4 v[4]; float ss = 0.f;
#pragma unroll
    for (int j = 0; j < 4; ++j) { v[j] = *(const float4*)(src + j * 256 + lane * 4); ss += v[j].x * v[j].x + v[j].y * v[j].y + v[j].z * v[j].z + v[j].w * v[j].w; }
    ss = wave_sum(ss); const float rstd = rsqrtf(ss * (1.f / D) + EPS);
    float lg[8];
#pragma unroll
    for (int e = 0; e < 8; ++e) lg[e] = 0.f;
#pragma unroll
    for (int j = 0; j < 4; ++j) { const int k = j * 256 + lane * 4; const float4 gg = *(const float4*)(g + k), s1 = *(const float4*)(sc + k), s0 = *(const float4*)(sh + k);
        float a0 = v[j].x * rstd * gg.x * (1.f + s1.x) + s0.x, a1 = v[j].y * rstd * gg.y * (1.f + s1.y) + s0.y, a2 = v[j].z * rstd * gg.z * (1.f + s1.z) + s0.z, a3 = v[j].w * rstd * gg.w * (1.f + s1.w) + s0.w;
        ushort4 o; o.x = f2bf(a0); o.y = f2bf(a1); o.z = f2bf(a2); o.w = f2bf(a3); *(ushort4*)(A + (size_t)r * D + k) = o;
        if (ROUTE) {
#pragma unroll
            for (int e = 0; e < 8; ++e) lg[e] += a0 * wr[(k + 0) * 8 + e] + a1 * wr[(k + 1) * 8 + e] + a2 * wr[(k + 2) * 8 + e] + a3 * wr[(k + 3) * 8 + e]; } }
    if (ROUTE) {
#pragma unroll
        for (int e = 0; e < 8; ++e) lg[e] = wave_sum(lg[e]) + br[e];
        if (lane == 0) { int e1 = 0; float v1 = lg[0];
#pragma unroll
            for (int e = 1; e < 8; ++e) if (lg[e] > v1) { v1 = lg[e]; e1 = e; }
            int e2 = -1; float v2 = -3.0e38f;
#pragma unroll
            for (int e = 0; e < 8; ++e) if (e != e1 && lg[e] > v2) { v2 = lg[e]; e2 = e; }
            const float w1 = 1.f / (1.f + expf(v2 - v1)); const int t = r - TC;
            tok_e[t * 2] = e1; tok_e[t * 2 + 1] = e2; tok_w[t * 2] = w1; tok_w[t * 2 + 1] = 1.f - w1; }
    }
}
__global__ __launch_bounds__(64) void k_s5_naive(const bf16_t* UX, const float* are, const float* aim, const float* logdt, const float* bre, const float* bim, const float* cre, const float* cim,
                                                  const float* dsk, float* Yacc, bf16_t* YS) {
    const int b = blockIdx.x >> 5, g = blockIdx.x & 31, p = threadIdx.x, lane = p;
    const int hh = ((lane >> 5) & 1) * 8 + ((lane >> 4) & 1) * 4 + ((lane >> 3) & 1) * 2 + ((lane >> 2) & 1);
    for (int dir = 0; dir < 2; ++dir) {
        const int gp = (dir * 32 + g) * 64 + p;
        const float ar = are[gp], ai = aim[gp], dt = expf(logdt[dir * 32 + g]);
        const float er = expf(ar * dt), lbr = er * cosf(ai * dt), lbi = er * sinf(ai * dt);
        const float nr = lbr - 1.f, ni = lbi, den = ar * ar + ai * ai, qr = (nr * ar + ni * ai) / den, qi = (ni * ar - nr * ai) / den;
        float Br[16], Bi[16], Cr[16], Ci[16];
#pragma unroll
        for (int h = 0; h < 16; ++h) { const float x0 = bre[(size_t)gp * 16 + h], x1 = bim[(size_t)gp * 16 + h]; Br[h] = qr * x0 - qi * x1; Bi[h] = qr * x1 + qi * x0;
            Cr[h] = cre[((size_t)(dir * 32 + g) * 16 + h) * 64 + p]; Ci[h] = cim[((size_t)(dir * 32 + g) * 16 + h) * 64 + p]; }
        float xr = 0.f, xi = 0.f;
        for (int s = 0; s < LC + L; ++s) {
            int row; if (dir == 0) row = s < LC ? b * LC + s : TC + b * L + (s - LC); else row = s < LC ? b * LC + (LC - 1 - s) : TC + b * L + (L - 1 - (s - LC));
            const bf16_t* up = UX + ux_index(g, row, 0);
            float u[16];
#pragma unroll
            for (int h = 0; h < 16; ++h) u[h] = bf2f(up[h]);
            float bur = 0.f, bui = 0.f;
#pragma unroll
            for (int h = 0; h < 16; ++h) { bur += Br[h] * u[h]; bui += Bi[h] * u[h]; }
            const float nxr = lbr * xr - lbi * xi + bur, nxi = lbr * xi + lbi * xr + bui; xr = nxr; xi = nxi;
            float v[16];
#pragma unroll
            for (int h = 0; h < 16; ++h) v[h] = Cr[h] * xr - Ci[h] * xi;
#pragma unroll
            for (int st = 0; st < 4; ++st) { const int n = 8 >> st, off = 32 >> st; const bool hi = (lane & off) != 0;
#pragma unroll
                for (int j = 0; j < 8; ++j) if (j < n) { const float mine = hi ? v[j + n] : v[j]; const float other = hi ? v[j] : v[j + n]; v[j] = mine + __shfl_xor(other, off); } }
            float val = v[0]; val += __shfl_xor(val, 2); val += __shfl_xor(val, 1);
            if ((lane & 3) == 0) { const size_t o = (size_t)row * 512 + g * 16 + hh;
                if (dir == 0) Yacc[o] = val; else { const float y = Yacc[o] + val + dsk[g * 16 + hh] * bf2f(up[hh]); YS[(size_t)row * 1024 + 512 + g * 16 + hh] = f2bf(geluf_(y)); } }
        }
    }
}
__global__ void k_moe_zero(int* cnt, int* rowtok) { const int i = blockIdx.x * blockDim.x + threadIdx.x; if (i < 16) cnt[i] = 0; if (i < MOEROWS) rowtok[i] = -1; }
__global__ __launch_bounds__(256) void k_moe_count(const int* tok_e, int* cnt, int* tok_pos) {
    __shared__ int lc[8], lb[8];
    if (threadIdx.x < 8) lc[threadIdx.x] = 0; __syncthreads();
    const int i = blockIdx.x * 256 + threadIdx.x;
    const int e = tok_e[i]; const int lp = atomicAdd(&lc[e], 1); __syncthreads();
    if (threadIdx.x < 8) lb[threadIdx.x] = atomicAdd(&cnt[threadIdx.x], lc[threadIdx.x]); __syncthreads();
    tok_pos[i] = lb[e] + lp;
}
__global__ __launch_bounds__(256) void k_moe_place(const int* tok_e, const int* cnt, const int* tok_pos, int* tok_row, int* rowtok, int* tile_e) {
    int base[9]; base[0] = 0;
#pragma unroll
    for (int e = 0; e < 8; ++e) base[e + 1] = base[e] + ((cnt[e] + 255) & ~255);
    const int i = blockIdx.x * 256 + threadIdx.x; const int e = tok_e[i];
    int bs = 0;
#pragma unroll
    for (int k = 0; k < 8; ++k) if (k == e) bs = base[k];
    const int row = bs + tok_pos[i]; tok_row[i] = row; rowtok[row] = i >> 1;
    if (i < MOETILES) { int te = -1;
#pragma unroll
        for (int k = 0; k < 8; ++k) if (i * 256 >= base[k] && i * 256 < base[k + 1]) te = k;
        tile_e[i] = te; }
}
__global__ __launch_bounds__(256) void k_final(float* h, const float* mod, const float* O, const int* tok_row, const float* tok_w, const float* fg, float* out) {
    const int lane = threadIdx.x & 63; const int t = blockIdx.x * 4 + (threadIdx.x >> 6); const int cond = t / L;
    const float* g2 = mod + (size_t)cond * 6144 + 5 * 1024; const int r1 = tok_row[t * 2], r2 = tok_row[t * 2 + 1]; const float w1 = tok_w[t * 2], w2 = tok_w[t * 2 + 1];
    float4 v[4]; float ss = 0.f;
#pragma unroll
    for (int j = 0; j < 4; ++j) { const int k = j * 256 + lane * 4; const float4 hv = *(const float4*)(h + (size_t)t * D + k), a = *(const float4*)(O + (size_t)r1 * D + k), b = *(const float4*)(O + (size_t)r2 * D + k), gg = *(const float4*)(g2 + k);
        v[j].x = hv.x + gg.x * (w1 * a.x + w2 * b.x); v[j].y = hv.y + gg.y * (w1 * a.y + w2 * b.y); v[j].z = hv.z + gg.z * (w1 * a.z + w2 * b.z); v[j].w = hv.w + gg.w * (w1 * a.w + w2 * b.w);
        ss += v[j].x * v[j].x + v[j].y * v[j].y + v[j].z * v[j].z + v[j].w * v[j].w; }
    ss = wave_sum(ss); const float rstd = rsqrtf(ss * (1.f / D) + EPS);
#pragma unroll
    for (int j = 0; j < 4; ++j) { const int k = j * 256 + lane * 4; const float4 gg = *(const float4*)(fg + k); float4 o; o.x = v[j].x * rstd * gg.x; o.y = v[j].y * rstd * gg.y; o.z = v[j].z * rstd * gg.z; o.w = v[j].w * rstd * gg.w;
        *(float4*)(out + (size_t)t * D + k) = o; }
}
}


namespace mk {
#define LAS __attribute__((address_space(3)))
typedef short bf16x8 __attribute__((ext_vector_type(8)));
typedef float f32x4 __attribute__((ext_vector_type(4)));
typedef float f32x2 __attribute__((ext_vector_type(2)));
typedef unsigned u32x4 __attribute__((ext_vector_type(4)));
typedef unsigned u32x2 __attribute__((ext_vector_type(2)));
constexpr int BK = 64, HTB = 128 * BK * 2, STAGE_BYTES = 8 * HTB;
constexpr int MISC_OFF = STAGE_BYTES + 320, LDS_BYTES = 147456;
constexpr int NPH = 25;

#define XB_TMO      128
#define XB_XCNT(j)  (256  + 64 * (j))
#define XB_XSUB(j)  (1280 + 64 * (j))
#define XB_XGEN(j)  (2304 + 64 * (j))
#define XB_TOP      3328
#define XB_TOPGEN   3392
#define XCD_BAR_WORDS 3456
#define XB_SPIN_CAP (1u << 18)
__device__ __forceinline__ unsigned xb_ld(unsigned* p)              { return __hip_atomic_load(p, __ATOMIC_RELAXED, __HIP_MEMORY_SCOPE_AGENT); }
__device__ __forceinline__ unsigned xb_add(unsigned* p, unsigned v) { return __hip_atomic_fetch_add(p, v, __ATOMIC_RELAXED, __HIP_MEMORY_SCOPE_AGENT); }
__device__ __forceinline__ unsigned xb_xcc_id() { return (unsigned)__builtin_amdgcn_s_getreg((3 << 11) | 20) & 0xFu; }
#define XB_SPIN(cond, bar) do { unsigned _sp = 0; while (cond) { __builtin_amdgcn_s_sleep(1); \
    if ((++_sp & 255u) == 0u) { if (xb_ld(&(bar)[XB_TMO])) break; if (_sp > XB_SPIN_CAP) { atomicAdd(&(bar)[XB_TMO], 1u); break; } } } } while (0)
struct XcdBarrier { unsigned* bar; unsigned x; volatile LAS unsigned* st; };
__device__ __forceinline__ XcdBarrier xcd_barrier_post(unsigned* bar, volatile LAS unsigned* st) {
    XcdBarrier b; b.bar = bar; b.x = xb_xcc_id(); b.st = st;
    if (threadIdx.x == 0) (void)xb_add(&bar[XB_XCNT(b.x)], 1u);
    return b;
}
__device__ __forceinline__ void xcd_barrier_complete(unsigned* bar, unsigned x, unsigned& nloc, unsigned& nx) {
    const unsigned G = gridDim.x * gridDim.y * gridDim.z;
    unsigned sum, cnt, mine, sp = 0u;
    for (;;) {
        sum = 0u; cnt = 0u; mine = 0u;
#pragma unroll
        for (unsigned j = 0; j < 16; ++j) { const unsigned c = xb_ld(&bar[XB_XCNT(j)]); sum += c; cnt += (c > 0u) ? 1u : 0u; mine = (j == x) ? c : mine; }
        if (sum == G) break;
        __builtin_amdgcn_s_sleep(1);
        if ((++sp & 255u) == 0u) { if (xb_ld(&bar[XB_TMO])) break; if (sp > XB_SPIN_CAP) { atomicAdd(&bar[XB_TMO], 1u); break; } }
    }
    nloc = mine > 0u ? mine : 1u; nx = cnt > 0u ? cnt : 1u;
}
__device__ __forceinline__ void xcd_barrier(const XcdBarrier& b) {
    asm volatile("s_waitcnt vmcnt(0)" ::: "memory");
    __syncthreads();
    if (threadIdx.x == 0) {
        unsigned* bar = b.bar;
        __builtin_amdgcn_s_waitcnt(0);
        unsigned nloc = b.st[0], nx = b.st[1];
        if (nloc == 0u) { xcd_barrier_complete(bar, b.x, nloc, nx); b.st[0] = nloc; b.st[1] = nx; }
        const unsigned old = xb_add(&bar[XB_XSUB(b.x)], 1u);
        const unsigned gen = old / nloc;
        if (old + 1u == (gen + 1u) * nloc) {
            __builtin_amdgcn_fence(__ATOMIC_RELEASE, "agent");
            asm volatile("s_waitcnt vmcnt(0)" ::: "memory");
            const unsigned og = xb_add(&bar[XB_TOP], 1u);
            const unsigned tg = og / nx;
            if (og + 1u == (tg + 1u) * nx) xb_add(&bar[XB_TOPGEN], 1u);
            else XB_SPIN(xb_ld(&bar[XB_TOPGEN]) == tg, bar);
            __builtin_amdgcn_fence(__ATOMIC_ACQUIRE, "agent");
            xb_add(&bar[XB_XGEN(b.x)], 1u);
            asm volatile("s_waitcnt vmcnt(0)" ::: "memory");
        } else {
            XB_SPIN(xb_ld(&bar[XB_XGEN(b.x)]) == gen, bar);
            __builtin_amdgcn_fence(__ATOMIC_ACQUIRE, "agent");
            asm volatile("s_waitcnt vmcnt(0)" ::: "memory");
        }
    }
    __syncthreads();
}

__device__ __forceinline__ int lds_byte(int r, int c) { const int st = (r >> 4) * 2 + (c >> 5), rr = r & 15, cc = c & 31, ob = rr * 64 + cc * 2; return st * 1024 + (ob ^ (((ob >> 9) & 1) << 5)); }
__device__ __forceinline__ void stage_rc(int b, int& R, int& C) { const int st = b / 1024, sb = b % 1024, swz = sb ^ (((sb >> 9) & 1) << 5); R = (st >> 1) * 16 + swz / 64; C = (st & 1) * 32 + (swz % 64) / 2; }
__device__ __forceinline__ int perm32(int rho) { const int n = rho >> 4, i = rho & 15; return 8 * (i >> 2) + 4 * n + (i & 3); }
typedef __bf16 bf16x2_t __attribute__((ext_vector_type(2)));
__device__ __forceinline__ unsigned cvt_pk_bf16(float lo, float hi) { const f32x2 v = {lo, hi}; return __builtin_bit_cast(unsigned, __builtin_convertvector(v, bf16x2_t)); }
__device__ __forceinline__ u32x4 pack8(const f32x4 a, const f32x4 b) { u32x4 w; w.x = cvt_pk_bf16(a[0], a[1]); w.y = cvt_pk_bf16(a[2], a[3]); w.z = cvt_pk_bf16(b[0], b[1]); w.w = cvt_pk_bf16(b[2], b[3]); return w; }
__device__ __forceinline__ float bflo(unsigned w) { return __uint_as_float(w << 16); }
__device__ __forceinline__ float bfhi(unsigned w) { return __uint_as_float(w & 0xffff0000u); }
__device__ __forceinline__ void unpack8(const u32x4 w, f32x4& a, f32x4& b) { a[0] = bflo(w.x); a[1] = bfhi(w.x); a[2] = bflo(w.y); a[3] = bfhi(w.y); b[0] = bflo(w.z); b[1] = bfhi(w.z); b[2] = bflo(w.w); b[3] = bfhi(w.w); }
__device__ __forceinline__ float fsigmoid(float v) { return __builtin_amdgcn_rcpf(1.f + __expf(-v)); }
__device__ __forceinline__ float fgelu(float v) { return v * fsigmoid(1.5957691216057308f * (v + 0.044715f * v * v * v)); }

struct Unit { const char* A; const char* B; unsigned lda2, ldb2; int nt, perm, kind, z, pm, pn; };
struct Job { const char* A; const char* B; size_t zA, zB, eB; const LAS int* tlut; unsigned lda2, ldb2; int nt, nM, nN, nZ, perm, kind, pm0, pn0; };
__device__ __forceinline__ Job mkjob(const void* A, const void* B, size_t zA, size_t zB, unsigned lda2, unsigned ldb2, int nt, int nM, int nN, int nZ, int perm, int kind, int pm0, int pn0) {
    Job j; j.A = (const char*)A; j.B = (const char*)B; j.zA = zA; j.zB = zB; j.eB = 0; j.tlut = nullptr; j.lda2 = lda2; j.ldb2 = ldb2; j.nt = nt; j.nM = nM; j.nN = nN; j.nZ = nZ; j.perm = perm; j.kind = kind; j.pm0 = pm0; j.pn0 = pn0; return j; }
template <int NJ> struct JobSched {
    Job j[NJ]; int cnt[NJ]; int total, G, c;
    __device__ __forceinline__ void init(int G_, int c_) { total = 0;
#pragma unroll
        for (int k = 0; k < NJ; ++k) { cnt[k] = j[k].nZ * j[k].nM * j[k].nN; total += cnt[k]; }
        G = G_; c = c_; }
    __device__ __forceinline__ bool next(int i, Unit& u) const {
        const long Lq = (long)i * G + c; if (Lq >= total) return false;
        int w = (int)Lq; { const int q = total / 8, r = total % 8, xcd = w % 8, off = w / 8; w = (xcd < r ? xcd * (q + 1) : r * (q + 1) + (xcd - r) * q) + off; }
        Job J = j[0];
        int ww = w; bool done = false;
#pragma unroll
        for (int k = 0; k < NJ; ++k) { if (!done) { if (ww < cnt[k] || k == NJ - 1) { J = j[k]; done = true; } else ww -= cnt[k]; } }
        const int per = J.nM * J.nN; const int z = ww / per, rem = ww - z * per;
        const int nig = 8 * J.nN, gid = rem / nig, fm = gid * 8, gsz = (J.nM - fm) < 8 ? (J.nM - fm) : 8, rr = rem - gid * nig;
        const int pm = J.pm0 + fm + (rr % gsz), pn = J.pn0 + rr / gsz;
        u.A = J.A + (size_t)z * J.zA + (size_t)pm * 256 * J.lda2;
        u.B = J.B + (size_t)z * J.zB + (size_t)pn * 256 * J.ldb2 + (J.tlut ? (size_t)J.tlut[pm] * J.eB : (size_t)0);
        u.lda2 = J.lda2; u.ldb2 = J.ldb2; u.nt = J.nt; u.perm = J.perm; u.kind = J.kind; u.z = z; u.pm = pm; u.pn = pn;
        { unsigned long long pa = (unsigned long long)u.A, pb = (unsigned long long)u.B;
          pa = ((unsigned long long)(unsigned)__builtin_amdgcn_readfirstlane((int)(pa >> 32)) << 32) | (unsigned)__builtin_amdgcn_readfirstlane((int)(unsigned)pa);
          pb = ((unsigned long long)(unsigned)__builtin_amdgcn_readfirstlane((int)(pb >> 32)) << 32) | (unsigned)__builtin_amdgcn_readfirstlane((int)(unsigned)pb);
          u.A = (const char*)pa; u.B = (const char*)pb; u.lda2 = (unsigned)__builtin_amdgcn_readfirstlane((int)u.lda2); u.ldb2 = (unsigned)__builtin_amdgcn_readfirstlane((int)u.ldb2);
          u.nt = __builtin_amdgcn_readfirstlane(u.nt); u.perm = __builtin_amdgcn_readfirstlane(u.perm); u.kind = __builtin_amdgcn_readfirstlane(u.kind); u.z = __builtin_amdgcn_readfirstlane(u.z);
          u.pm = __builtin_amdgcn_readfirstlane(u.pm); u.pn = __builtin_amdgcn_readfirstlane(u.pn); }
        return true;
    }
};

template <class Epi, class Sched>
__device__ __forceinline__ void gemm_phase(LAS unsigned char* lds, const Sched& S, const Epi& E) {
    int tid = threadIdx.x; asm volatile("" : "+v"(tid));
    const int wid = __builtin_amdgcn_readfirstlane(tid >> 6), lane = tid & 63, wr = wid >> 2, wc = wid & 3, fr = lane & 15, fq = lane >> 4;
    int R0, C0; stage_rc(tid * 16, R0, C0);
    const int Rp0 = (R0 & ~31) + perm32(R0 & 31);
    const unsigned ldsw = (unsigned)wid * 1024u;
    const int aoff = lds_byte(wr * 64 + fr, fq * 8), boff = lds_byte(wc * 32 + fr, fq * 8);
#define G_SA(b, h) (((b) * 2 + (h)) * HTB)
#define G_SB(b, h) ((4 + (b) * 2 + (h)) * HTB)
#define G_STAGE(bufoff, gbase, v0, s64) do { \
        __builtin_amdgcn_global_load_lds((const unsigned*)((const char*)(gbase) + (v0)), (LAS unsigned*)(lds + (bufoff) + ldsw), 16, 0, 0); \
        __builtin_amdgcn_global_load_lds((const unsigned*)((const char*)(gbase) + (s64) + (v0)), (LAS unsigned*)(lds + (bufoff) + ldsw + 8192), 16, 0, 0); } while (0)
#define G_LDA(dst, b, h) do { _Pragma("unroll") for (int m = 0; m < 4; ++m) _Pragma("unroll") for (int k = 0; k < 2; ++k) dst[m][k] = *(const LAS bf16x8*)(lds + G_SA(b, h) + aoff + m * 2048 + k * 1024); } while (0)
#define G_LDB(dst, b, h) do { _Pragma("unroll") for (int n = 0; n < 2; ++n) _Pragma("unroll") for (int k = 0; k < 2; ++k) dst[n][k] = *(const LAS bf16x8*)(lds + G_SB(b, h) + boff + n * 2048 + k * 1024); } while (0)
#define G_MMA(ai, bj, At, Bt) do { __builtin_amdgcn_s_setprio(1); _Pragma("unroll") for (int m = 0; m < 4; ++m) _Pragma("unroll") for (int n = 0; n < 2; ++n) _Pragma("unroll") for (int k = 0; k < 2; ++k) \
        acc[ai][bj][m][n] = __builtin_amdgcn_mfma_f32_16x16x32_bf16(Bt[n][k], At[m][k], acc[ai][bj][m][n], 0, 0, 0); __builtin_amdgcn_s_setprio(0); } while (0)
#define G_WAIT_V(n) asm volatile("s_waitcnt vmcnt(" #n ")" ::: "memory")
#define G_WAIT_L(n) asm volatile("s_waitcnt lgkmcnt(" #n ")" ::: "memory")
#define G_BAR __builtin_amdgcn_s_barrier()
#define G_SCHED __builtin_amdgcn_sched_barrier(0)
#define G_VOFF(u, a0, b0, ha, hb) do { a0 = (unsigned)R0 * (u).lda2 + (unsigned)C0 * 2u; b0 = (unsigned)((u).perm ? Rp0 : R0) * (u).ldb2 + (unsigned)C0 * 2u; ha = 128u * (u).lda2; hb = 128u * (u).ldb2; } while (0)
    Unit cur, nxt; int ui = 0;
    if (!S.next(0, cur)) return;
    f32x4 acc[2][2][4][2];
#pragma unroll
    for (int a = 0; a < 2; ++a)
#pragma unroll
        for (int b = 0; b < 2; ++b)
#pragma unroll
            for (int m = 0; m < 4; ++m)
#pragma unroll
                for (int n = 0; n < 2; ++n) acc[a][b][m][n] = (f32x4){0.f, 0.f, 0.f, 0.f};
    bf16x8 At[4][2], B0[2][2], B1[2][2];
    unsigned vA, vB, hA, hB; G_VOFF(cur, vA, vB, hA, hB);
    const char* cA = cur.A; const char* cB = cur.B;
    const size_t kstep = 128;
    G_STAGE(G_SB(0, 0), cB, vB, hB / 2); G_STAGE(G_SB(0, 1), cB + hB, vB, hB / 2); G_STAGE(G_SA(0, 0), cA, vA, hA / 2); G_STAGE(G_SA(0, 1), cA + hA, vA, hA / 2);
    if (wr == 1) G_BAR;
    G_WAIT_V(2); G_BAR;
    G_STAGE(G_SB(1, 0), cB + kstep, vB, hB / 2); G_STAGE(G_SA(1, 0), cA + kstep, vA, hA / 2); G_STAGE(G_SB(1, 1), cB + hB + kstep, vB, hB / 2);
    G_WAIT_V(6); G_BAR;
    for (;;) {
        const bool has_next = S.next(ui + 1, nxt);
        unsigned nvA = vA, nvB = vB, nhA = hA, nhB = hB; const char* nA = cA; const char* nB = cB;
        if (has_next) { G_VOFF(nxt, nvA, nvB, nhA, nhB); nA = nxt.A; nB = nxt.B; }
        const int nt = cur.nt;
        for (int t = 0; t < nt; t += 2) {
            const bool last = (t == nt - 2);
            const char* a1 = cA + (size_t)(t + 1) * kstep;
            const char* a2 = last ? nA : cA + (size_t)(t + 2) * kstep; const char* b2 = last ? nB : cB + (size_t)(t + 2) * kstep;
            const char* a3 = a2 + kstep; const char* b3 = b2 + kstep;
            const unsigned xA = last ? nvA : vA, xB = last ? nvB : vB, xhA = last ? nhA : hA, xhB = last ? nhB : hB;
            G_LDB(B0, 0, 0); G_LDB(B1, 0, 1); G_SCHED; G_LDA(At, 0, 0); G_STAGE(G_SA(1, 1), a1 + hA, vA, hA / 2);
            G_WAIT_V(8); G_WAIT_L(0); G_BAR; G_MMA(0, 0, At, B0); G_MMA(0, 1, At, B1); G_BAR; G_SCHED;
            G_LDA(At, 0, 1); G_STAGE(G_SB(0, 0), b2, xB, xhB / 2); G_STAGE(G_SB(0, 1), b2 + xhB, xB, xhB / 2); G_STAGE(G_SA(0, 0), a2, xA, xhA / 2);
            G_WAIT_V(8); G_WAIT_L(0); G_BAR; G_MMA(1, 0, At, B0); G_MMA(1, 1, At, B1); G_BAR; G_SCHED;
            G_LDB(B0, 1, 0); G_LDB(B1, 1, 1); G_SCHED; G_LDA(At, 1, 0); G_STAGE(G_SA(0, 1), a2 + xhA, xA, xhA / 2);
            G_WAIT_V(8); G_WAIT_L(0); G_BAR; G_MMA(0, 0, At, B0); G_MMA(0, 1, At, B1); G_BAR; G_SCHED;
            G_LDA(At, 1, 1); G_STAGE(G_SB(1, 0), b3, xB, xhB / 2); G_STAGE(G_SB(1, 1), b3 + xhB, xB, xhB / 2); G_STAGE(G_SA(1, 0), a3, xA, xhA / 2);
            G_WAIT_V(8); G_WAIT_L(0); G_BAR; G_MMA(1, 0, At, B0); G_MMA(1, 1, At, B1); G_BAR; G_SCHED;
        }
        if (wr == 0) G_BAR;
        E(acc, cur, wr, wc, fr, fq);
        if (!has_next) break;
#pragma unroll
        for (int a = 0; a < 2; ++a)
#pragma unroll
            for (int b = 0; b < 2; ++b)
#pragma unroll
                for (int m = 0; m < 4; ++m)
#pragma unroll
                    for (int n = 0; n < 2; ++n) acc[a][b][m][n] = (f32x4){0.f, 0.f, 0.f, 0.f};
        cur = nxt; cA = nA; cB = nB; vA = nvA; vB = nvB; hA = nhA; hB = nhB; ++ui;
        if (wr == 1) G_BAR;
    }
    G_WAIT_V(0);
    G_BAR;
#undef G_SA
#undef G_SB
#undef G_STAGE
#undef G_LDA
#undef G_LDB
#undef G_MMA
#undef G_WAIT_V
#undef G_WAIT_L
#undef G_BAR
#undef G_SCHED
#undef G_VOFF
}

#define EPI_ARGS const f32x4 (&acc)[2][2][4][2], const Unit& u, int wr, int wc, int fr, int fq
struct EpiInproj {
    bf16_t* UX; bf16_t* GT; bf16_t* VL; bf16_t* VC;
    __device__ __forceinline__ void operator()(EPI_ARGS) const {
        const int rb = u.pm * 256 + wr * 64 + fr, cb = u.pn * 256 + wc * 32 + 8 * fq;
#pragma unroll
        for (int ai = 0; ai < 2; ++ai)
#pragma unroll
            for (int m = 0; m < 4; ++m) { const int r = rb + ai * 128 + m * 16;
#pragma unroll
                for (int bj = 0; bj < 2; ++bj) { const int c0 = cb + bj * 128; f32x4 v0 = acc[ai][bj][m][0], v1 = acc[ai][bj][m][1];
                    if (u.kind == 0) {
                        if (u.pn < 2) { *(u32x4*)(UX + ux_index(c0 >> 4, r, c0 & 15)) = pack8(v0, v1); }
                        else {
#pragma unroll
                            for (int j = 0; j < 4; ++j) { v0[j] = fsigmoid(v0[j]); v1[j] = fsigmoid(v1[j]); }
                            *(u32x4*)(GT + (size_t)r * 2048 + (c0 - 512)) = pack8(v0, v1); }
                    } else { bf16_t* dst = (c0 < TC ? VC : VL) + vt2_index(c0, r & 511, r >> 9); *(u32x4*)dst = pack8(v0, v1); }
                } }
    }
};
struct EpiP3 {
    bf16_t* YS; float* S; float sl, sc;
    __device__ __forceinline__ void operator()(EPI_ARGS) const {
        const int rb = u.pm * 256 + wr * 64 + fr;
        if (u.kind == 2) { const int cb = wc * 32 + 4 * fq;
#pragma unroll
            for (int ai = 0; ai < 2; ++ai)
#pragma unroll
                for (int m = 0; m < 4; ++m) { float* rowp = S + ((size_t)u.z * CHR + rb + ai * 128 + m * 16) * 256 + cb;
#pragma unroll
                    for (int bj = 0; bj < 2; ++bj)
#pragma unroll
                        for (int n = 0; n < 2; ++n) *(f32x4*)(rowp + bj * 128 + n * 16) = acc[ai][bj][m][n]; }
        } else { const int cb = u.pn * 256 + wc * 32 + 8 * fq; const float s = u.kind == 0 ? sl : sc; const size_t row0 = u.kind == 0 ? (size_t)TC + (size_t)u.z * L : (size_t)u.z * LC;
#pragma unroll
            for (int ai = 0; ai < 2; ++ai)
#pragma unroll
                for (int m = 0; m < 4; ++m) { bf16_t* rowp = YS + (row0 + rb + ai * 128 + m * 16) * 1024 + cb;
#pragma unroll
                    for (int bj = 0; bj < 2; ++bj) *(u32x4*)(rowp + bj * 128) = pack8(acc[ai][bj][m][0] * s, acc[ai][bj][m][1] * s); }
        }
    }
};
struct EpiP5 {
    bf16_t* YS; const bf16_t* GT; bf16_t* TM;
    __device__ __forceinline__ void operator()(EPI_ARGS) const {
        const int rb = u.pm * 256 + wr * 64 + fr, cb = u.pn * 256 + wc * 32 + 8 * fq;
#pragma unroll
        for (int ai = 0; ai < 2; ++ai)
#pragma unroll
            for (int m = 0; m < 4; ++m) { const int r = rb + ai * 128 + m * 16;
#pragma unroll
                for (int bj = 0; bj < 2; ++bj) { const int c0 = cb + bj * 128; f32x4 v0 = acc[ai][bj][m][0], v1 = acc[ai][bj][m][1];
                    if (u.kind == 0) {
#pragma unroll
                        for (int j = 0; j < 4; ++j) { v0[j] = fgelu(v0[j]); v1[j] = fgelu(v1[j]); }
                        *(u32x4*)(YS + ((size_t)r * 16 + (c0 >> 4)) * 1024 + 512 + u.z * 16 + (c0 & 15)) = pack8(v0, v1);
                    } else { f32x4 g0, g1; unpack8(*(const u32x4*)(GT + (size_t)r * 2048 + c0), g0, g1); *(u32x4*)(TM + (size_t)r * 1024 + c0) = pack8(v0 * g0, v1 * g1); }
                } }
    }
};
struct EpiGlu {
    const bf16_t* GT; bf16_t* TM;
    __device__ __forceinline__ void operator()(EPI_ARGS) const {
        const int rb = u.pm * 256 + wr * 64 + fr, c0 = u.pn * 128 + wc * 32 + 8 * fq;
#pragma unroll
        for (int ai = 0; ai < 2; ++ai)
#pragma unroll
            for (int m = 0; m < 4; ++m) { const int r = rb + ai * 128 + m * 16;
                f32x4 g0, g1, t0, t1; unpack8(*(const u32x4*)(GT + (size_t)r * 2048 + 1024 + c0), g0, g1); unpack8(*(const u32x4*)(TM + (size_t)r * 1024 + c0), t0, t1);
                f32x4 a0 = acc[ai][0][m][0], a1 = acc[ai][0][m][1], b0 = acc[ai][1][m][0], b1 = acc[ai][1][m][1];
#pragma unroll
                for (int j = 0; j < 4; ++j) { t0[j] += g0[j] * a0[j] * fsigmoid(b0[j]); t1[j] += g1[j] * a1[j] * fsigmoid(b1[j]); }
                *(u32x4*)(TM + (size_t)r * 1024 + c0) = pack8(t0, t1); }
    }
};
struct EpiRes {
    float* h; float* z; const float* mod; int gidx;
    __device__ __forceinline__ void operator()(EPI_ARGS) const {
        const int rb = u.pm * 256 + wr * 64 + fr, cb = u.pn * 256 + wc * 32 + 4 * fq;
#pragma unroll
        for (int ai = 0; ai < 2; ++ai)
#pragma unroll
            for (int m = 0; m < 4; ++m) { const int r = rb + ai * 128 + m * 16; float* rowp = (r < TC ? z + (size_t)r * D : h + (size_t)(r - TC) * D) + cb;
                const float* gp = mod + (size_t)(r < TC ? 16 : (r - TC) >> 11) * 6144 + gidx * 1024 + cb;
#pragma unroll
                for (int bj = 0; bj < 2; ++bj)
#pragma unroll
                    for (int n = 0; n < 2; ++n) { const f32x4 gg = *(const f32x4*)(gp + bj * 128 + n * 16); f32x4 o = *(const f32x4*)(rowp + bj * 128 + n * 16); o += gg * acc[ai][bj][m][n]; *(f32x4*)(rowp + bj * 128 + n * 16) = o; }
                asm volatile("" ::: "memory"); }
    }
};
struct EpiSwiglu {
    bf16_t* H; int ld; int row0;
    __device__ __forceinline__ void operator()(EPI_ARGS) const {
        const int rb = u.pm * 256 + wr * 64 + fr - row0, c0 = u.pn * 128 + wc * 32 + 8 * fq;
#pragma unroll
        for (int ai = 0; ai < 2; ++ai)
#pragma unroll
            for (int m = 0; m < 4; ++m) { const int r = rb + ai * 128 + m * 16;
                f32x4 a0 = acc[ai][0][m][0], a1 = acc[ai][0][m][1]; const f32x4 b0 = acc[ai][1][m][0], b1 = acc[ai][1][m][1];
#pragma unroll
                for (int j = 0; j < 4; ++j) { a0[j] = a0[j] * fsigmoid(a0[j]) * b0[j]; a1[j] = a1[j] * fsigmoid(a1[j]) * b1[j]; }
                *(u32x4*)(H + (size_t)r * ld + c0) = pack8(a0, a1); }
    }
};
struct EpiBf {
    bf16_t* O; int ld;
    __device__ __forceinline__ void operator()(EPI_ARGS) const {
        const int rb = u.pm * 256 + wr * 64 + fr, cb = u.pn * 256 + wc * 32 + 8 * fq;
#pragma unroll
        for (int ai = 0; ai < 2; ++ai)
#pragma unroll
            for (int m = 0; m < 4; ++m) { bf16_t* rowp = O + (size_t)(rb + ai * 128 + m * 16) * ld + cb;
#pragma unroll
                for (int bj = 0; bj < 2; ++bj) *(u32x4*)(rowp + bj * 128) = pack8(acc[ai][bj][m][0], acc[ai][bj][m][1]); }
    }
};

struct Args { const float* in[30]; float* out; unsigned char* ws; int ph_lo, ph_hi, mask, pad; };
enum { I_X, I_C, I_CTX, I_CCTX, I_WMOD, I_BMOD, I_N1G, I_N2G, I_WIN, I_WFOUR, I_ARE, I_AIM, I_LOGDT, I_BRE, I_BIM, I_CRE, I_CIM, I_SSMD, I_GLUA, I_GLUB, I_WOUT, I_FG, I_FU, I_FD, I_MR, I_MBR, I_MG, I_MU, I_MD, I_FINALG };

__device__ __forceinline__ void tr_item(const float* W, int ldw, int k0, int n0, bf16_t* WT, int ldk, int drow0, LAS float* scr, int lane) {
#pragma unroll 8
    for (int i = 0; i < 32; ++i) { const int kk = 2 * i + (lane >> 5); scr[kk * 33 + (lane & 31)] = W[(size_t)(k0 + kk) * ldw + n0 + (lane & 31)]; }
    asm volatile("s_waitcnt lgkmcnt(0)" ::: "memory");
    const int c = lane & 7;
#pragma unroll
    for (int j = 0; j < 4; ++j) { const int n = (lane >> 3) + 8 * j; const LAS float* s = scr + (8 * c) * 33 + n;
        u32x4 o; o.x = cvt_pk_bf16(s[0 * 33], s[1 * 33]); o.y = cvt_pk_bf16(s[2 * 33], s[3 * 33]); o.z = cvt_pk_bf16(s[4 * 33], s[5 * 33]); o.w = cvt_pk_bf16(s[6 * 33], s[7 * 33]);
        *(u32x4*)(WT + (size_t)(drow0 + n) * ldk + k0 + 8 * c) = o; }
    asm volatile("s_waitcnt lgkmcnt(0)" ::: "memory");
}
__device__ __forceinline__ void tr_mat_item(const float* W, int K, int N, int ldw, int coff, bf16_t* WT, int roff, int mode, int it, LAS float* scr, int lane) {
    const int nblk = N / 32, kb = it / nblk, nb = it - kb * nblk, n0 = nb * 32;
    const int drow = mode == 0 ? roff + n0 : ((n0 >> 7) * 256 + (mode == 2 ? 128 : 0) + (n0 & 127));
    tr_item(W, ldw, kb * 64, coff + n0, WT, K, drow, scr, lane);
}

template <bool ROUTE>
__device__ __forceinline__ void norm_row(const float* src, const float* g, const float* sh, const float* sc, bf16_t* dst, int lane, const float* wr, const float* br, int& e1o, int& e2o, float& w1o) {
    f32x4 v[4]; float ss = 0.f;
#pragma unroll
    for (int j = 0; j < 4; ++j) { v[j] = *(const f32x4*)(src + j * 256 + lane * 4); ss += v[j][0] * v[j][0] + v[j][1] * v[j][1] + v[j][2] * v[j][2] + v[j][3] * v[j][3]; }
    ss = wave_sum(ss); const float rstd = rsqrtf(ss * (1.f / D) + EPS);
    float lg[8];
#pragma unroll
    for (int e = 0; e < 8; ++e) lg[e] = 0.f;
#pragma unroll
    for (int j = 0; j < 4; ++j) { const int k = j * 256 + lane * 4; const f32x4 gg = *(const f32x4*)(g + k), s1 = *(const f32x4*)(sc + k), s0 = *(const f32x4*)(sh + k);
        f32x4 a;
#pragma unroll
        for (int q = 0; q < 4; ++q) a[q] = v[j][q] * rstd * gg[q] * (1.f + s1[q]) + s0[q];
        u32x2 o; o.x = cvt_pk_bf16(a[0], a[1]); o.y = cvt_pk_bf16(a[2], a[3]); *(u32x2*)(dst + k) = o;
        if (ROUTE) {
#pragma unroll
            for (int q = 0; q < 4; ++q) { const f32x4 w0 = *(const f32x4*)(wr + (k + q) * 8), w1 = *(const f32x4*)(wr + (k + q) * 8 + 4);
#pragma unroll
                for (int e = 0; e < 4; ++e) { lg[e] += a[q] * w0[e]; lg[4 + e] += a[q] * w1[e]; } } } }
    if (ROUTE) {
#pragma unroll
        for (int e = 0; e < 8; ++e) lg[e] = wave_sum(lg[e]) + br[e];
        int e1 = 0; float v1 = lg[0];
#pragma unroll
        for (int e = 1; e < 8; ++e) if (lg[e] > v1) { v1 = lg[e]; e1 = e; }
        int e2 = -1; float v2 = -3.0e38f;
#pragma unroll
        for (int e = 0; e < 8; ++e) if (e != e1 && lg[e] > v2) { v2 = lg[e]; e2 = e; }
        e1o = e1; e2o = e2; w1o = 1.f / (1.f + expf(v2 - v1));
    }
}

__global__ void __launch_bounds__(512, 2) fwd(Args args) {
    extern __shared__ __attribute__((aligned(16))) unsigned char lds_raw[];
    LAS unsigned char* lds = (LAS unsigned char*)lds_raw;
    volatile LAS unsigned* MISC = (volatile LAS unsigned*)(lds + MISC_OFF);
    const int G = gridDim.x, bx = blockIdx.x, NGW = G * 8;
#define PHASE_IDS int tid = threadIdx.x; asm volatile("" : "+v"(tid)); const int lane = tid & 63, wave = __builtin_amdgcn_readfirstlane(tid >> 6), gw = bx * 8 + wave; (void)lane; (void)gw;
    unsigned char* ws = args.ws;
    unsigned* ctl = (unsigned*)(ws + WS_CTL);
    const int lo = args.ph_lo, hi = args.ph_hi, mask = args.mask;
    { PHASE_IDS for (int u = tid; u < (LDS_BYTES - STAGE_BYTES) / 4; u += 512) ((LAS unsigned*)(lds + STAGE_BYTES))[u] = 0u; }
    __syncthreads();
    XcdBarrier bar; bar.bar = ctl + CW_BAR; bar.x = 0; bar.st = nullptr;
    if (hi - lo > 1) bar = xcd_barrier_post(ctl + CW_BAR, MISC + 8);
#ifndef ONLYPH
#define ONLYPH -1
#endif
#define PHON(k) (ONLYPH < 0 || ONLYPH == (k))
#define IN(k) (lo <= (k) && (k) < hi)
#define SEAM(k) do { if (lo <= (k) && (k) + 1 < hi) xcd_barrier(bar); } while (0)

#define h (args.out)
#define zs ((float*)(ws + WS_Z))
#define mod ((float*)(ws + WS_MOD))
#define XA ((bf16_t*)(ws + WS_XA))
#define YS ((bf16_t*)(ws + WS_YS))
#define UX ((bf16_t*)(ws + WS_UX))
#define GT ((bf16_t*)(ws + WS_GT))
#define VL ((bf16_t*)(ws + WS_VT2L))
#define VC ((bf16_t*)(ws + WS_VT2C))
#define Sst ((float*)(ws + WS_S))
#define TM ((bf16_t*)(ws + WS_TM))
#define HID ((bf16_t*)(ws + WS_HID))
#define cnt ((int*)(ctl + CW_CNT))
#define tok_e ((int*)(ws + WS_TOKE))
#define tok_w ((float*)(ws + WS_TOKW))
#define tok_pos ((int*)(ws + WS_TOKPOS))
#define tok_row ((int*)(ws + WS_TOKROW))
#define tile_e ((int*)(ws + WS_TILEE))

    if (IN(0)) { PHASE_IDS
        LAS float* scr = (LAS float*)(lds + wave * 8448);
        if (bx < 64) {
            const int l = bx >> 5, g = bx & 31;
            LAS float* POWr = (LAS float*)(lds); LAS float* POWi = POWr + 2 * 64 * 17; LAS float* Bbr = POWi + 2 * 64 * 17; LAS float* Bbi = Bbr + 2048; LAS float* Cr = Bbi + 2048; LAS float* Ci = Cr + 2048; LAS float* Kt = Ci + 2048;
            if (tid < 128) { const int dir = tid >> 6, p = tid & 63; const int gp = ((l * 2 + dir) * 32 + g) * 64 + p;
                const float ar = args.in[I_ARE][gp], ai = args.in[I_AIM][gp], dt = expf(args.in[I_LOGDT][(l * 2 + dir) * 32 + g]); const float lr = ar * dt, li = ai * dt;
                for (int e = 0; e <= 16; ++e) { const float mg = expf(lr * e); POWr[(dir * 64 + p) * 17 + e] = mg * cosf(li * e); POWi[(dir * 64 + p) * 17 + e] = mg * sinf(li * e); }
                const float lbr = POWr[(dir * 64 + p) * 17 + 1], lbi = POWi[(dir * 64 + p) * 17 + 1];
                const float nr = lbr - 1.f, ni = lbi, den = ar * ar + ai * ai, qr = (nr * ar + ni * ai) / den, qi = (ni * ar - nr * ai) / den;
                for (int hh = 0; hh < 16; ++hh) { const float x0 = args.in[I_BRE][(size_t)gp * 16 + hh], x1 = args.in[I_BIM][(size_t)gp * 16 + hh]; Bbr[(dir * 64 + p) * 16 + hh] = qr * x0 - qi * x1; Bbi[(dir * 64 + p) * 16 + hh] = qr * x1 + qi * x0;
                    const size_t ci = ((size_t)((l * 2 + dir) * 32 + g) * 16 + hh) * 64 + p; Cr[(dir * 16 + hh) * 64 + p] = args.in[I_CRE][ci]; Ci[(dir * 16 + hh) * 64 + p] = args.in[I_CIM][ci]; }
                float* lamq = (float*)(ws + WS_LAMQ) + (size_t)gp * 2; lamq[0] = POWr[(dir * 64 + p) * 17 + 16]; lamq[1] = POWi[(dir * 64 + p) * 17 + 16];
            }
            __syncthreads();
            for (int o = tid; o < 8192; o += 512) { const int dir = o >> 12, tau = (o >> 8) & 15, hh = (o >> 4) & 15, h2 = o & 15; float s = 0.f;
                for (int p = 0; p < 64; ++p) { const float pr = POWr[(dir * 64 + p) * 17 + tau], pi = POWi[(dir * 64 + p) * 17 + tau], br_ = Bbr[(dir * 64 + p) * 16 + h2], bi_ = Bbi[(dir * 64 + p) * 16 + h2];
                    const float wr_ = pr * br_ - pi * bi_, wi_ = pr * bi_ + pi * br_; s += Cr[(dir * 16 + hh) * 64 + p] * wr_ - Ci[(dir * 16 + hh) * 64 + p] * wi_; }
                Kt[o] = s; }
            __syncthreads();
            bf16_t* TG = (bf16_t*)(ws + WS_S5TG + (size_t)l * S5_LSTRIDE) + (size_t)g * 256 * 512; bf16_t* EE = (bf16_t*)(ws + WS_S5E + (size_t)l * S5_LSTRIDE) + (size_t)g * 256 * 256;
            const float* dsk = args.in[I_SSMD] + l * 512 + g * 16;
            for (int o = tid; o < 256 * 512; o += 512) { const int row = o >> 9, k = o & 511, t = row >> 4, hh = row & 15; float val;
                if (k < 256) { const int s = k >> 4, h2 = k & 15; val = 0.f; if (s <= t) val += Kt[((0 * 16 + (t - s)) * 16 + hh) * 16 + h2]; if (s >= t) val += Kt[((1 * 16 + (s - t)) * 16 + hh) * 16 + h2]; if (s == t && hh == h2) val += dsk[hh]; }
                else { const int kk = k - 256, dir = kk >> 7, p = (kk >> 1) & 63, ri = kk & 1, e = dir == 0 ? t + 1 : 16 - t; const float cr = Cr[(dir * 16 + hh) * 64 + p], ci = Ci[(dir * 16 + hh) * 64 + p], pr = POWr[(dir * 64 + p) * 17 + e], pi = POWi[(dir * 64 + p) * 17 + e];
                    val = ri == 0 ? (cr * pr - ci * pi) : -(cr * pi + ci * pr); }
                TG[o] = f2bf(val); }
            for (int o = tid; o < 256 * 256; o += 512) { const int row = o >> 8, k = o & 255, dir = row >> 7, p = (row >> 1) & 63, ri = row & 1, s = k >> 4, h2 = k & 15, e = dir == 0 ? 15 - s : s;
                const float pr = POWr[(dir * 64 + p) * 17 + e], pi = POWi[(dir * 64 + p) * 17 + e], br_ = Bbr[(dir * 64 + p) * 16 + h2], bi_ = Bbi[(dir * 64 + p) * 16 + h2];
                EE[o] = f2bf(ri == 0 ? (pr * br_ - pi * bi_) : (pr * bi_ + pi * br_)); }
            __syncthreads();
        } else if (bx < 160) {
            const int it = bx - 64, l = it / 48, cb = it % 48; LAS float* sl = (LAS float*)(lds); LAS float* part = sl + 17 * 1024;
            for (int o = tid; o < 17 * 1024; o += 512) { const int r = o >> 10, k = o & 1023; const float v = r < 16 ? args.in[I_C][r * D + k] : args.in[I_CCTX][k]; sl[o] = v / (1.f + expf(-v)); }
            __syncthreads();
            const int col = cb * 128 + (tid & 127), kq = tid >> 7; const float* w = args.in[I_WMOD] + (size_t)l * D * 6144 + col;
            float a[17];
#pragma unroll
            for (int r = 0; r < 17; ++r) a[r] = 0.f;
            for (int k = kq * 256; k < kq * 256 + 256; ++k) { const float wv = w[(size_t)k * 6144];
#pragma unroll
                for (int r = 0; r < 17; ++r) a[r] += sl[r * 1024 + k] * wv; }
#pragma unroll
            for (int r = 0; r < 17; ++r) part[(kq * 17 + r) * 128 + (tid & 127)] = a[r];
            __syncthreads();
            for (int o = tid; o < 17 * 128; o += 512) { const int r = o >> 7, c = o & 127; const float s = part[(0 * 17 + r) * 128 + c] + part[(1 * 17 + r) * 128 + c] + part[(2 * 17 + r) * 128 + c] + part[(3 * 17 + r) * 128 + c];
                mod[((size_t)l * 17 + r) * 6144 + cb * 128 + c] = s + args.in[I_BMOD][l * 6144 + cb * 128 + c]; }
            __syncthreads();
        }
        { bf16_t* DL = (bf16_t*)(ws + WS_DFTL); bf16_t* DC = (bf16_t*)(ws + WS_DFTC);
          for (int o = bx * 512 + tid; o < 2048 * 512 + 256 * 64; o += G * 512) { const bool big = o < 2048 * 512; const int oo = big ? o : o - 2048 * 512; const int LL = big ? 2048 : 256, per = big ? 512 : 64;
              const int n = oo / per, k0 = (oo - n * per) * 8; const bool sn = k0 >= LL; const int kb = sn ? k0 - LL : k0; unsigned w[4];
#pragma unroll
              for (int q = 0; q < 4; ++q) { float v2[2];
#pragma unroll
                  for (int e = 0; e < 2; ++e) { const int idx = (n * (kb + 2 * q + e)) & (LL - 1); const float a = (float)idx * (2.0f / (float)LL); v2[e] = sn ? -sinpif(a) : cospif(a); }
                  w[q] = cvt_pk_bf16(v2[0], v2[1]); }
              u32x4 o4; o4.x = w[0]; o4.y = w[1]; o4.z = w[2]; o4.w = w[3]; *(u32x4*)((big ? DL : DC) + (size_t)n * (2 * LL) + k0) = o4; } }
        { LAS float* ct = (LAS float*)(lds + 67584);
          if (tid < 256) ct[tid] = tid < 128 ? cospif((float)tid / 64.f) : sinpif((float)(tid - 128) / 64.f);
          __syncthreads();
          for (int o = bx * 512 + tid; o < 2 * 1024 * 1024; o += G * 512) { const int l = o >> 20, j = (o >> 10) & 1023, k = o & 1023, type = j >> 9, g = (j >> 7) & 3, kp = j & 127;
              const float* wrow = args.in[I_WIN] + (size_t)l * D * INC + (size_t)k * INC + g * 128; float s = 0.f;
#pragma unroll 4
              for (int c = 0; c < 128; c += 4) { const f32x4 wv = *(const f32x4*)(wrow + c);
#pragma unroll
                  for (int q = 0; q < 4; ++q) s += wv[q] * ct[type * 128 + (((c + q) * kp) & 127)]; }
              ((bf16_t*)(ws + WS_MIXW + (size_t)l * MIXW_LSTRIDE))[(size_t)j * 1024 + k] = f2bf(s); } }
        { constexpr int I_SG = 16 * 80, I_4 = 8 * 32, I_GL = 8 * 32, I_O = 16 * 32, PERL = I_SG + I_4 + 2 * I_GL + I_O, I_FGU = 16 * 88, I_FDN = 44 * 32, NIT = 2 * PERL + 2 * I_FGU + I_FDN;
          for (int it = gw; it < NIT; it += NGW) { int r = it;
              if (r < 2 * PERL) { const int l = r / PERL; r -= l * PERL; unsigned char* mw = ws + WS_MIXW + (size_t)l * MIXW_LSTRIDE;
                  if (r < I_SG) { tr_mat_item(args.in[I_WIN] + (size_t)l * D * INC, 1024, 2560, INC, 512, (bf16_t*)(mw + 2 * MiB), 0, 0, r, scr, lane); continue; } r -= I_SG;
                  if (r < I_4) { tr_mat_item(args.in[I_WFOUR] + (size_t)l * 512 * D, 512, 1024, D, 0, (bf16_t*)(mw + 7 * MiB), 0, 0, r, scr, lane); continue; } r -= I_4;
                  if (r < I_GL) { tr_mat_item(args.in[I_GLUA] + (size_t)l * 512 * D, 512, 1024, D, 0, (bf16_t*)(mw + 8 * MiB), 0, 1, r, scr, lane); continue; } r -= I_GL;
                  if (r < I_GL) { tr_mat_item(args.in[I_GLUB] + (size_t)l * 512 * D, 512, 1024, D, 0, (bf16_t*)(mw + 8 * MiB), 0, 2, r, scr, lane); continue; } r -= I_GL;
                  tr_mat_item(args.in[I_WOUT] + (size_t)l * D * D, 1024, 1024, D, 0, (bf16_t*)(mw + 10 * MiB), 0, 0, r, scr, lane); continue; }
              r -= 2 * PERL;
              if (r < I_FGU) { tr_mat_item(args.in[I_FG], 1024, DFF, DFF, 0, (bf16_t*)(ws + WS_WGU), 0, 1, r, scr, lane); continue; } r -= I_FGU;
              if (r < I_FGU) { tr_mat_item(args.in[I_FU], 1024, DFF, DFF, 0, (bf16_t*)(ws + WS_WGU), 0, 2, r, scr, lane); continue; } r -= I_FGU;
              tr_mat_item(args.in[I_FD], DFF, 1024, D, 0, (bf16_t*)(ws + WS_WDN), 0, 0, r, scr, lane); } }
        for (int o = bx * 512 + tid; o < L * 256; o += G * 512) { const int n = o >> 8, d0 = (o & 255) * 4; const int q = d0 >> 8; const float base = q < 2 ? (float)(n >> 6) : (float)(n & 63); f32x4 pv;
#pragma unroll
            for (int e = 0; e < 4; ++e) { const float omega = 1.0f / powf(10000.f, (float)((d0 + e) & 255) / 256.f); const float ang = base * omega; pv[e] = (q & 1) ? cosf(ang) : sinf(ang); }
#pragma unroll 4
            for (int b = 0; b < NB; ++b) { const size_t idx = ((size_t)b * L + n) * D + d0; *(f32x4*)(h + idx) = *(const f32x4*)(args.in[I_X] + idx) + pv; } }
        for (int o = bx * 512 + tid; o < TC * 256; o += G * 512) *(f32x4*)(zs + (size_t)o * 4) = *(const f32x4*)(args.in[I_CTX] + (size_t)o * 4);
    }
    SEAM(0);

    for (int l = 0; l < 2; ++l) {
        const int pb = 1 + 10 * l; const float* modl = mod + (size_t)l * 17 * 6144; const bool need_ctx = (l == 0);
        unsigned char* mw = ws + WS_MIXW + (size_t)l * MIXW_LSTRIDE;
        const int tile0 = need_ctx ? 0 : 16, ntile = 144 - tile0;
        if (IN(pb + 0)) { PHASE_IDS const float* g1 = args.in[I_N1G] + l * D;
            for (int r = gw; r < TT; r += NGW) { const float* src = r < TC ? zs + (size_t)r * D : h + (size_t)(r - TC) * D; const float* mc = modl + (size_t)(r < TC ? 16 : (r - TC) >> 11) * 6144; int e1, e2; float w1;
                norm_row<false>(src, g1, mc, mc + 1024, XA + (size_t)r * D, lane, nullptr, nullptr, e1, e2, w1); } }
        SEAM(pb + 0);
        if (PHON(1) && IN(pb + 1)) { JobSched<3> S;
            S.j[0] = mkjob(XA, mw + 2 * MiB, 0, 0, 2048, 2048, 16, (mask & 0x1000) ? 0 : ntile, 10, 1, 1, 0, tile0, 0);
            S.j[1] = mkjob(XA, mw + 2 * MiB, 0, 0, 2048, 2048, 16, (need_ctx || (mask & 0x1000)) ? 0 : 16, 2, 1, 1, 0, 0, 0);
            S.j[2] = mkjob(mw, XA, 0, 0, 2048, 2048, 16, (mask & 0x2000) ? 0 : 4, ntile, 1, 1, 1, 0, tile0);
            S.init(G, bx); EpiInproj E{UX, GT, VL, VC}; gemm_phase(lds, S, E); }
        SEAM(pb + 1);
        if (PHON(2) && IN(pb + 2)) { JobSched<3> S;
            S.j[0] = mkjob(ws + WS_DFTL, VL, 0, (size_t)512 * 4096 * 2, 8192, 8192, 64, 8, 2, (mask & F_FOUR) ? NB : 0, 1, 0, 0, 0);
            S.j[1] = mkjob(ws + WS_DFTC, VC, 0, (size_t)512 * 512 * 2, 1024, 1024, 8, 1, 2, ((mask & F_FOUR) && need_ctx) ? NB : 0, 1, 1, 0, 0);
            S.j[2] = mkjob(UX, ws + WS_S5E + (size_t)l * S5_LSTRIDE, (size_t)CHR * 512 * 2, (size_t)256 * 256 * 2, 1024, 512, 4, 9, 1, (mask & F_S5) ? 32 : 0, 0, 2, 0, 0);
            S.init(G, bx); EpiP3 E{YS, Sst, 1.0f / sqrtf((float)L * 128.f), 1.0f / sqrtf((float)LC * 128.f)}; gemm_phase(lds, S, E); }
        SEAM(pb + 2);
        if (IN(pb + 3) && (mask & F_S5)) { PHASE_IDS const int id = bx * 512 + tid;
            if (id < 65536) { const int p = id & 63, dir = (id >> 6) & 1, g = (id >> 7) & 31, b = id >> 12;
                const float* lq = (const float*)(ws + WS_LAMQ) + (size_t)(((l * 2 + dir) * 32 + g) * 64 + p) * 2; const float qr = lq[0], qi = lq[1];
                const float* __restrict__ Sp = Sst + (size_t)g * CHR * 256 + dir * 128 + p * 2; bf16_t* __restrict__ Xp = UX + (size_t)g * CHR * 512 + 256 + dir * 128 + p * 2;
                float xr = 0.f, xi = 0.f;
#pragma unroll 8
                for (int k = 0; k < 144; ++k) { const int r = dir == 0 ? (k < 16 ? b * 16 + k : 256 + b * 128 + (k - 16)) : (k < 16 ? b * 16 + 15 - k : 256 + b * 128 + 127 - (k - 16));
                    const f32x2 s = *(const f32x2*)(Sp + (size_t)r * 256); *(unsigned*)(Xp + (size_t)r * 512) = cvt_pk_bf16(xr, xi);
                    const float nr = qr * xr - qi * xi + s[0], ni = qr * xi + qi * xr + s[1]; xr = nr; xi = ni; } } }
        SEAM(pb + 3);
        if (PHON(4) && IN(pb + 4)) { JobSched<2> S;
            S.j[0] = mkjob(UX, ws + WS_S5TG + (size_t)l * S5_LSTRIDE, (size_t)CHR * 512 * 2, (size_t)256 * 512 * 2, 1024, 1024, 8, need_ctx ? 9 : 8, 1, (mask & F_S5) ? 32 : 0, 1, 0, need_ctx ? 0 : 1, 0);
            S.j[1] = mkjob(YS, mw + 7 * MiB, 0, 0, 2048, 1024, 8, ntile, 4, (mask & F_GLU) ? 1 : 0, 1, 1, tile0, 0);
            S.init(G, bx); EpiP5 E{YS, GT, TM}; gemm_phase(lds, S, E); }
        SEAM(pb + 4);
        if (PHON(5) && IN(pb + 5)) { JobSched<1> S; S.j[0] = mkjob(YS + 512, mw + 8 * MiB, 0, 0, 2048, 1024, 8, ntile, 8, 1, 1, 0, tile0, 0);
            S.init(G, bx); EpiGlu E{GT, TM}; gemm_phase(lds, S, E); }
        SEAM(pb + 5);
        if (PHON(6) && IN(pb + 6)) { JobSched<1> S; S.j[0] = mkjob(TM, mw + 10 * MiB, 0, 0, 2048, 2048, 16, ntile, 4, 1, 0, 0, tile0, 0);
            S.init(G, bx); EpiRes E{h, zs, modl, 2}; gemm_phase(lds, S, E); }
        SEAM(pb + 6);
        if (l == 0) {
            if (IN(pb + 7)) { PHASE_IDS const float* g2 = args.in[I_N2G] + l * D;
                for (int r = gw; r < TT; r += NGW) { const float* src = r < TC ? zs + (size_t)r * D : h + (size_t)(r - TC) * D; const float* mc = modl + (size_t)(r < TC ? 16 : (r - TC) >> 11) * 6144 + 3 * 1024; int e1, e2; float w1;
                    norm_row<false>(src, g2, mc, mc + 1024, XA + (size_t)r * D, lane, nullptr, nullptr, e1, e2, w1); } }
            SEAM(pb + 7);
            if (PHON(8) && IN(pb + 8)) { JobSched<1> S; S.j[0] = mkjob(XA, ws + WS_WGU, 0, 0, 2048, 2048, 16, 144, 22, 1, 1, 0, 0, 0);
                S.init(G, bx); EpiSwiglu E{HID, DFF, 0}; gemm_phase(lds, S, E); }
            SEAM(pb + 8);
            if (PHON(9) && IN(pb + 9)) { JobSched<1> S; S.j[0] = mkjob(HID, ws + WS_WDN, 0, 0, 2 * DFF, 2 * DFF, 44, 144, 4, 1, 0, 0, 0, 0);
                S.init(G, bx); EpiRes E{h, zs, modl, 5}; gemm_phase(lds, S, E); }
            SEAM(pb + 9);
        }
    }
    {
        const float* modl = mod + (size_t)17 * 6144; bf16_t* XS = (bf16_t*)(ws + WS_XS); bf16_t* HIDM = (bf16_t*)(ws + WS_HIDM); unsigned char* wmoe = ws + WS_WMOE;
        if (IN(18)) { PHASE_IDS const float* g2 = args.in[I_N2G] + D; LAS int* lcnt = (LAS int*)(lds + 69632);
            int lc[8];
#pragma unroll
            for (int e = 0; e < 8; ++e) lc[e] = 0;
            for (int t = gw; t < TL; t += NGW) { const float* mc = modl + (size_t)(t >> 11) * 6144 + 3 * 1024; int e1, e2; float w1;
                norm_row<true>(h + (size_t)t * D, g2, mc, mc + 1024, XA + (size_t)(TC + t) * D, lane, args.in[I_MR], args.in[I_MBR], e1, e2, w1);
                int p1 = 0, p2 = 0;
#pragma unroll
                for (int e = 0; e < 8; ++e) { if (e == e1) { p1 = lc[e]; lc[e]++; } }
#pragma unroll
                for (int e = 0; e < 8; ++e) { if (e == e2) { p2 = lc[e]; lc[e]++; } }
                if (lane == 0) { tok_e[t * 2] = e1; tok_e[t * 2 + 1] = e2; tok_w[t * 2] = w1; tok_w[t * 2 + 1] = 1.f - w1; tok_pos[t * 2] = p1; tok_pos[t * 2 + 1] = p2; } }
            { int mine = 0;
#pragma unroll
              for (int e = 0; e < 8; ++e) if (lane == e) mine = lc[e];
              if (lane < 8) lcnt[wave * 8 + lane] = mine; }
            __syncthreads();
            if (tid < 8) { int run = 0; for (int w = 0; w < 8; ++w) { const int c = lcnt[w * 8 + tid]; lcnt[64 + w * 8 + tid] = run; run += c; } lcnt[128 + tid] = atomicAdd(&cnt[tid], run); }
            __syncthreads();
            asm volatile("s_waitcnt vmcnt(0)" ::: "memory");
            for (int t = gw; t < TL; t += NGW) { if (lane == 0) { const int ea = tok_e[t * 2], eb = tok_e[t * 2 + 1]; tok_pos[t * 2] += lcnt[64 + wave * 8 + ea] + lcnt[128 + ea]; tok_pos[t * 2 + 1] += lcnt[64 + wave * 8 + eb] + lcnt[128 + eb]; } }
            __syncthreads();
            LAS float* scr = (LAS float*)(lds + wave * 8448);
            constexpr int I_G = 16 * 112, I_D = 56 * 32, PERE = 2 * I_G + I_D;
            for (int it = gw; it < 8 * PERE; it += NGW) { const int e = it / PERE; int r = it - e * PERE; bf16_t* wg = (bf16_t*)(wmoe + (size_t)e * 21 * MiB); bf16_t* wd = (bf16_t*)(wmoe + (size_t)e * 21 * MiB + 14 * MiB);
                if (r < I_G) { tr_mat_item(args.in[I_MG] + (size_t)e * D * DFE, 1024, DFE, DFE, 0, wg, 0, 1, r, scr, lane); continue; } r -= I_G;
                if (r < I_G) { tr_mat_item(args.in[I_MU] + (size_t)e * D * DFE, 1024, DFE, DFE, 0, wg, 0, 2, r, scr, lane); continue; } r -= I_G;
                tr_mat_item(args.in[I_MD] + (size_t)e * DFE * D, DFE, 1024, D, 0, wd, 0, 0, r, scr, lane); }
        }
        SEAM(18);
        if (IN(19)) { PHASE_IDS int base[9]; base[0] = 0;
#pragma unroll
            for (int e = 0; e < 8; ++e) base[e + 1] = base[e] + ((cnt[e] + 255) & ~255);
            if (bx == 0) { if (tid < MOETILES) { int te = 0;
#pragma unroll
                    for (int k = 0; k < 8; ++k) if (tid * 256 >= base[k]) te = k;
                    tile_e[tid] = te; }
                if (tid == 0) ctl[CW_NT] = (unsigned)(base[8] >> 8); }
            for (int i = gw; i < 2 * TL; i += NGW) { const int e = tok_e[i]; int bs = 0;
#pragma unroll
                for (int k = 0; k < 8; ++k) if (k == e) bs = base[k];
                const int row = bs + tok_pos[i]; if (lane == 0) tok_row[i] = row;
                const u32x4* src = (const u32x4*)(XA + (size_t)(TC + (i >> 1)) * D); u32x4* dst = (u32x4*)(XS + (size_t)row * D); dst[lane] = src[lane]; dst[64 + lane] = src[64 + lane]; } }
        SEAM(19);
        LAS int* tile_l = (LAS int*)(lds + STAGE_BYTES + 1024);
        if (hi > 20 && lo < 24) { PHASE_IDS if (tid < MOETILES) tile_l[tid] = tile_e[tid]; __syncthreads(); }
        for (int ps = 0; ps < 2; ++ps) {
            const int ph = 20 + 2 * ps;
            if (PHON(20) && IN(ph)) { const int ntl = (int)ctl[CW_NT]; const int t0 = ps * MOE_TP; int nm = ntl - t0; nm = nm < 0 ? 0 : (nm > MOE_TP ? MOE_TP : nm);
                JobSched<1> S; S.j[0] = mkjob(XS, wmoe, 0, 0, 2048, 2048, 16, nm, 28, 1, 1, 0, t0, 0); S.j[0].tlut = tile_l; S.j[0].eB = 21 * MiB;
                S.init(G, bx); EpiSwiglu E{HIDM, DFE, t0 * 256}; gemm_phase(lds, S, E); }
            SEAM(ph);
            if (PHON(21) && IN(ph + 1)) { const int ntl = (int)ctl[CW_NT]; const int t0 = ps * MOE_TP; int nm = ntl - t0; nm = nm < 0 ? 0 : (nm > MOE_TP ? MOE_TP : nm);
                JobSched<1> S; S.j[0] = mkjob((const char*)HIDM - (size_t)t0 * 256 * 2 * DFE, wmoe + 14 * MiB, 0, 0, 2 * DFE, 2 * DFE, 56, nm, 4, 1, 1, 0, t0, 0); S.j[0].tlut = tile_l; S.j[0].eB = 21 * MiB;
                S.init(G, bx); EpiBf E{XS, D}; gemm_phase(lds, S, E); }
            SEAM(ph + 1);
        }
        if (IN(24)) { PHASE_IDS const float* fg = args.in[I_FINALG];
            for (int t = gw; t < TL; t += NGW) { const float* g2 = modl + (size_t)(t >> 11) * 6144 + 5 * 1024; const int r1 = tok_row[t * 2], r2 = tok_row[t * 2 + 1]; const float w1 = tok_w[t * 2], w2 = tok_w[t * 2 + 1];
                f32x4 v[4]; float ss = 0.f;
#pragma unroll
                for (int j = 0; j < 4; ++j) { const int k = j * 256 + lane * 4; const f32x4 hv = *(const f32x4*)(h + (size_t)t * D + k), gg = *(const f32x4*)(g2 + k);
                    const u32x2 a = *(const u32x2*)(XS + (size_t)r1 * D + k), b = *(const u32x2*)(XS + (size_t)r2 * D + k);
                    const f32x4 av = {bflo(a.x), bfhi(a.x), bflo(a.y), bfhi(a.y)}, bv = {bflo(b.x), bfhi(b.x), bflo(b.y), bfhi(b.y)};
                    v[j] = hv + gg * (av * w1 + bv * w2); ss += v[j][0] * v[j][0] + v[j][1] * v[j][1] + v[j][2] * v[j][2] + v[j][3] * v[j][3]; }
                ss = wave_sum(ss); const float rstd = rsqrtf(ss * (1.f / D) + EPS);
#pragma unroll
                for (int j = 0; j < 4; ++j) { const int k = j * 256 + lane * 4; const f32x4 gg = *(const f32x4*)(fg + k); *(f32x4*)(h + (size_t)t * D + k) = v[j] * rstd * gg; } } }
    }
#undef IN
#undef SEAM
#undef h
#undef zs
#undef mod
#undef XA
#undef YS
#undef UX
#undef GT
#undef VL
#undef VC
#undef Sst
#undef TM
#undef HID
#undef cnt
#undef tok_e
#undef tok_w
#undef tok_pos
#undef tok_row
#undef tile_e
}
}

extern "C" void kernel_launch(void* const* d_in, const int* in_sizes, int n_in, void* d_out, int out_size, void* d_ws, size_t ws_size, hipStream_t stream) {
    const float* x = (const float*)d_in[0]; const float* c = (const float*)d_in[1]; const float* ctx = (const float*)d_in[2]; const float* cctx = (const float*)d_in[3];
    const float* wmod = (const float*)d_in[4]; const float* bmod = (const float*)d_in[5]; const float* n1g = (const float*)d_in[6]; const float* n2g = (const float*)d_in[7];
    const float* win = (const float*)d_in[8]; const float* wfour = (const float*)d_in[9];
    const float* are = (const float*)d_in[10]; const float* aim = (const float*)d_in[11]; const float* logdt = (const float*)d_in[12];
    const float* bre = (const float*)d_in[13]; const float* bim = (const float*)d_in[14]; const float* cre = (const float*)d_in[15]; const float* cim = (const float*)d_in[16];
    const float* ssmd = (const float*)d_in[17]; const float* glua = (const float*)d_in[18]; const float* glub = (const float*)d_in[19]; const float* wout = (const float*)d_in[20];
    const float* fgw = (const float*)d_in[21]; const float* fuw = (const float*)d_in[22]; const float* fdw = (const float*)d_in[23];
    const float* mrw = (const float*)d_in[24]; const float* mrb = (const float*)d_in[25]; const float* mgw = (const float*)d_in[26]; const float* muw = (const float*)d_in[27]; const float* mdw = (const float*)d_in[28];
    const float* finalg = (const float*)d_in[29];
    float* h = (float*)d_out; char* ws = (char*)d_ws;
    float* mod = (float*)(ws + WS_MOD); float* cosT = (float*)(ws + WS_COST); float* sinT = cosT + 2048;
    int* cnt = (int*)(ws + WS_CTL) + CW_CNT; int* tok_e = (int*)(ws + WS_TOKE); float* tok_w = (float*)(ws + WS_TOKW); int* tok_pos = (int*)(ws + WS_TOKPOS); int* tok_row = (int*)(ws + WS_TOKROW);
    int* tile_e = (int*)(ws + WS_TILEE); int* rowtok = (int*)(ws + WS_ROWTOK);
    float* z = (float*)(ws + WS_Z); bf16_t* XA = (bf16_t*)(ws + WS_XA); bf16_t* YS = (bf16_t*)(ws + WS_YS); bf16_t* UX = (bf16_t*)(ws + WS_UX); bf16_t* GT = (bf16_t*)(ws + WS_GT);
    bf16_t* VL = (bf16_t*)(ws + WS_VT2L); bf16_t* VC = (bf16_t*)(ws + WS_VT2C); bf16_t* TM = (bf16_t*)(ws + WS_TM); bf16_t* PF = (bf16_t*)(ws + WS_PF); bf16_t* T1 = (bf16_t*)(ws + WS_T1); bf16_t* T2 = (bf16_t*)(ws + WS_T2);
    float* Yacc = (float*)(ws + WS_YACC); bf16_t* HID = (bf16_t*)(ws + WS_HID); float* O = (float*)(ws + WS_NO); bf16_t* HQ = (bf16_t*)(ws + WS_NHQ);
    const int mask = FASTMASK;

    static int grid = 0;
    if (grid == 0) {
        int dev = 0, cus = 0; (void)hipGetDevice(&dev); (void)hipDeviceGetAttribute(&cus, hipDeviceAttributeMultiprocessorCount, dev);
        (void)hipFuncSetAttribute((const void*)mk::fwd, hipFuncAttributeMaxDynamicSharedMemorySize, mk::LDS_BYTES);
        int per_cu = 0; (void)hipOccupancyMaxActiveBlocksPerMultiprocessor(&per_cu, (const void*)mk::fwd, 512, mk::LDS_BYTES); (void)hipGetLastError();
        grid = cus > 0 ? cus : 256;
    }
    (void)hipMemsetAsync(ws + WS_CTL, 0, CTL_BYTES, stream);
    mk::Args a{};
    for (int i = 0; i < 30; ++i) a.in[i] = (const float*)d_in[i];
    a.out = h; a.ws = (unsigned char*)d_ws; a.mask = mask; a.pad = 0;
    auto fast = [&](int lo, int hi) { a.ph_lo = lo; a.ph_hi = hi; hipLaunchKernelGGL(mk::fwd, dim3(grid), dim3(512), mk::LDS_BYTES, stream, a); };
#if ONE_LAUNCH
    fast(0, mk::NPH);
#else
    hipLaunchKernelGGL(k_tables, dim3(8), dim3(256), 0, stream, cosT, sinT);
    if (mask & F_PRO) fast(0, 1);
    else { hipLaunchKernelGGL(k_mod, dim3(24, 17, 2), dim3(256), 0, stream, c, cctx, wmod, bmod, mod); hipLaunchKernelGGL(k_init, dim3(TL * D / 256), dim3(256), 0, stream, x, ctx, h, z); }
    for (int l = 0; l < 2; ++l) {
        const int pb = 1 + 10 * l; const float* modl = mod + (size_t)l * 17 * 6144; const bool need_ctx = (l == 0);
        if (mask & F_NORM) fast(pb, pb + 1);
        else hipLaunchKernelGGL(k_norm<false>, dim3(TT / 4), dim3(256), 0, stream, h, z, n1g + l * D, modl, 0, 1, XA, 0, TT, nullptr, nullptr, nullptr, nullptr);
        if (!(mask & F_INPROJ) || (mask & 0x3000)) {
            { LAbf la{XA, D, 0}; LBw lb{win + (size_t)l * D * INC, INC, 0}; EPinproj ep{PF, UX, GT}; hipLaunchKernelGGL((ngemm<LAbf, LBw, EPinproj>), dim3(INC / 64, TT / 64, 1), dim3(256), 0, stream, D, 0, la, lb, ep); }
            { LAbfZ la{PF, 512, 128}; LBdft128 lb{cosT, sinT}; EPzdft ep{VL, VC}; hipLaunchKernelGGL((ngemm<LAbfZ, LBdft128, EPzdft>), dim3(256 / 64, TT / 64, 4), dim3(256), 0, stream, 128, 0, la, lb, ep); }
        }
        if (mask & F_INPROJ) fast(pb + 1, pb + 2);
        if (mask & (F_FOUR | F_S5)) fast(pb + 2, pb + 3);
        if (!(mask & F_FOUR)) {
            { LAdftL<L> la{cosT, sinT}; LBvt2<L> lb{VL}; EPfour<L> ep{YS, TC, 1.0f / sqrtf((float)L * 128.f)}; hipLaunchKernelGGL((ngemm<LAdftL<L>, LBvt2<L>, EPfour<L>>), dim3(512 / 64, L / 64, NB), dim3(256), 0, stream, 2 * L, 0, la, lb, ep); }
            if (need_ctx) { LAdftL<LC> la{cosT, sinT}; LBvt2<LC> lb{VC}; EPfour<LC> ep{YS, 0, 1.0f / sqrtf((float)LC * 128.f)}; hipLaunchKernelGGL((ngemm<LAdftL<LC>, LBvt2<LC>, EPfour<LC>>), dim3(512 / 64, LC / 64, NB), dim3(256), 0, stream, 2 * LC, 0, la, lb, ep); }
        }
        if (mask & F_S5) fast(pb + 3, pb + 4);
        else hipLaunchKernelGGL(k_s5_naive, dim3(NB * 32), dim3(64), 0, stream, UX, are + l * 4096, aim + l * 4096, logdt + l * 64, bre + (size_t)l * 65536, bim + (size_t)l * 65536, cre + (size_t)l * 65536, cim + (size_t)l * 65536, ssmd + l * 512, Yacc, YS);
        if (mask & (F_S5 | F_GLU)) fast(pb + 4, pb + 5);
        const int r0 = need_ctx ? 0 : TC, nr = TT - r0;
        if (mask & F_GLU) fast(pb + 5, pb + 6);
        else {
            { LAbf la{YS + (size_t)r0 * 1024, 1024, 0}; LBw lb{wfour + (size_t)l * 512 * D, D, 0}; EPbf ep{T1 + (size_t)r0 * D, D, 0}; hipLaunchKernelGGL((ngemm<LAbf, LBw, EPbf>), dim3(D / 64, nr / 64, 1), dim3(256), 0, stream, 512, 0, la, lb, ep); }
            { LAbf la{YS + (size_t)r0 * 1024 + 512, 1024, 0}; LBw lb{glua + (size_t)l * 512 * D, D, 0}; EPbf ep{T2 + (size_t)r0 * D, D, 0}; hipLaunchKernelGGL((ngemm<LAbf, LBw, EPbf>), dim3(D / 64, nr / 64, 1), dim3(256), 0, stream, 512, 0, la, lb, ep); }
            { LAbf la{YS + (size_t)r0 * 1024 + 512, 1024, 0}; LBw lb{glub + (size_t)l * 512 * D, D, 0}; EPmerge ep{GT + (size_t)r0 * 2048, T1 + (size_t)r0 * D, T2 + (size_t)r0 * D, TM + (size_t)r0 * D}; hipLaunchKernelGGL((ngemm<LAbf, LBw, EPmerge>), dim3(D / 64, nr / 64, 1), dim3(256), 0, stream, 512, 0, la, lb, ep); }
        }
        if (mask & F_OUT) fast(pb + 6, pb + 7);
        else { LAbf la{TM + (size_t)r0 * D, D, 0}; LBw lb{wout + (size_t)l * D * D, D, 0}; EPres ep{h, z, modl, 2, r0}; hipLaunchKernelGGL((ngemm<LAbf, LBw, EPres>), dim3(D / 64, nr / 64, 1), dim3(256), 0, stream, D, 0, la, lb, ep); }
        if (l == 0) {
            if (mask & F_NORM) fast(pb + 7, pb + 8);
            else hipLaunchKernelGGL(k_norm<false>, dim3(TT / 4), dim3(256), 0, stream, h, z, n2g + l * D, modl, 3, 4, XA, 0, TT, nullptr, nullptr, nullptr, nullptr);
            if (mask & F_FFN) { fast(pb + 8, pb + 9); fast(pb + 9, pb + 10); }
            else {
                { LAbf la{XA, D, 0}; LBw lb{fgw, DFF, 0}; EPbf ep{HID, DFF, 0}; hipLaunchKernelGGL((ngemm<LAbf, LBw, EPbf>), dim3(DFF / 64, TT / 64, 1), dim3(256), 0, stream, D, 0, la, lb, ep); }
                { LAbf la{XA, D, 0}; LBw lb{fuw, DFF, 0}; EPswi ep{HID, DFF, 0}; hipLaunchKernelGGL((ngemm<LAbf, LBw, EPswi>), dim3(DFF / 64, TT / 64, 1), dim3(256), 0, stream, D, 0, la, lb, ep); }
                { LAbf la{HID, DFF, 0}; LBw lb{fdw, D, 0}; EPres ep{h, z, modl, 5, 0}; hipLaunchKernelGGL((ngemm<LAbf, LBw, EPres>), dim3(D / 64, TT / 64, 1), dim3(256), 0, stream, DFF, 0, la, lb, ep); }
            }
        } else if (mask & F_MOE) {
            for (int ph = 18; ph < 25; ++ph) fast(ph, ph + 1);
        } else {
            hipLaunchKernelGGL(k_moe_zero, dim3((MOEROWS + 255) / 256), dim3(256), 0, stream, cnt, rowtok);
            hipLaunchKernelGGL(k_norm<true>, dim3(TL / 4), dim3(256), 0, stream, h, z, n2g + l * D, modl, 3, 4, XA, TC, TL, mrw, mrb, tok_e, tok_w);
            hipLaunchKernelGGL(k_moe_count, dim3(TL * 2 / 256), dim3(256), 0, stream, tok_e, cnt, tok_pos);
            hipLaunchKernelGGL(k_moe_place, dim3(TL * 2 / 256), dim3(256), 0, stream, tok_e, cnt, tok_pos, tok_row, rowtok, tile_e);
            for (int q = 0; q < 4; ++q) {
                { LAgather la{XA + (size_t)TC * D, rowtok, tile_e}; LBmoe lb{mgw, tile_e, (size_t)D * DFE, DFE, q * 896, 0, 0}; EPbf ep{HQ, 896, 0}; hipLaunchKernelGGL((ngemm<LAgather, LBmoe, EPbf>), dim3(896 / 64, MOEROWS / 64, 1), dim3(256), 0, stream, D, 0, la, lb, ep); }
                { LAgather la{XA + (size_t)TC * D, rowtok, tile_e}; LBmoe lb{muw, tile_e, (size_t)D * DFE, DFE, q * 896, 0, 0}; EPswi ep{HQ, 896, 0}; hipLaunchKernelGGL((ngemm<LAgather, LBmoe, EPswi>), dim3(896 / 64, MOEROWS / 64, 1), dim3(256), 0, stream, D, 0, la, lb, ep); }
                { LAmoeh la{HQ, tile_e}; LBmoe lb{mdw, tile_e, (size_t)DFE * D, D, 0, q * 896, 0}; EPacc ep{O, q == 0, 0}; hipLaunchKernelGGL((ngemm<LAmoeh, LBmoe, EPacc>), dim3(D / 64, MOEROWS / 64, 1), dim3(256), 0, stream, 896, 0, la, lb, ep); }
            }
            hipLaunchKernelGGL(k_final, dim3(TL / 4), dim3(256), 0, stream, h, modl, O, tok_row, tok_w, finalg, (float*)d_out);
        }
    }
#endif
}
```

```cpp
#define FASTMASK 0x1FF
#define ONE_LAUNCH 1
#include <hip/hip_runtime.h>
#include <stdint.h>
#include <math.h>

#ifndef FASTMASK
#define FASTMASK 0x0
#endif
#ifndef ONE_LAUNCH
#define ONE_LAUNCH 0
#endif

namespace {
typedef unsigned short bf16_t;
constexpr int D = 1024, NB = 16, L = 2048, LC = 256, TL = NB * L, TC = NB * LC, TT = TL + TC;
constexpr int INC = 3072, DFF = 2816, NE = 8, DFE = 3584, MOEROWS = 2 * TL + NE * 256, MOETILES = MOEROWS / 256;
constexpr int CHR = TT / 16;
constexpr float EPS = 1e-6f;
constexpr int F_PRO = 1, F_INPROJ = 2, F_FOUR = 4, F_S5 = 8, F_GLU = 16, F_OUT = 32, F_FFN = 64, F_MOE = 128, F_NORM = 256;

constexpr size_t MiB = (size_t)1 << 20, KiB = 1024;
constexpr size_t WS_CTL = 0, CTL_BYTES = 64 * KiB;
constexpr size_t WS_MOD = 128 * KiB;
constexpr size_t WS_LAMQ = 1 * MiB;
constexpr size_t WS_COST = 1 * MiB + 64 * KiB;
constexpr size_t WS_TOKE = 1 * MiB + 256 * KiB, WS_TOKW = WS_TOKE + 256 * KiB, WS_TOKPOS = WS_TOKW + 256 * KiB, WS_TOKROW = WS_TOKPOS + 256 * KiB;
constexpr size_t WS_TILEE = WS_TOKROW + 256 * KiB, WS_ROWTOK = WS_TILEE + 4 * KiB;
constexpr size_t WS_Z = 4 * MiB;
constexpr size_t WS_DFTL = 20 * MiB, WS_DFTC = 36 * MiB;
constexpr size_t WS_S5E = 37 * MiB, WS_S5TG = 41 * MiB, S5_LSTRIDE = 12 * MiB;
constexpr size_t WS_MIXW = 61 * MiB, MIXW_LSTRIDE = 12 * MiB;
constexpr size_t WS_WGU = 85 * MiB, WS_WDN = 96 * MiB;
constexpr size_t WS_UX = 102 * MiB, WS_GT = 174 * MiB, WS_S = 318 * MiB, WS_VT2L = 390 * MiB, WS_VT2C = 454 * MiB, WS_TM = 390 * MiB, WS_XA = 535 * MiB, WS_YS = 535 * MiB;
constexpr size_t WS_PF = 462 * MiB, WS_T1 = 462 * MiB, WS_YACC = 318 * MiB, WS_T2 = 318 * MiB;
constexpr size_t WS_HID = 102 * MiB;
constexpr size_t WS_WMOE = 4 * MiB, WS_XS = 172 * MiB, WS_HIDM = 304 * MiB;
constexpr int MOE_TP = 132;
constexpr size_t WS_NO = 102 * MiB, WS_NHQ = 366 * MiB;
constexpr size_t WS_END = 607 * MiB;
constexpr int CW_BAR = 0, CW_CNT = 4096, CW_NT = 4096 + 64;

__device__ __forceinline__ float bf2f(bf16_t b) { return __uint_as_float(((unsigned)b) << 16); }
__device__ __forceinline__ bf16_t f2bf(float f) { unsigned u = __float_as_uint(f); u += 0x7FFFu + ((u >> 16) & 1u); return (bf16_t)(u >> 16); }
__device__ __forceinline__ float sigmoidf_(float v) { return 1.f / (1.f + expf(-v)); }
__device__ __forceinline__ float siluf_(float v) { return v / (1.f + expf(-v)); }
__device__ __forceinline__ float geluf_(float v) { return 0.5f * v * (1.f + tanhf(0.7978845608028654f * (v + 0.044715f * v * v * v))); }
__device__ __forceinline__ float wave_sum(float v) {
#pragma unroll
    for (int o = 32; o >= 1; o >>= 1) v += __shfl_xor(v, o);
    return v;
}
__device__ __forceinline__ size_t ux_index(int g, int row, int h) { return ((size_t)g * CHR + (row >> 4)) * 512 + (row & 15) * 16 + h; }
__device__ __forceinline__ size_t vt2_index(int row, int gk, int type) {
    if (row < TC) { const int b = row >> 8, n = row & 255; return ((size_t)(b * 512 + gk)) * 512 + type * 256 + n; }
    const int t = row - TC, b = t >> 11, n = t & 2047; return ((size_t)(b * 512 + gk)) * 4096 + type * 2048 + n;
}

template <class LA, class LB, class EP>
__global__ __launch_bounds__(256) void ngemm(int K, int kpad, LA la, LB lb, EP ep) {
    __shared__ float As[16][68], Bs[16][68];
    const int tx = threadIdx.x & 15, ty = threadIdx.x >> 4;
    const int m0 = blockIdx.y * 64, n0 = blockIdx.x * 64, z = blockIdx.z;
    if (!la.active(z, m0)) return;
    float acc[4][4];
#pragma unroll
    for (int i = 0; i < 4; ++i)
#pragma unroll
        for (int j = 0; j < 4; ++j) acc[i][j] = 0.f;
    for (int k0 = 0; k0 < K; k0 += 16) {
#pragma unroll
        for (int i = 0; i < 4; ++i) { const int e = threadIdx.x + i * 256; const int mm = e >> 4, kk = e & 15; As[kk][mm] = la(z, m0 + mm, k0 + kk); }
#pragma unroll
        for (int i = 0; i < 4; ++i) { const int e = threadIdx.x + i * 256; const int kk = e >> 6, nn = e & 63; Bs[kk][nn] = lb(z, m0, k0 + kk, n0 + nn); }
        __syncthreads();
#pragma unroll
        for (int kk = 0; kk < 16; ++kk) {
            float a[4], b[4];
#pragma unroll
            for (int i = 0; i < 4; ++i) { a[i] = As[kk][ty * 4 + i]; b[i] = Bs[kk][tx * 4 + i]; }
#pragma unroll
            for (int i = 0; i < 4; ++i)
#pragma unroll
                for (int j = 0; j < 4; ++j) acc[i][j] += a[i] * b[j];
        }
        __syncthreads();
    }
#pragma unroll
    for (int i = 0; i < 4; ++i)
#pragma unroll
        for (int j = 0; j < 4; ++j) ep(z, m0 + ty * 4 + i, n0 + tx * 4 + j, acc[i][j]);
}
struct LAbf { const bf16_t* p; int ld; int pad; __device__ bool active(int, int) const { return true; } __device__ float operator()(int, int m, int k) const { return bf2f(p[(size_t)m * ld + k]); } };
struct LAbfZ { const bf16_t* p; int ld; int zoff; __device__ bool active(int, int) const { return true; } __device__ float operator()(int z, int m, int k) const { return bf2f(p[(size_t)m * ld + z * zoff + k]); } };
struct LBw { const float* p; int ld; int pad; __device__ float operator()(int, int, int k, int n) const { return p[(size_t)k * ld + n]; } };
struct LBdft128 { const float* cosT; const float* sinT; __device__ float operator()(int, int, int k, int n) const { const int nn = n & 127; const int idx = ((k * nn) & 127) * 16; return n < 128 ? cosT[idx] : sinT[idx]; } };
template <int LL> struct LAdftL { const float* cosT; const float* sinT; __device__ bool active(int, int) const { return true; }
    __device__ float operator()(int, int m, int k) const { const int kk = k & (LL - 1); const int idx = ((m * kk) & (LL - 1)) * (2048 / LL); return k < LL ? cosT[idx] : -sinT[idx]; } };
template <int LL> struct LBvt2 { const bf16_t* V; __device__ float operator()(int z, int, int k, int n) const { return bf2f(V[((size_t)(z * 512 + n)) * (2 * LL) + k]); } };
struct LAgather { const bf16_t* A; const int* rowtok; const int* tile_e; __device__ bool active(int, int m0) const { return tile_e[m0 >> 8] >= 0; }
    __device__ float operator()(int, int m, int k) const { const int t = rowtok[m]; return t < 0 ? 0.f : bf2f(A[(size_t)t * D + k]); } };
struct LAmoeh { const bf16_t* H; const int* tile_e; __device__ bool active(int, int m0) const { return tile_e[m0 >> 8] >= 0; }
    __device__ float operator()(int, int m, int k) const { return bf2f(H[(size_t)m * 896 + k]); } };
struct LBmoe { const float* w; const int* tile_e; size_t estride; int ld; int coff; int roff; int pad; __device__ float operator()(int, int m0, int k, int n) const { const int e = tile_e[m0 >> 8]; return w[(size_t)e * estride + (size_t)(k + roff) * ld + coff + n]; } };

struct EPbf { bf16_t* o; int ld; int pad; __device__ void operator()(int, int m, int n, float v) const { o[(size_t)m * ld + n] = f2bf(v); } };
struct EPinproj { bf16_t* PF; bf16_t* UX; bf16_t* GT; __device__ void operator()(int, int m, int n, float v) const {
    if (n < 512) PF[(size_t)m * 512 + n] = f2bf(v); else if (n < 1024) { const int c = n - 512; UX[ux_index(c >> 4, m, c & 15)] = f2bf(v); } else GT[(size_t)m * 2048 + (n - 1024)] = f2bf(sigmoidf_(v)); } };
struct EPzdft { bf16_t* VL; bf16_t* VC; __device__ void operator()(int z, int m, int n, float v) const { (m < TC ? VC : VL)[vt2_index(m, z * 128 + (n & 127), n >> 7)] = f2bf(v); } };
template <int LL> struct EPfour { bf16_t* YS; int rowbase; float scale; __device__ void operator()(int z, int m, int n, float v) const { YS[((size_t)rowbase + z * LL + m) * 1024 + n] = f2bf(v * scale); } };
struct EPmerge { const bf16_t* GT; const bf16_t* T1; const bf16_t* T2; bf16_t* M; __device__ void operator()(int, int m, int n, float v) const {
    const float ga = bf2f(GT[(size_t)m * 2048 + n]), gb = bf2f(GT[(size_t)m * 2048 + 1024 + n]);
    const size_t o = (size_t)m * D + n; M[o] = f2bf(ga * bf2f(T1[o]) + gb * bf2f(T2[o]) * sigmoidf_(v)); } };
struct EPres { float* h; float* z; const float* mod; int gidx; int rowoff; __device__ void operator()(int, int m, int n, float v) const {
    const int r = m + rowoff; float* dst = r < TC ? z + (size_t)r * D + n : h + (size_t)(r - TC) * D + n; const int cond = r < TC ? 16 : (r - TC) / L;
    *dst += mod[(size_t)cond * 6144 + gidx * 1024 + n] * v; } };
struct EPswi { bf16_t* G; int ld; int pad; __device__ void operator()(int, int m, int n, float v) const { const size_t o = (size_t)m * ld + n; G[o] = f2bf(siluf_(bf2f(G[o])) * v); } };
struct EPacc { float* O; int first; int pad; __device__ void operator()(int, int m, int n, float v) const { const size_t o = (size_t)m * D + n; O[o] = first ? v : O[o] + v; } };

__global__ void k_tables(float* cosT, float* sinT) { const int i = blockIdx.x * blockDim.x + threadIdx.x; if (i < 2048) { cosT[i] = cospif(i / 1024.f); sinT[i] = sinpif(i / 1024.f); } }
__global__ void k_mod(const float* c, const float* cctx, const float* wmod, const float* bmod, float* mod) {
    const int col = blockIdx.x * 256 + threadIdx.x, r = blockIdx.y, l = blockIdx.z;
    const float* cond = r < 16 ? c + r * D : cctx; const float* w = wmod + (size_t)l * D * 6144;
    float acc = 0.f;
    for (int k = 0; k < D; ++k) acc += siluf_(cond[k]) * w[(size_t)k * 6144 + col];
    mod[((size_t)l * 17 + r) * 6144 + col] = acc + bmod[l * 6144 + col];
}
__global__ void k_init(const float* x, const float* ctx, float* h, float* z) {
    const size_t i = (size_t)blockIdx.x * blockDim.x + threadIdx.x;
    if (i < (size_t)TL * D) { const int d = (int)(i & 1023); const int t = (int)(i >> 10); const int n = t & (L - 1); const int r = n >> 6, col = n & 63; const int q = d >> 8, ii = d & 255;
        const float omega = 1.0f / powf(10000.f, (float)ii / 256.f); const float ang = (q < 2 ? (float)r : (float)col) * omega; h[i] = x[i] + ((q & 1) ? cosf(ang) : sinf(ang)); }
    if (i < (size_t)TC * D) z[i] = ctx[i];
}
template <bool ROUTE>
__global__ __launch_bounds__(256) void k_norm(const float* h, const float* z, const float* g, const float* mod, int shi, int sci, bf16_t* A, int row0, int nrows,
                                              const float* wr, const float* br, int* tok_e, float* tok_w) {
    const int lane = threadIdx.x & 63; const int r = row0 + blockIdx.x * 4 + (threadIdx.x >> 6); if (r >= row0 + nrows) return;
    const float* src = r < TC ? z + (size_t)r * D : h + (size_t)(r - TC) * D; const int cond = r < TC ? 16 : (r - TC) / L;
    const float* sh = mod + (size_t)cond * 6144 + shi * 1024; const float* sc = mod + (size_t)cond * 6144 + sci * 1024;
    float4 v[4]; float ss = 0.f;
#pragma unroll
    for (int j = 0; j < 4; ++j) { v[j] = *(const float4*)(src + j * 256 + lane * 4); ss += v[j].x * v[j].x + v[j].y * v[j].y + v[j].z * v[j].z + v[j].w * v[j].w; }
    ss = wave_sum(ss); const float rstd = rsqrtf(ss * (1.f / D) + EPS);
    float lg[8];
#pragma unroll
    for (int e = 0; e < 8; ++e) lg[e] = 0.f;
#pragma unroll
    for (int j = 0; j < 4; ++j) { const int k = j * 256 + lane * 4; const float4 gg = *(const float4*)(g + k), s1 = *(const float4*)(sc + k), s0 = *(const float4*)(sh + k);
        float a0 = v[j].x * rstd * gg.x * (1.f + s1.x) + s0.x, a1 = v[j].y * rstd * gg.y * (1.f + s1.y) + s0.y, a2 = v[j].z * rstd * gg.z * (1.f + s1.z) + s0.z, a3 = v[j].w * rstd * gg.w * (1.f + s1.w) + s0.w;
        ushort4 o; o.x = f2bf(a0); o.y = f2bf(a1); o.z = f2bf(a2); o.w = f2bf(a3); *(ushort4*)(A + (size_t)r * D + k) = o;
        if (ROUTE) {
#pragma unroll
            for (int e = 0; e < 8; ++e) lg[e] += a0 * wr[(k + 0) * 8 + e] + a1 * wr[(k + 1) * 8 + e] + a2 * wr[(k + 2) * 8 + e] + a3 * wr[(k + 3) * 8 + e]; } }
    if (ROUTE) {
#pragma unroll
        for (int e = 0; e < 8; ++e) lg[e] = wave_sum(lg[e]) + br[e];
        if (lane == 0) { int e1 = 0; float v1 = lg[0];
#pragma unroll
            for (int e = 1; e < 8; ++e) if (lg[e] > v1) { v1 = lg[e]; e1 = e; }
            int e2 = -1; float v2 = -3.0e38f;
#pragma unroll
            for (int e = 0; e < 8; ++e) if (e != e1 && lg[e] > v2) { v2 = lg[e]; e2 = e; }
            const float w1 = 1.f / (1.f + expf(v2 - v1)); const int t = r - TC;
            tok_e[t * 2] = e1; tok_e[t * 2 + 1] = e2; tok_w[t * 2] = w1; tok_w[t * 2 + 1] = 1.f - w1; }
    }
}
__global__ __launch_bounds__(64) void k_s5_naive(const bf16_t* UX, const float* are, const float* aim, const float* logdt, const float* bre, const float* bim, const float* cre, const float* cim,
                                                  const float* dsk, float* Yacc, bf16_t* YS) {
    const int b = blockIdx.x >> 5, g = blockIdx.x & 31, p = threadIdx.x, lane = p;
    const int hh = ((lane >> 5) & 1) * 8 + ((lane >> 4) & 1) * 4 + ((lane >> 3) & 1) * 2 + ((lane >> 2) & 1);
    for (int dir = 0; dir < 2; ++dir) {
        const int gp = (dir * 32 + g) * 64 + p;
        const float ar = are[gp], ai = aim[gp], dt = expf(logdt[dir * 32 + g]);
        const float er = expf(ar * dt), lbr = er * cosf(ai * dt), lbi = er * sinf(ai * dt);
        const float nr = lbr - 1.f, ni = lbi, den = ar * ar + ai * ai, qr = (nr * ar + ni * ai) / den, qi = (ni * ar - nr * ai) / den;
        float Br[16], Bi[16], Cr[16], Ci[16];
#pragma unroll
        for (int h = 0; h < 16; ++h) { const float x0 = bre[(size_t)gp * 16 + h], x1 = bim[(size_t)gp * 16 + h]; Br[h] = qr * x0 - qi * x1; Bi[h] = qr * x1 + qi * x0;
            Cr[h] = cre[((size_t)(dir * 32 + g) * 16 + h) * 64 + p]; Ci[h] = cim[((size_t)(dir * 32 + g) * 16 + h) * 64 + p]; }
        float xr = 0.f, xi = 0.f;
        for (int s = 0; s < LC + L; ++s) {
            int row; if (dir == 0) row = s < LC ? b * LC + s : TC + b * L + (s - LC); else row = s < LC ? b * LC + (LC - 1 - s) : TC + b * L + (L - 1 - (s - LC));
            const bf16_t* up = UX + ux_index(g, row, 0);
            float u[16];
#pragma unroll
            for (int h = 0; h < 16; ++h) u[h] = bf2f(up[h]);
            float bur = 0.f, bui = 0.f;
#pragma unroll
            for (int h = 0; h < 16; ++h) { bur += Br[h] * u[h]; bui += Bi[h] * u[h]; }
            const float nxr = lbr * xr - lbi * xi + bur, nxi = lbr * xi + lbi * xr + bui; xr = nxr; xi = nxi;
            float v[16];
#pragma unroll
            for (int h = 0; h < 16; ++h) v[h] = Cr[h] * xr - Ci[h] * xi;
#pragma unroll
            for (int st = 0; st < 4; ++st) { const int n = 8 >> st, off = 32 >> st; const bool hi = (lane & off) != 0;
#pragma unroll
                for (int j = 0; j < 8; ++j) if (j < n) { const float mine = hi ? v[j + n] : v[j]; const float other = hi ? v[j] : v[j + n]; v[j] = mine + __shfl_xor(other, off); } }
            float val = v[0]; val += __shfl_xor(val, 2); val += __shfl_xor(val, 1);
            if ((lane & 3) == 0) { const size_t o = (size_t)row * 512 + g * 16 + hh;
                if (dir == 0) Yacc[o] = val; else { const float y = Yacc[o] + val + dsk[g * 16 + hh] * bf2f(up[hh]); YS[(size_t)row * 1024 + 512 + g * 16 + hh] = f2bf(geluf_(y)); } }
        }
    }
}
__global__ void k_moe_zero(int* cnt, int* rowtok) { const int i = blockIdx.x * blockDim.x + threadIdx.x; if (i < 16) cnt[i] = 0; if (i < MOEROWS) rowtok[i] = -1; }
__global__ __launch_bounds__(256) void k_moe_count(const int* tok_e, int* cnt, int* tok_pos) {
    __shared__ int lc[8], lb[8];
    if (threadIdx.x < 8) lc[threadIdx.x] = 0; __syncthreads();
    const int i = blockIdx.x * 256 + threadIdx.x;
    const int e = tok_e[i]; const int lp = atomicAdd(&lc[e], 1); __syncthreads();
    if (threadIdx.x < 8) lb[threadIdx.x] = atomicAdd(&cnt[threadIdx.x], lc[threadIdx.x]); __syncthreads();
    tok_pos[i] = lb[e] + lp;
}
__global__ __launch_bounds__(256) void k_moe_place(const int* tok_e, const int* cnt, const int* tok_pos, int* tok_row, int* rowtok, int* tile_e) {
    int base[9]; base[0] = 0;
#pragma unroll
    for (int e = 0; e < 8; ++e) base[e + 1] = base[e] + ((cnt[e] + 255) & ~255);
    const int i = blockIdx.x * 256 + threadIdx.x; const int e = tok_e[i];
    int bs = 0;
#pragma unroll
    for (int k = 0; k < 8; ++k) if (k == e) bs = base[k];
    const int row = bs + tok_pos[i]; tok_row[i] = row; rowtok[row] = i >> 1;
    if (i < MOETILES) { int te = -1;
#pragma unroll
        for (int k = 0; k < 8; ++k) if (i * 256 >= base[k] && i * 256 < base[k + 1]) te = k;
        tile_e[i] = te; }
}
__global__ __launch_bounds__(256) void k_final(float* h, const float* mod, const float* O, const int* tok_row, const float* tok_w, const float* fg, float* out) {
    const int lane = threadIdx.x & 63; const int t = blockIdx.x * 4 + (threadIdx.x >> 6); const int cond = t / L;
    const float* g2 = mod + (size_t)cond * 6144 + 5 * 1024; const int r1 = tok_row[t * 2], r2 = tok_row[t * 2 + 1]; const float w1 = tok_w[t * 2], w2 = tok_w[t * 2 + 1];
    float4 v[4]; float ss = 0.f;
#pragma unroll
    for (int j = 0; j < 4; ++j) { const int k = j * 256 + lane * 4; const float4 hv = *(const float4*)(h + (size_t)t * D + k), a = *(const float4*)(O + (size_t)r1 * D + k), b = *(const float4*)(O + (size_t)r2 * D + k), gg = *(const float4*)(g2 + k);
        v[j].x = hv.x + gg.x * (w1 * a.x + w2 * b.x); v[j].y = hv.y + gg.y * (w1 * a.y + w2 * b.y); v[j].z = hv.z + gg.z * (w1 * a.z + w2 * b.z); v[j].w = hv.w + gg.w * (w1 * a.w + w2 * b.w);
        ss += v[j].x * v[j].x + v[j].y * v[j].y + v[j].z * v[j].z + v[j].w * v[j].w; }
    ss = wave_sum(ss); const float rstd = rsqrtf(ss * (1.f / D) + EPS);
#pragma unroll
    for (int j = 0; j < 4; ++j) { const int k = j * 256 + lane * 4; const float4 gg = *(const float4*)(fg + k); float4 o; o.x = v[j].x * rstd * gg.x; o.y = v[j].y * rstd * gg.y; o.z = v[j].z * rstd * gg.z; o.w = v[j].w * rstd * gg.w;
        *(float4*)(out + (size_t)t * D + k) = o; }
}
}


namespace mk {
#define LAS __attribute__((address_space(3)))
typedef short bf16x8 __attribute__((ext_vector_type(8)));
typedef float f32x4 __attribute__((ext_vector_type(4)));
typedef float f32x2 __attribute__((ext_vector_type(2)));
typedef unsigned u32x4 __attribute__((ext_vector_type(4)));
typedef unsigned u32x2 __attribute__((ext_vector_type(2)));
constexpr int BK = 64, HTB = 128 * BK * 2, STAGE_BYTES = 8 * HTB;
constexpr int MISC_OFF = STAGE_BYTES + 320, LDS_BYTES = 147456;
constexpr int NPH = 25;

#define XB_TMO      128
#define XB_XCNT(j)  (256  + 64 * (j))
#define XB_XSUB(j)  (1280 + 64 * (j))
#define XB_XGEN(j)  (2304 + 64 * (j))
#define XB_TOP      3328
#define XB_TOPGEN   3392
#define XCD_BAR_WORDS 3456
#define XB_SPIN_CAP (1u << 18)
__device__ __forceinline__ unsigned xb_ld(unsigned* p)              { return __hip_atomic_load(p, __ATOMIC_RELAXED, __HIP_MEMORY_SCOPE_AGENT); }
__device__ __forceinline__ unsigned xb_add(unsigned* p, unsigned v) { return __hip_atomic_fetch_add(p, v, __ATOMIC_RELAXED, __HIP_MEMORY_SCOPE_AGENT); }
__device__ __forceinline__ unsigned xb_xcc_id() { return (unsigned)__builtin_amdgcn_s_getreg((3 << 11) | 20) & 0xFu; }
#define XB_SPIN(cond, bar) do { unsigned _sp = 0; while (cond) { __builtin_amdgcn_s_sleep(1); \
    if ((++_sp & 255u) == 0u) { if (xb_ld(&(bar)[XB_TMO])) break; if (_sp > XB_SPIN_CAP) { atomicAdd(&(bar)[XB_TMO], 1u); break; } } } } while (0)
struct XcdBarrier { unsigned* bar; unsigned x; volatile LAS unsigned* st; };
__device__ __forceinline__ XcdBarrier xcd_barrier_post(unsigned* bar, volatile LAS unsigned* st) {
    XcdBarrier b; b.bar = bar; b.x = xb_xcc_id(); b.st = st;
    if (threadIdx.x == 0) (void)xb_add(&bar[XB_XCNT(b.x)], 1u);
    return b;
}
__device__ __forceinline__ void xcd_barrier_complete(unsigned* bar, unsigned x, unsigned& nloc, unsigned& nx) {
    const unsigned G = gridDim.x * gridDim.y * gridDim.z;
    unsigned sum, cnt, mine, sp = 0u;
    for (;;) {
        sum = 0u; cnt = 0u; mine = 0u;
#pragma unroll
        for (unsigned j = 0; j < 16; ++j) { const unsigned c = xb_ld(&bar[XB_XCNT(j)]); sum += c; cnt += (c > 0u) ? 1u : 0u; mine = (j == x) ? c : mine; }
        if (sum == G) break;
        __builtin_amdgcn_s_sleep(1);
        if ((++sp & 255u) == 0u) { if (xb_ld(&bar[XB_TMO])) break; if (sp > XB_SPIN_CAP) { atomicAdd(&bar[XB_TMO], 1u); break; } }
    }
    nloc = mine > 0u ? mine : 1u; nx = cnt > 0u ? cnt : 1u;
}
__device__ __forceinline__ void xcd_barrier(const XcdBarrier& b) {
    asm volatile("s_waitcnt vmcnt(0)" ::: "memory");
    __syncthreads();
    if (threadIdx.x == 0) {
        unsigned* bar = b.bar;
        __builtin_amdgcn_s_waitcnt(0);
        unsigned nloc = b.st[0], nx = b.st[1];
        if (nloc == 0u) { xcd_barrier_complete(bar, b.x, nloc, nx); b.st[0] = nloc; b.st[1] = nx; }
        const unsigned old = xb_add(&bar[XB_XSUB(b.x)], 1u);
        const unsigned gen = old / nloc;
        if (old + 1u == (gen + 1u) * nloc) {
            __builtin_amdgcn_fence(__ATOMIC_RELEASE, "agent");
            asm volatile("s_waitcnt vmcnt(0)" ::: "memory");
            const unsigned og = xb_add(&bar[XB_TOP], 1u);
            const unsigned tg = og / nx;
            if (og + 1u == (tg + 1u) * nx) xb_add(&bar[XB_TOPGEN], 1u);
            else XB_SPIN(xb_ld(&bar[XB_TOPGEN]) == tg, bar);
            __builtin_amdgcn_fence(__ATOMIC_ACQUIRE, "agent");
            xb_add(&bar[XB_XGEN(b.x)], 1u);
            asm volatile("s_waitcnt vmcnt(0)" ::: "memory");
        } else {
            XB_SPIN(xb_ld(&bar[XB_XGEN(b.x)]) == gen, bar);
            __builtin_amdgcn_fence(__ATOMIC_ACQUIRE, "agent");
            asm volatile("s_waitcnt vmcnt(0)" ::: "memory");
        }
    }
    __syncthreads();
}

__device__ __forceinline__ int lds_byte(int r, int c) { const int st = (r >> 4) * 2 + (c >> 5), rr = r & 15, cc = c & 31, ob = rr * 64 + cc * 2; return st * 1024 + (ob ^ (((ob >> 9) & 1) << 5)); }
__device__ __forceinline__ void stage_rc(int b, int& R, int& C) { const int st = b / 1024, sb = b % 1024, swz = sb ^ (((sb >> 9) & 1) << 5); R = (st >> 1) * 16 + swz / 64; C = (st & 1) * 32 + (swz % 64) / 2; }
__device__ __forceinline__ int perm32(int rho) { const int n = rho >> 4, i = rho & 15; return 8 * (i >> 2) + 4 * n + (i & 3); }
typedef __bf16 bf16x2_t __attribute__((ext_vector_type(2)));
__device__ __forceinline__ unsigned cvt_pk_bf16(float lo, float hi) { const f32x2 v = {lo, hi}; return __builtin_bit_cast(unsigned, __builtin_convertvector(v, bf16x2_t)); }
__device__ __forceinline__ u32x4 pack8(const f32x4 a, const f32x4 b) { u32x4 w; w.x = cvt_pk_bf16(a[0], a[1]); w.y = cvt_pk_bf16(a[2], a[3]); w.z = cvt_pk_bf16(b[0], b[1]); w.w = cvt_pk_bf16(b[2], b[3]); return w; }
__device__ __forceinline__ float bflo(unsigned w) { return __uint_as_float(w << 16); }
__device__ __forceinline__ float bfhi(unsigned w) { return __uint_as_float(w & 0xffff0000u); }
__device__ __forceinline__ void unpack8(const u32x4 w, f32x4& a, f32x4& b) { a[0] = bflo(w.x); a[1] = bfhi(w.x); a[2] = bflo(w.y); a[3] = bfhi(w.y); b[0] = bflo(w.z); b[1] = bfhi(w.z); b[2] = bflo(w.w); b[3] = bfhi(w.w); }
__device__ __forceinline__ float fsigmoid(float v) { return __builtin_amdgcn_rcpf(1.f + __expf(-v)); }
__device__ __forceinline__ float fgelu(float v) { return v * fsigmoid(1.5957691216057308f * (v + 0.044715f * v * v * v)); }

struct Unit { const char* A; const char* B; unsigned lda2, ldb2; int nt, perm, kind, z, pm, pn; };
struct Job { const char* A; const char* B; size_t zA, zB, eB; const LAS int* tlut; unsigned lda2, ldb2; int nt, nM, nN, nZ, perm, kind, pm0, pn0; };
__device__ __forceinline__ Job mkjob(const void* A, const void* B, size_t zA, size_t zB, unsigned lda2, unsigned ldb2, int nt, int nM, int nN, int nZ, int perm, int kind, int pm0, int pn0) {
    Job j; j.A = (const char*)A; j.B = (const char*)B; j.zA = zA; j.zB = zB; j.eB = 0; j.tlut = nullptr; j.lda2 = lda2; j.ldb2 = ldb2; j.nt = nt; j.nM = nM; j.nN = nN; j.nZ = nZ; j.perm = perm; j.kind = kind; j.pm0 = pm0; j.pn0 = pn0; return j; }
template <int NJ> struct JobSched {
    Job j[NJ]; int cnt[NJ]; int total, G, c;
    __device__ __forceinline__ void init(int G_, int c_) { total = 0;
#pragma unroll
        for (int k = 0; k < NJ; ++k) { cnt[k] = j[k].nZ * j[k].nM * j[k].nN; total += cnt[k]; }
        G = G_; c = c_; }
    __device__ __forceinline__ bool next(int i, Unit& u) const {
        const long Lq = (long)i * G + c; if (Lq >= total) return false;
        int w = (int)Lq; { const int q = total / 8, r = total % 8, xcd = w % 8, off = w / 8; w = (xcd < r ? xcd * (q + 1) : r * (q + 1) + (xcd - r) * q) + off; }
        Job J = j[0];
        int ww = w; bool done = false;
#pragma unroll
        for (int k = 0; k < NJ; ++k) { if (!done) { if (ww < cnt[k] || k == NJ - 1) { J = j[k]; done = true; } else ww -= cnt[k]; } }
        const int per = J.nM * J.nN; const int z = ww / per, rem = ww - z * per;
        const int nig = 8 * J.nN, gid = rem / nig, fm = gid * 8, gsz = (J.nM - fm) < 8 ? (J.nM - fm) : 8, rr = rem - gid * nig;
        const int pm = J.pm0 + fm + (rr % gsz), pn = J.pn0 + rr / gsz;
        u.A = J.A + (size_t)z * J.zA + (size_t)pm * 256 * J.lda2;
        u.B = J.B + (size_t)z * J.zB + (size_t)pn * 256 * J.ldb2 + (J.tlut ? (size_t)J.tlut[pm] * J.eB : (size_t)0);
        u.lda2 = J.lda2; u.ldb2 = J.ldb2; u.nt = J.nt; u.perm = J.perm; u.kind = J.kind; u.z = z; u.pm = pm; u.pn = pn;
        { unsigned long long pa = (unsigned long long)u.A, pb = (unsigned long long)u.B;
          pa = ((unsigned long long)(unsigned)__builtin_amdgcn_readfirstlane((int)(pa >> 32)) << 32) | (unsigned)__builtin_amdgcn_readfirstlane((int)(unsigned)pa);
          pb = ((unsigned long long)(unsigned)__builtin_amdgcn_readfirstlane((int)(pb >> 32)) << 32) | (unsigned)__builtin_amdgcn_readfirstlane((int)(unsigned)pb);
          u.A = (const char*)pa; u.B = (const char*)pb; u.lda2 = (unsigned)__builtin_amdgcn_readfirstlane((int)u.lda2); u.ldb2 = (unsigned)__builtin_amdgcn_readfirstlane((int)u.ldb2);
          u.nt = __builtin_amdgcn_readfirstlane(u.nt); u.perm = __builtin_amdgcn_readfirstlane(u.perm); u.kind = __builtin_amdgcn_readfirstlane(u.kind); u.z = __builtin_amdgcn_readfirstlane(u.z);
          u.pm = __builtin_amdgcn_readfirstlane(u.pm); u.pn = __builtin_amdgcn_readfirstlane(u.pn); }
        return true;
    }
};

template <class Epi, class Sched>
__device__ __forceinline__ void gemm_phase(LAS unsigned char* lds, const Sched& S, const Epi& E) {
    int tid = threadIdx.x; asm volatile("" : "+v"(tid));
    const int wid = __builtin_amdgcn_readfirstlane(tid >> 6), lane = tid & 63, wr = wid >> 2, wc = wid & 3, fr = lane & 15, fq = lane >> 4;
    int R0, C0; stage_rc(tid * 16, R0, C0);
    const int Rp0 = (R0 & ~31) + perm32(R0 & 31);
    const unsigned ldsw = (unsigned)wid * 1024u;
    const int aoff = lds_byte(wr * 64 + fr, fq * 8), boff = lds_byte(wc * 32 + fr, fq * 8);
#define G_SA(b, h) (((b) * 2 + (h)) * HTB)
#define G_SB(b, h) ((4 + (b) * 2 + (h)) * HTB)
#define G_STAGE(bufoff, gbase, v0, s64) do { \
        __builtin_amdgcn_global_load_lds((const unsigned*)((const char*)(gbase) + (v0)), (LAS unsigned*)(lds + (bufoff) + ldsw), 16, 0, 0); \
        __builtin_amdgcn_global_load_lds((const unsigned*)((const char*)(gbase) + (s64) + (v0)), (LAS unsigned*)(lds + (bufoff) + ldsw + 8192), 16, 0, 0); } while (0)
#define G_LDA(dst, b, h) do { _Pragma("unroll") for (int m = 0; m < 4; ++m) _Pragma("unroll") for (int k = 0; k < 2; ++k) dst[m][k] = *(const LAS bf16x8*)(lds + G_SA(b, h) + aoff + m * 2048 + k * 1024); } while (0)
#define G_LDB(dst, b, h) do { _Pragma("unroll") for (int n = 0; n < 2; ++n) _Pragma("unroll") for (int k = 0; k < 2; ++k) dst[n][k] = *(const LAS bf16x8*)(lds + G_SB(b, h) + boff + n * 2048 + k * 1024); } while (0)
#define G_MMA(ai, bj, At, Bt) do { __builtin_amdgcn_s_setprio(1); _Pragma("unroll") for (int m = 0; m < 4; ++m) _Pragma("unroll") for (int n = 0; n < 2; ++n) _Pragma("unroll") for (int k = 0; k < 2; ++k) \
        acc[ai][bj][m][n] = __builtin_amdgcn_mfma_f32_16x16x32_bf16(Bt[n][k], At[m][k], acc[ai][bj][m][n], 0, 0, 0); __builtin_amdgcn_s_setprio(0); } while (0)
#define G_WAIT_V(n) asm volatile("s_waitcnt vmcnt(" #n ")" ::: "memory")
#define G_WAIT_L(n) asm volatile("s_waitcnt lgkmcnt(" #n ")" ::: "memory")
#define G_BAR __builtin_amdgcn_s_barrier()
#define G_SCHED __builtin_amdgcn_sched_barrier(0)
#define G_VOFF(u, a0, b0, ha, hb) do { a0 = (unsigned)R0 * (u).lda2 + (unsigned)C0 * 2u; b0 = (unsigned)((u).perm ? Rp0 : R0) * (u).ldb2 + (unsigned)C0 * 2u; ha = 128u * (u).lda2; hb = 128u * (u).ldb2; } while (0)
    Unit cur, nxt; int ui = 0;
    if (!S.next(0, cur)) return;
    f32x4 acc[2][2][4][2];
#pragma unroll
    for (int a = 0; a < 2; ++a)
#pragma unroll
        for (int b = 0; b < 2; ++b)
#pragma unroll
            for (int m = 0; m < 4; ++m)
#pragma unroll
                for (int n = 0; n < 2; ++n) acc[a][b][m][n] = (f32x4){0.f, 0.f, 0.f, 0.f};
    bf16x8 At[4][2], B0[2][2], B1[2][2];
    unsigned vA, vB, hA, hB; G_VOFF(cur, vA, vB, hA, hB);
    const char* cA = cur.A; const char* cB = cur.B;
    const size_t kstep = 128;
    G_STAGE(G_SB(0, 0), cB, vB, hB / 2); G_STAGE(G_SB(0, 1), cB + hB, vB, hB / 2); G_STAGE(G_SA(0, 0), cA, vA, hA / 2); G_STAGE(G_SA(0, 1), cA + hA, vA, hA / 2);
    if (wr == 1) G_BAR;
    G_WAIT_V(2); G_BAR;
    G_STAGE(G_SB(1, 0), cB + kstep, vB, hB / 2); G_STAGE(G_SA(1, 0), cA + kstep, vA, hA / 2); G_STAGE(G_SB(1, 1), cB + hB + kstep, vB, hB / 2);
    G_WAIT_V(6); G_BAR;
    for (;;) {
        const bool has_next = S.next(ui + 1, nxt);
        unsigned nvA = vA, nvB = vB, nhA = hA, nhB = hB; const char* nA = cA; const char* nB = cB;
        if (has_next) { G_VOFF(nxt, nvA, nvB, nhA, nhB); nA = nxt.A; nB = nxt.B; }
        const int nt = cur.nt;
        for (int t = 0; t < nt; t += 2) {
            const bool last = (t == nt - 2);
            const char* a1 = cA + (size_t)(t + 1) * kstep;
            const char* a2 = last ? nA : cA + (size_t)(t + 2) * kstep; const char* b2 = last ? nB : cB + (size_t)(t + 2) * kstep;
            const char* a3 = a2 + kstep; const char* b3 = b2 + kstep;
            const unsigned xA = last ? nvA : vA, xB = last ? nvB : vB, xhA = last ? nhA : hA, xhB = last ? nhB : hB;
            G_LDB(B0, 0, 0); G_LDB(B1, 0, 1); G_SCHED; G_LDA(At, 0, 0); G_STAGE(G_SA(1, 1), a1 + hA, vA, hA / 2);
            G_WAIT_V(8); G_WAIT_L(0); G_BAR; G_MMA(0, 0, At, B0); G_MMA(0, 1, At, B1); G_BAR; G_SCHED;
            G_LDA(At, 0, 1); G_STAGE(G_SB(0, 0), b2, xB, xhB / 2); G_STAGE(G_SB(0, 1), b2 + xhB, xB, xhB / 2); G_STAGE(G_SA(0, 0), a2, xA, xhA / 2);
            G_WAIT_V(8); G_WAIT_L(0); G_BAR; G_MMA(1, 0, At, B0); G_MMA(1, 1, At, B1); G_BAR; G_SCHED;
            G_LDB(B0, 1, 0); G_LDB(B1, 1, 1); G_SCHED; G_LDA(At, 1, 0); G_STAGE(G_SA(0, 1), a2 + xhA, xA, xhA / 2);
            G_WAIT_V(8); G_WAIT_L(0); G_BAR; G_MMA(0, 0, At, B0); G_MMA(0, 1, At, B1); G_BAR; G_SCHED;
            G_LDA(At, 1, 1); G_STAGE(G_SB(1, 0), b3, xB, xhB / 2); G_STAGE(G_SB(1, 1), b3 + xhB, xB, xhB / 2); G_STAGE(G_SA(1, 0), a3, xA, xhA / 2);
            G_WAIT_V(8); G_WAIT_L(0); G_BAR; G_MMA(1, 0, At, B0); G_MMA(1, 1, At, B1); G_BAR; G_SCHED;
        }
        if (wr == 0) G_BAR;
        E(acc, cur, wr, wc, fr, fq);
        if (!has_next) break;
#pragma unroll
        for (int a = 0; a < 2; ++a)
#pragma unroll
            for (int b = 0; b < 2; ++b)
#pragma unroll
                for (int m = 0; m < 4; ++m)
#pragma unroll
                    for (int n = 0; n < 2; ++n) acc[a][b][m][n] = (f32x4){0.f, 0.f, 0.f, 0.f};
        cur = nxt; cA = nA; cB = nB; vA = nvA; vB = nvB; hA = nhA; hB = nhB; ++ui;
        if (wr == 1) G_BAR;
    }
    G_WAIT_V(0);
    G_BAR;
#undef G_SA
#undef G_SB
#undef G_STAGE
#undef G_LDA
#undef G_LDB
#undef G_MMA
#undef G_WAIT_V
#undef G_WAIT_L
#undef G_BAR
#undef G_SCHED
#undef G_VOFF
}

#define EPI_ARGS const f32x4 (&acc)[2][2][4][2], const Unit& u, int wr, int wc, int fr, int fq
struct EpiInproj {
    bf16_t* UX; bf16_t* GT; bf16_t* VL; bf16_t* VC;
    __device__ __forceinline__ void operator()(EPI_ARGS) const {
        const int rb = u.pm * 256 + wr * 64 + fr, cb = u.pn * 256 + wc * 32 + 8 * fq;
#pragma unroll
        for (int ai = 0; ai < 2; ++ai)
#pragma unroll
            for (int m = 0; m < 4; ++m) { const int r = rb + ai * 128 + m * 16;
#pragma unroll
                for (int bj = 0; bj < 2; ++bj) { const int c0 = cb + bj * 128; f32x4 v0 = acc[ai][bj][m][0], v1 = acc[ai][bj][m][1];
                    if (u.kind == 0) {
                        if (u.pn < 2) { *(u32x4*)(UX + ux_index(c0 >> 4, r, c0 & 15)) = pack8(v0, v1); }
                        else {
#pragma unroll
                            for (int j = 0; j < 4; ++j) { v0[j] = fsigmoid(v0[j]); v1[j] = fsigmoid(v1[j]); }
                            *(u32x4*)(GT + (size_t)r * 2048 + (c0 - 512)) = pack8(v0, v1); }
                    } else { bf16_t* dst = (c0 < TC ? VC : VL) + vt2_index(c0, r & 511, r >> 9); *(u32x4*)dst = pack8(v0, v1); }
                } }
    }
};
struct EpiP3 {
    bf16_t* YS; float* S; float sl, sc;
    __device__ __forceinline__ void operator()(EPI_ARGS) const {
        const int rb = u.pm * 256 + wr * 64 + fr;
        if (u.kind == 2) { const int cb = wc * 32 + 4 * fq;
#pragma unroll
            for (int ai = 0; ai < 2; ++ai)
#pragma unroll
                for (int m = 0; m < 4; ++m) { float* rowp = S + ((size_t)u.z * CHR + rb + ai * 128 + m * 16) * 256 + cb;
#pragma unroll
                    for (int bj = 0; bj < 2; ++bj)
#pragma unroll
                        for (int n = 0; n < 2; ++n) *(f32x4*)(rowp + bj * 128 + n * 16) = acc[ai][bj][m][n]; }
        } else { const int cb = u.pn * 256 + wc * 32 + 8 * fq; const float s = u.kind == 0 ? sl : sc; const size_t row0 = u.kind == 0 ? (size_t)TC + (size_t)u.z * L : (size_t)u.z * LC;
#pragma unroll
            for (int ai = 0; ai < 2; ++ai)
#pragma unroll
                for (int m = 0; m < 4; ++m) { bf16_t* rowp = YS + (row0 + rb + ai * 128 + m * 16) * 1024 + cb;
#pragma unroll
                    for (int bj = 0; bj < 2; ++bj) *(u32x4*)(rowp + bj * 128) = pack8(acc[ai][bj][m][0] * s, acc[ai][bj][m][1] * s); }
        }
    }
};
struct EpiP5 {
    bf16_t* YS; const bf16_t* GT; bf16_t* TM;
    __device__ __forceinline__ void operator()(EPI_ARGS) const {
        const int rb = u.pm * 256 + wr * 64 + fr, cb = u.pn * 256 + wc * 32 + 8 * fq;
#pragma unroll
        for (int ai = 0; ai < 2; ++ai)
#pragma unroll
            for (int m = 0; m < 4; ++m) { const int r = rb + ai * 128 + m * 16;
#pragma unroll
                for (int bj = 0; bj < 2; ++bj) { const int c0 = cb + bj * 128; f32x4 v0 = acc[ai][bj][m][0], v1 = acc[ai][bj][m][1];
                    if (u.kind == 0) {
#pragma unroll
                        for (int j = 0; j < 4; ++j) { v0[j] = fgelu(v0[j]); v1[j] = fgelu(v1[j]); }
                        *(u32x4*)(YS + ((size_t)r * 16 + (c0 >> 4)) * 1024 + 512 + u.z * 16 + (c0 & 15)) = pack8(v0, v1);
                    } else { f32x4 g0, g1; unpack8(*(const u32x4*)(GT + (size_t)r * 2048 + c0), g0, g1); *(u32x4*)(TM + (size_t)r * 1024 + c0) = pack8(v0 * g0, v1 * g1); }
                } }
    }
};
struct EpiGlu {
    const bf16_t* GT; bf16_t* TM;
    __device__ __forceinline__ void operator()(EPI_ARGS) const {
        const int rb = u.pm * 256 + wr * 64 + fr, c0 = u.pn * 128 + wc * 32 + 8 * fq;
#pragma unroll
        for (int ai = 0; ai < 2; ++ai)
#pragma unroll
            for (int m = 0; m < 4; ++m) { const int r = rb + ai * 128 + m * 16;
                f32x4 g0, g1, t0, t1; unpack8(*(const u32x4*)(GT + (size_t)r * 2048 + 1024 + c0), g0, g1); unpack8(*(const u32x4*)(TM + (size_t)r * 1024 + c0), t0, t1);
                f32x4 a0 = acc[ai][0][m][0], a1 = acc[ai][0][m][1], b0 = acc[ai][1][m][0], b1 = acc[ai][1][m][1];
#pragma unroll
                for (int j = 0; j < 4; ++j) { t0[j] += g0[j] * a0[j] * fsigmoid(b0[j]); t1[j] += g1[j] * a1[j] * fsigmoid(b1[j]); }
                *(u32x4*)(TM + (size_t)r * 1024 + c0) = pack8(t0, t1); }
    }
};
struct EpiRes {
    float* h; float* z; const float* mod; int gidx;
    __device__ __forceinline__ void operator()(EPI_ARGS) const {
        const int rb = u.pm * 256 + wr * 64 + fr, cb = u.pn * 256 + wc * 32 + 4 * fq;
#pragma unroll
        for (int ai = 0; ai < 2; ++ai)
#pragma unroll
            for (int m = 0; m < 4; ++m) { const int r = rb + ai * 128 + m * 16; float* rowp = (r < TC ? z + (size_t)r * D : h + (size_t)(r - TC) * D) + cb;
                const float* gp = mod + (size_t)(r < TC ? 16 : (r - TC) >> 11) * 6144 + gidx * 1024 + cb;
#pragma unroll
                for (int bj = 0; bj < 2; ++bj)
#pragma unroll
                    for (int n = 0; n < 2; ++n) { const f32x4 gg = *(const f32x4*)(gp + bj * 128 + n * 16); f32x4 o = *(const f32x4*)(rowp + bj * 128 + n * 16); o += gg * acc[ai][bj][m][n]; *(f32x4*)(rowp + bj * 128 + n * 16) = o; }
                asm volatile("" ::: "memory"); }
    }
};
struct EpiSwiglu {
    bf16_t* H; int ld; int row0;
    __device__ __forceinline__ void operator()(EPI_ARGS) const {
        const int rb = u.pm * 256 + wr * 64 + fr - row0, c0 = u.pn * 128 + wc * 32 + 8 * fq;
#pragma unroll
        for (int ai = 0; ai < 2; ++ai)
#pragma unroll
            for (int m = 0; m < 4; ++m) { const int r = rb + ai * 128 + m * 16;
                f32x4 a0 = acc[ai][0][m][0], a1 = acc[ai][0][m][1]; const f32x4 b0 = acc[ai][1][m][0], b1 = acc[ai][1][m][1];
#pragma unroll
                for (int j = 0; j < 4; ++j) { a0[j] = a0[j] * fsigmoid(a0[j]) * b0[j]; a1[j] = a1[j] * fsigmoid(a1[j]) * b1[j]; }
                *(u32x4*)(H + (size_t)r * ld + c0) = pack8(a0, a1); }
    }
};
struct EpiBf {
    bf16_t* O; int ld;
    __device__ __forceinline__ void operator()(EPI_ARGS) const {
        const int rb = u.pm * 256 + wr * 64 + fr, cb = u.pn * 256 + wc * 32 + 8 * fq;
#pragma unroll
        for (int ai = 0; ai < 2; ++ai)
#pragma unroll
            for (int m = 0; m < 4; ++m) { bf16_t* rowp = O + (size_t)(rb + ai * 128 + m * 16) * ld + cb;
#pragma unroll
                for (int bj = 0; bj < 2; ++bj) *(u32x4*)(rowp + bj * 128) = pack8(acc[ai][bj][m][0], acc[ai][bj][m][1]); }
    }
};

struct Args { const float* in[30]; float* out; unsigned char* ws; int ph_lo, ph_hi, mask, pad; };
enum { I_X, I_C, I_CTX, I_CCTX, I_WMOD, I_BMOD, I_N1G, I_N2G, I_WIN, I_WFOUR, I_ARE, I_AIM, I_LOGDT, I_BRE, I_BIM, I_CRE, I_CIM, I_SSMD, I_GLUA, I_GLUB, I_WOUT, I_FG, I_FU, I_FD, I_MR, I_MBR, I_MG, I_MU, I_MD, I_FINALG };

__device__ __forceinline__ void tr_item(const float* W, int ldw, int k0, int n0, bf16_t* WT, int ldk, int drow0, LAS float* scr, int lane) {
#pragma unroll 8
    for (int i = 0; i < 32; ++i) { const int kk = 2 * i + (lane >> 5); scr[kk * 33 + (lane & 31)] = W[(size_t)(k0 + kk) * ldw + n0 + (lane & 31)]; }
    asm volatile("s_waitcnt lgkmcnt(0)" ::: "memory");
    const int c = lane & 7;
#pragma unroll
    for (int j = 0; j < 4; ++j) { const int n = (lane >> 3) + 8 * j; const LAS float* s = scr + (8 * c) * 33 + n;
        u32x4 o; o.x = cvt_pk_bf16(s[0 * 33], s[1 * 33]); o.y = cvt_pk_bf16(s[2 * 33], s[3 * 33]); o.z = cvt_pk_bf16(s[4 * 33], s[5 * 33]); o.w = cvt_pk_bf16(s[6 * 33], s[7 * 33]);
        *(u32x4*)(WT + (size_t)(drow0 + n) * ldk + k0 + 8 * c) = o; }
    asm volatile("s_waitcnt lgkmcnt(0)" ::: "memory");
}
__device__ __forceinline__ void tr_mat_item(const float* W, int K, int N, int ldw, int coff, bf16_t* WT, int roff, int mode, int it, LAS float* scr, int lane) {
    const int nblk = N / 32, kb = it / nblk, nb = it - kb * nblk, n0 = nb * 32;
    const int drow = mode == 0 ? roff + n0 : ((n0 >> 7) * 256 + (mode == 2 ? 128 : 0) + (n0 & 127));
    tr_item(W, ldw, kb * 64, coff + n0, WT, K, drow, scr, lane);
}

template <bool ROUTE>
__device__ __forceinline__ void norm_row(const float* src, const float* g, const float* sh, const float* sc, bf16_t* dst, int lane, const float* wr, const float* br, int& e1o, int& e2o, float& w1o) {
    f32x4 v[4]; float ss = 0.f;
#pragma unroll
    for (int j = 0; j < 4; ++j) { v[j] = *(const f32x4*)(src + j * 256 + lane * 4); ss += v[j][0] * v[j][0] + v[j][1] * v[j][1] + v[j][2] * v[j][2] + v[j][3] * v[j][3]; }
    ss = wave_sum(ss); const float rstd = rsqrtf(ss * (1.f / D) + EPS);
    float lg[8];
#pragma unroll
    for (int e = 0; e < 8; ++e) lg[e] = 0.f;
#pragma unroll
    for (int j = 0; j < 4; ++j) { const int k = j * 256 + lane * 4; const f32x4 gg = *(const f32x4*)(g + k), s1 = *(const f32x4*)(sc + k), s0 = *(const f32x4*)(sh + k);
        f32x4 a;
#pragma unroll
        for (int q = 0; q < 4; ++q) a[q] = v[j][q] * rstd * gg[q] * (1.f + s1[q]) + s0[q];
        u32x2 o; o.x = cvt_pk_bf16(a[0], a[1]); o.y = cvt_pk_bf16(a[2], a[3]); *(u32x2*)(dst + k) = o;
        if (ROUTE) {
#pragma unroll
            for (int q = 0; q < 4; ++q) { const f32x4 w0 = *(const f32x4*)(wr + (k + q) * 8), w1 = *(const f32x4*)(wr + (k + q) * 8 + 4);
#pragma unroll
                for (int e = 0; e < 4; ++e) { lg[e] += a[q] * w0[e]; lg[4 + e] += a[q] * w1[e]; } } } }
    if (ROUTE) {
#pragma unroll
        for (int e = 0; e < 8; ++e) lg[e] = wave_sum(lg[e]) + br[e];
        int e1 = 0; float v1 = lg[0];
#pragma unroll
        for (int e = 1; e < 8; ++e) if (lg[e] > v1) { v1 = lg[e]; e1 = e; }
        int e2 = -1; float v2 = -3.0e38f;
#pragma unroll
        for (int e = 0; e < 8; ++e) if (e != e1 && lg[e] > v2) { v2 = lg[e]; e2 = e; }
        e1o = e1; e2o = e2; w1o = 1.f / (1.f + expf(v2 - v1));
    }
}

__global__ void __launch_bounds__(512, 2) fwd(Args args) {
    extern __shared__ __attribute__((aligned(16))) unsigned char lds_raw[];
    LAS unsigned char* lds = (LAS unsigned char*)lds_raw;
    volatile LAS unsigned* MISC = (volatile LAS unsigned*)(lds + MISC_OFF);
    const int G = gridDim.x, bx = blockIdx.x, NGW = G * 8;
#define PHASE_IDS int tid = threadIdx.x; asm volatile("" : "+v"(tid)); const int lane = tid & 63, wave = __builtin_amdgcn_readfirstlane(tid >> 6), gw = bx * 8 + wave; (void)lane; (void)gw;
    unsigned char* ws = args.ws;
    unsigned* ctl = (unsigned*)(ws + WS_CTL);
    const int lo = args.ph_lo, hi = args.ph_hi, mask = args.mask;
    { PHASE_IDS for (int u = tid; u < (LDS_BYTES - STAGE_BYTES) / 4; u += 512) ((LAS unsigned*)(lds + STAGE_BYTES))[u] = 0u; }
    __syncthreads();
    XcdBarrier bar; bar.bar = ctl + CW_BAR; bar.x = 0; bar.st = nullptr;
    if (hi - lo > 1) bar = xcd_barrier_post(ctl + CW_BAR, MISC + 8);
#ifndef ONLYPH
#define ONLYPH -1
#endif
#define PHON(k) (ONLYPH < 0 || ONLYPH == (k))
#define IN(k) (lo <= (k) && (k) < hi)
#define SEAM(k) do { if (lo <= (k) && (k) + 1 < hi) xcd_barrier(bar); } while (0)

#define h (args.out)
#define zs ((float*)(ws + WS_Z))
#define mod ((float*)(ws + WS_MOD))
#define XA ((bf16_t*)(ws + WS_XA))
#define YS ((bf16_t*)(ws + WS_YS))
#define UX ((bf16_t*)(ws + WS_UX))
#define GT ((bf16_t*)(ws + WS_GT))
#define VL ((bf16_t*)(ws + WS_VT2L))
#define VC ((bf16_t*)(ws + WS_VT2C))
#define Sst ((float*)(ws + WS_S))
#define TM ((bf16_t*)(ws + WS_TM))
#define HID ((bf16_t*)(ws + WS_HID))
#define cnt ((int*)(ctl + CW_CNT))
#define tok_e ((int*)(ws + WS_TOKE))
#define tok_w ((float*)(ws + WS_TOKW))
#define tok_pos ((int*)(ws + WS_TOKPOS))
#define tok_row ((int*)(ws + WS_TOKROW))
#define tile_e ((int*)(ws + WS_TILEE))

    if (IN(0)) { PHASE_IDS
        LAS float* scr = (LAS float*)(lds + wave * 8448);
        if (bx < 64) {
            const int l = bx >> 5, g = bx & 31;
            LAS float* POWr = (LAS float*)(lds); LAS float* POWi = POWr + 2 * 64 * 17; LAS float* Bbr = POWi + 2 * 64 * 17; LAS float* Bbi = Bbr + 2048; LAS float* Cr = Bbi + 2048; LAS float* Ci = Cr + 2048; LAS float* Kt = Ci + 2048;
            if (tid < 128) { const int dir = tid >> 6, p = tid & 63; const int gp = ((l * 2 + dir) * 32 + g) * 64 + p;
                const float ar = args.in[I_ARE][gp], ai = args.in[I_AIM][gp], dt = expf(args.in[I_LOGDT][(l * 2 + dir) * 32 + g]); const float lr = ar * dt, li = ai * dt;
                for (int e = 0; e <= 16; ++e) { const float mg = expf(lr * e); POWr[(dir * 64 + p) * 17 + e] = mg * cosf(li * e); POWi[(dir * 64 + p) * 17 + e] = mg * sinf(li * e); }
                const float lbr = POWr[(dir * 64 + p) * 17 + 1], lbi = POWi[(dir * 64 + p) * 17 + 1];
                const float nr = lbr - 1.f, ni = lbi, den = ar * ar + ai * ai, qr = (nr * ar + ni * ai) / den, qi = (ni * ar - nr * ai) / den;
                for (int hh = 0; hh < 16; ++hh) { const float x0 = args.in[I_BRE][(size_t)gp * 16 + hh], x1 = args.in[I_BIM][(size_t)gp * 16 + hh]; Bbr[(dir * 64 + p) * 16 + hh] = qr * x0 - qi * x1; Bbi[(dir * 64 + p) * 16 + hh] = qr * x1 + qi * x0;
                    const size_t ci = ((size_t)((l * 2 + dir) * 32 + g) * 16 + hh) * 64 + p; Cr[(dir * 16 + hh) * 64 + p] = args.in[I_CRE][ci]; Ci[(dir * 16 + hh) * 64 + p] = args.in[I_CIM][ci]; }
                float* lamq = (float*)(ws + WS_LAMQ) + (size_t)gp * 2; lamq[0] = POWr[(dir * 64 + p) * 17 + 16]; lamq[1] = POWi[(dir * 64 + p) * 17 + 16];
            }
            __syncthreads();
            for (int o = tid; o < 8192; o += 512) { const int dir = o >> 12, tau = (o >> 8) & 15, hh = (o >> 4) & 15, h2 = o & 15; float s = 0.f;
                for (int p = 0; p < 64; ++p) { const float pr = POWr[(dir * 64 + p) * 17 + tau], pi = POWi[(dir * 64 + p) * 17 + tau], br_ = Bbr[(dir * 64 + p) * 16 + h2], bi_ = Bbi[(dir * 64 + p) * 16 + h2];
                    const float wr_ = pr * br_ - pi * bi_, wi_ = pr * bi_ + pi * br_; s += Cr[(dir * 16 + hh) * 64 + p] * wr_ - Ci[(dir * 16 + hh) * 64 + p] * wi_; }
                Kt[o] = s; }
            __syncthreads();
            bf16_t* TG = (bf16_t*)(ws + WS_S5TG + (size_t)l * S5_LSTRIDE) + (size_t)g * 256 * 512; bf16_t* EE = (bf16_t*)(ws + WS_S5E + (size_t)l * S5_LSTRIDE) + (size_t)g * 256 * 256;
            const float* dsk = args.in[I_SSMD] + l * 512 + g * 16;
            for (int o = tid; o < 256 * 512; o += 512) { const int row = o >> 9, k = o & 511, t = row >> 4, hh = row & 15; float val;
                if (k < 256) { const int s = k >> 4, h2 = k & 15; val = 0.f; if (s <= t) val += Kt[((0 * 16 + (t - s)) * 16 + hh) * 16 + h2]; if (s >= t) val += Kt[((1 * 16 + (s - t)) * 16 + hh) * 16 + h2]; if (s == t && hh == h2) val += dsk[hh]; }
                else { const int kk = k - 256, dir = kk >> 7, p = (kk >> 1) & 63, ri = kk & 1, e = dir == 0 ? t + 1 : 16 - t; const float cr = Cr[(dir * 16 + hh) * 64 + p], ci = Ci[(dir * 16 + hh) * 64 + p], pr = POWr[(dir * 64 + p) * 17 + e], pi = POWi[(dir * 64 + p) * 17 + e];
                    val = ri == 0 ? (cr * pr - ci * pi) : -(cr * pi + ci * pr); }
                TG[o] = f2bf(val); }
            for (int o = tid; o < 256 * 256; o += 512) { const int row = o >> 8, k = o & 255, dir = row >> 7, p = (row >> 1) & 63, ri = row & 1, s = k >> 4, h2 = k & 15, e = dir == 0 ? 15 - s : s;
                const float pr = POWr[(dir * 64 + p) * 17 + e], pi = POWi[(dir * 64 + p) * 17 + e], br_ = Bbr[(dir * 64 + p) * 16 + h2], bi_ = Bbi[(dir * 64 + p) * 16 + h2];
                EE[o] = f2bf(ri == 0 ? (pr * br_ - pi * bi_) : (pr * bi_ + pi * br_)); }
            __syncthreads();
        } else if (bx < 160) {
            const int it = bx - 64, l = it / 48, cb = it % 48; LAS float* sl = (LAS float*)(lds); LAS float* part = sl + 17 * 1024;
            for (int o = tid; o < 17 * 1024; o += 512) { const int r = o >> 10, k = o & 1023; const float v = r < 16 ? args.in[I_C][r * D + k] : args.in[I_CCTX][k]; sl[o] = v / (1.f + expf(-v)); }
            __syncthreads();
            const int col = cb * 128 + (tid & 127), kq = tid >> 7; const float* w = args.in[I_WMOD] + (size_t)l * D * 6144 + col;
            float a[17];
#pragma unroll
            for (int r = 0; r < 17; ++r) a[r] = 0.f;
            for (int k = kq * 256; k < kq * 256 + 256; ++k) { const float wv = w[(size_t)k * 6144];
#pragma unroll
                for (int r = 0; r < 17; ++r) a[r] += sl[r * 1024 + k] * wv; }
#pragma unroll
            for (int r = 0; r < 17; ++r) part[(kq * 17 + r) * 128 + (tid & 127)] = a[r];
            __syncthreads();
            for (int o = tid; o < 17 * 128; o += 512) { const int r = o >> 7, c = o & 127; const float s = part[(0 * 17 + r) * 128 + c] + part[(1 * 17 + r) * 128 + c] + part[(2 * 17 + r) * 128 + c] + part[(3 * 17 + r) * 128 + c];
                mod[((size_t)l * 17 + r) * 6144 + cb * 128 + c] = s + args.in[I_BMOD][l * 6144 + cb * 128 + c]; }
            __syncthreads();
        }
        { bf16_t* DL = (bf16_t*)(ws + WS_DFTL); bf16_t* DC = (bf16_t*)(ws + WS_DFTC);
          for (int o = bx * 512 + tid; o < 2048 * 512 + 256 * 64; o += G * 512) { const bool big = o < 2048 * 512; const int oo = big ? o : o - 2048 * 512; const int LL = big ? 2048 : 256, per = big ? 512 : 64;
              const int n = oo / per, k0 = (oo - n * per) * 8; const bool sn = k0 >= LL; const int kb = sn ? k0 - LL : k0; unsigned w[4];
#pragma unroll
              for (int q = 0; q < 4; ++q) { float v2[2];
#pragma unroll
                  for (int e = 0; e < 2; ++e) { const int idx = (n * (kb + 2 * q + e)) & (LL - 1); const float a = (float)idx * (2.0f / (float)LL); v2[e] = sn ? -sinpif(a) : cospif(a); }
                  w[q] = cvt_pk_bf16(v2[0], v2[1]); }
              u32x4 o4; o4.x = w[0]; o4.y = w[1]; o4.z = w[2]; o4.w = w[3]; *(u32x4*)((big ? DL : DC) + (size_t)n * (2 * LL) + k0) = o4; } }
        { LAS float* ct = (LAS float*)(lds + 67584);
          if (tid < 256) ct[tid] = tid < 128 ? cospif((float)tid / 64.f) : sinpif((float)(tid - 128) / 64.f);
          __syncthreads();
          for (int o = bx * 512 + tid; o < 2 * 1024 * 1024; o += G * 512) { const int l = o >> 20, j = (o >> 10) & 1023, k = o & 1023, type = j >> 9, g = (j >> 7) & 3, kp = j & 127;
              const float* wrow = args.in[I_WIN] + (size_t)l * D * INC + (size_t)k * INC + g * 128; float s = 0.f;
#pragma unroll 4
              for (int c = 0; c < 128; c += 4) { const f32x4 wv = *(const f32x4*)(wrow + c);
#pragma unroll
                  for (int q = 0; q < 4; ++q) s += wv[q] * ct[type * 128 + (((c + q) * kp) & 127)]; }
              ((bf16_t*)(ws + WS_MIXW + (size_t)l * MIXW_LSTRIDE))[(size_t)j * 1024 + k] = f2bf(s); } }
        { constexpr int I_SG = 16 * 80, I_4 = 8 * 32, I_GL = 8 * 32, I_O = 16 * 32, PERL = I_SG + I_4 + 2 * I_GL + I_O, I_FGU = 16 * 88, I_FDN = 44 * 32, NIT = 2 * PERL + 2 * I_FGU + I_FDN;
          for (int it = gw; it < NIT; it += NGW) { int r = it;
              if (r < 2 * PERL) { const int l = r / PERL; r -= l * PERL; unsigned char* mw = ws + WS_MIXW + (size_t)l * MIXW_LSTRIDE;
                  if (r < I_SG) { tr_mat_item(args.in[I_WIN] + (size_t)l * D * INC, 1024, 2560, INC, 512, (bf16_t*)(mw + 2 * MiB), 0, 0, r, scr, lane); continue; } r -= I_SG;
                  if (r < I_4) { tr_mat_item(args.in[I_WFOUR] + (size_t)l * 512 * D, 512, 1024, D, 0, (bf16_t*)(mw + 7 * MiB), 0, 0, r, scr, lane); continue; } r -= I_4;
                  if (r < I_GL) { tr_mat_item(args.in[I_GLUA] + (size_t)l * 512 * D, 512, 1024, D, 0, (bf16_t*)(mw + 8 * MiB), 0, 1, r, scr, lane); continue; } r -= I_GL;
                  if (r < I_GL) { tr_mat_item(args.in[I_GLUB] + (size_t)l * 512 * D, 512, 1024, D, 0, (bf16_t*)(mw + 8 * MiB), 0, 2, r, scr, lane); continue; } r -= I_GL;
                  tr_mat_item(args.in[I_WOUT] + (size_t)l * D * D, 1024, 1024, D, 0, (bf16_t*)(mw + 10 * MiB), 0, 0, r, scr, lane); continue; }
              r -= 2 * PERL;
              if (r < I_FGU) { tr_mat_item(args.in[I_FG], 1024, DFF, DFF, 0, (bf16_t*)(ws + WS_WGU), 0, 1, r, scr, lane); continue; } r -= I_FGU;
              if (r < I_FGU) { tr_mat_item(args.in[I_FU], 1024, DFF, DFF, 0, (bf16_t*)(ws + WS_WGU), 0, 2, r, scr, lane); continue; } r -= I_FGU;
              tr_mat_item(args.in[I_FD], DFF, 1024, D, 0, (bf16_t*)(ws + WS_WDN), 0, 0, r, scr, lane); } }
        for (int o = bx * 512 + tid; o < L * 256; o += G * 512) { const int n = o >> 8, d0 = (o & 255) * 4; const int q = d0 >> 8; const float base = q < 2 ? (float)(n >> 6) : (float)(n & 63); f32x4 pv;
#pragma unroll
            for (int e = 0; e < 4; ++e) { const float omega = 1.0f / powf(10000.f, (float)((d0 + e) & 255) / 256.f); const float ang = base * omega; pv[e] = (q & 1) ? cosf(ang) : sinf(ang); }
#pragma unroll 4
            for (int b = 0; b < NB; ++b) { const size_t idx = ((size_t)b * L + n) * D + d0; *(f32x4*)(h + idx) = *(const f32x4*)(args.in[I_X] + idx) + pv; } }
        for (int o = bx * 512 + tid; o < TC * 256; o += G * 512) *(f32x4*)(zs + (size_t)o * 4) = *(const f32x4*)(args.in[I_CTX] + (size_t)o * 4);
    }
    SEAM(0);

    for (int l = 0; l < 2; ++l) {
        const int pb = 1 + 10 * l; const float* modl = mod + (size_t)l * 17 * 6144; const bool need_ctx = (l == 0);
        unsigned char* mw = ws + WS_MIXW + (size_t)l * MIXW_LSTRIDE;
        const int tile0 = need_ctx ? 0 : 16, ntile = 144 - tile0;
        if (IN(pb + 0)) { PHASE_IDS const float* g1 = args.in[I_N1G] + l * D;
            for (int r = gw; r < TT; r += NGW) { const float* src = r < TC ? zs + (size_t)r * D : h + (size_t)(r - TC) * D; const float* mc = modl + (size_t)(r < TC ? 16 : (r - TC) >> 11) * 6144; int e1, e2; float w1;
                norm_row<false>(src, g1, mc, mc + 1024, XA + (size_t)r * D, lane, nullptr, nullptr, e1, e2, w1); } }
        SEAM(pb + 0);
        if (PHON(1) && IN(pb + 1)) { JobSched<3> S;
            S.j[0] = mkjob(XA, mw + 2 * MiB, 0, 0, 2048, 2048, 16, (mask & 0x1000) ? 0 : ntile, 10, 1, 1, 0, tile0, 0);
            S.j[1] = mkjob(XA, mw + 2 * MiB, 0, 0, 2048, 2048, 16, (need_ctx || (mask & 0x1000)) ? 0 : 16, 2, 1, 1, 0, 0, 0);
            S.j[2] = mkjob(mw, XA, 0, 0, 2048, 2048, 16, (mask & 0x2000) ? 0 : 4, ntile, 1, 1, 1, 0, tile0);
            S.init(G, bx); EpiInproj E{UX, GT, VL, VC}; gemm_phase(lds, S, E); }
        SEAM(pb + 1);
        if (PHON(2) && IN(pb + 2)) { JobSched<3> S;
            S.j[0] = mkjob(ws + WS_DFTL, VL, 0, (size_t)512 * 4096 * 2, 8192, 8192, 64, 8, 2, (mask & F_FOUR) ? NB : 0, 1, 0, 0, 0);
            S.j[1] = mkjob(ws + WS_DFTC, VC, 0, (size_t)512 * 512 * 2, 1024, 1024, 8, 1, 2, ((mask & F_FOUR) && need_ctx) ? NB : 0, 1, 1, 0, 0);
            S.j[2] = mkjob(UX, ws + WS_S5E + (size_t)l * S5_LSTRIDE, (size_t)CHR * 512 * 2, (size_t)256 * 256 * 2, 1024, 512, 4, 9, 1, (mask & F_S5) ? 32 : 0, 0, 2, 0, 0);
            S.init(G, bx); EpiP3 E{YS, Sst, 1.0f / sqrtf((float)L * 128.f), 1.0f / sqrtf((float)LC * 128.f)}; gemm_phase(lds, S, E); }
        SEAM(pb + 2);
        if (IN(pb + 3) && (mask & F_S5)) { PHASE_IDS const int id = bx * 512 + tid;
            if (id < 65536) { const int p = id & 63, dir = (id >> 6) & 1, g = (id >> 7) & 31, b = id >> 12;
                const float* lq = (const float*)(ws + WS_LAMQ) + (size_t)(((l * 2 + dir) * 32 + g) * 64 + p) * 2; const float qr = lq[0], qi = lq[1];
                const float* __restrict__ Sp = Sst + (size_t)g * CHR * 256 + dir * 128 + p * 2; bf16_t* __restrict__ Xp = UX + (size_t)g * CHR * 512 + 256 + dir * 128 + p * 2;
                float xr = 0.f, xi = 0.f;
#pragma unroll 8
                for (int k = 0; k < 144; ++k) { const int r = dir == 0 ? (k < 16 ? b * 16 + k : 256 + b * 128 + (k - 16)) : (k < 16 ? b * 16 + 15 - k : 256 + b * 128 + 127 - (k - 16));
                    const f32x2 s = *(const f32x2*)(Sp + (size_t)r * 256); *(unsigned*)(Xp + (size_t)r * 512) = cvt_pk_bf16(xr, xi);
                    const float nr = qr * xr - qi * xi + s[0], ni = qr * xi + qi * xr + s[1]; xr = nr; xi = ni; } } }
        SEAM(pb + 3);
        if (PHON(4) && IN(pb + 4)) { JobSched<2> S;
            S.j[0] = mkjob(UX, ws + WS_S5TG + (size_t)l * S5_LSTRIDE, (size_t)CHR * 512 * 2, (size_t)256 * 512 * 2, 1024, 1024, 8, need_ctx ? 9 : 8, 1, (mask & F_S5) ? 32 : 0, 1, 0, need_ctx ? 0 : 1, 0);
            S.j[1] = mkjob(YS, mw + 7 * MiB, 0, 0, 2048, 1024, 8, ntile, 4, (mask & F_GLU) ? 1 : 0, 1, 1, tile0, 0);
            S.init(G, bx); EpiP5 E{YS, GT, TM}; gemm_phase(lds, S, E); }
        SEAM(pb + 4);
        if (PHON(5) && IN(pb + 5)) { JobSched<1> S; S.j[0] = mkjob(YS + 512, mw + 8 * MiB, 0, 0, 2048, 1024, 8, ntile, 8, 1, 1, 0, tile0, 0);
            S.init(G, bx); EpiGlu E{GT, TM}; gemm_phase(lds, S, E); }
        SEAM(pb + 5);
        if (PHON(6) && IN(pb + 6)) { JobSched<1> S; S.j[0] = mkjob(TM, mw + 10 * MiB, 0, 0, 2048, 2048, 16, ntile, 4, 1, 0, 0, tile0, 0);
            S.init(G, bx); EpiRes E{h, zs, modl, 2}; gemm_phase(lds, S, E); }
        SEAM(pb + 6);
        if (l == 0) {
            if (IN(pb + 7)) { PHASE_IDS const float* g2 = args.in[I_N2G] + l * D;
                for (int r = gw; r < TT; r += NGW) { const float* src = r < TC ? zs + (size_t)r * D : h + (size_t)(r - TC) * D; const float* mc = modl + (size_t)(r < TC ? 16 : (r - TC) >> 11) * 6144 + 3 * 1024; int e1, e2; float w1;
                    norm_row<false>(src, g2, mc, mc + 1024, XA + (size_t)r * D, lane, nullptr, nullptr, e1, e2, w1); } }
            SEAM(pb + 7);
            if (PHON(8) && IN(pb + 8)) { JobSched<1> S; S.j[0] = mkjob(XA, ws + WS_WGU, 0, 0, 2048, 2048, 16, 144, 22, 1, 1, 0, 0, 0);
                S.init(G, bx); EpiSwiglu E{HID, DFF, 0}; gemm_phase(lds, S, E); }
            SEAM(pb + 8);
            if (PHON(9) && IN(pb + 9)) { JobSched<1> S; S.j[0] = mkjob(HID, ws + WS_WDN, 0, 0, 2 * DFF, 2 * DFF, 44, 144, 4, 1, 0, 0, 0, 0);
                S.init(G, bx); EpiRes E{h, zs, modl, 5}; gemm_phase(lds, S, E); }
            SEAM(pb + 9);
        }
    }
    {
        const float* modl = mod + (size_t)17 * 6144; bf16_t* XS = (bf16_t*)(ws + WS_XS); bf16_t* HIDM = (bf16_t*)(ws + WS_HIDM); unsigned char* wmoe = ws + WS_WMOE;
        if (IN(18)) { PHASE_IDS const float* g2 = args.in[I_N2G] + D; LAS int* lcnt = (LAS int*)(lds + 69632);
            int lc[8];
#pragma unroll
            for (int e = 0; e < 8; ++e) lc[e] = 0;
            for (int t = gw; t < TL; t += NGW) { const float* mc = modl + (size_t)(t >> 11) * 6144 + 3 * 1024; int e1, e2; float w1;
                norm_row<true>(h + (size_t)t * D, g2, mc, mc + 1024, XA + (size_t)(TC + t) * D, lane, args.in[I_MR], args.in[I_MBR], e1, e2, w1);
                int p1 = 0, p2 = 0;
#pragma unroll
                for (int e = 0; e < 8; ++e) { if (e == e1) { p1 = lc[e]; lc[e]++; } }
#pragma unroll
                for (int e = 0; e < 8; ++e) { if (e == e2) { p2 = lc[e]; lc[e]++; } }
                if (lane == 0) { tok_e[t * 2] = e1; tok_e[t * 2 + 1] = e2; tok_w[t * 2] = w1; tok_w[t * 2 + 1] = 1.f - w1; tok_pos[t * 2] = p1; tok_pos[t * 2 + 1] = p2; } }
            { int mine = 0;
#pragma unroll
              for (int e = 0; e < 8; ++e) if (lane == e) mine = lc[e];
              if (lane < 8) lcnt[wave * 8 + lane] = mine; }
            __syncthreads();
            if (tid < 8) { int run = 0; for (int w = 0; w < 8; ++w) { const int c = lcnt[w * 8 + tid]; lcnt[64 + w * 8 + tid] = run; run += c; } lcnt[128 + tid] = atomicAdd(&cnt[tid], run); }
            __syncthreads();
            asm volatile("s_waitcnt vmcnt(0)" ::: "memory");
            for (int t = gw; t < TL; t += NGW) { if (lane == 0) { const int ea = tok_e[t * 2], eb = tok_e[t * 2 + 1]; tok_pos[t * 2] += lcnt[64 + wave * 8 + ea] + lcnt[128 + ea]; tok_pos[t * 2 + 1] += lcnt[64 + wave * 8 + eb] + lcnt[128 + eb]; } }
            __syncthreads();
            LAS float* scr = (LAS float*)(lds + wave * 8448);
            constexpr int I_G = 16 * 112, I_D = 56 * 32, PERE = 2 * I_G + I_D;
            for (int it = gw; it < 8 * PERE; it += NGW) { const int e = it / PERE; int r = it - e * PERE; bf16_t* wg = (bf16_t*)(wmoe + (size_t)e * 21 * MiB); bf16_t* wd = (bf16_t*)(wmoe + (size_t)e * 21 * MiB + 14 * MiB);
                if (r < I_G) { tr_mat_item(args.in[I_MG] + (size_t)e * D * DFE, 1024, DFE, DFE, 0, wg, 0, 1, r, scr, lane); continue; } r -= I_G;
                if (r < I_G) { tr_mat_item(args.in[I_MU] + (size_t)e * D * DFE, 1024, DFE, DFE, 0, wg, 0, 2, r, scr, lane); continue; } r -= I_G;
                tr_mat_item(args.in[I_MD] + (size_t)e * DFE * D, DFE, 1024, D, 0, wd, 0, 0, r, scr, lane); }
        }
        SEAM(18);
        if (IN(19)) { PHASE_IDS int base[9]; base[0] = 0;
#pragma unroll
            for (int e = 0; e < 8; ++e) base[e + 1] = base[e] + ((cnt[e] + 255) & ~255);
            if (bx == 0) { if (tid < MOETILES) { int te = 0;
#pragma unroll
                    for (int k = 0; k < 8; ++k) if (tid * 256 >= base[k]) te = k;
                    tile_e[tid] = te; }
                if (tid == 0) ctl[CW_NT] = (unsigned)(base[8] >> 8); }
            for (int i = gw; i < 2 * TL; i += NGW) { const int e = tok_e[i]; int bs = 0;
#pragma unroll
                for (int k = 0; k < 8; ++k) if (k == e) bs = base[k];
                const int row = bs + tok_pos[i]; if (lane == 0) tok_row[i] = row;
                const u32x4* src = (const u32x4*)(XA + (size_t)(TC + (i >> 1)) * D); u32x4* dst = (u32x4*)(XS + (size_t)row * D); dst[lane] = src[lane]; dst[64 + lane] = src[64 + lane]; } }
        SEAM(19);
        LAS int* tile_l = (LAS int*)(lds + STAGE_BYTES + 1024);
        if (hi > 20 && lo < 24) { PHASE_IDS if (tid < MOETILES) tile_l[tid] = tile_e[tid]; __syncthreads(); }
        for (int ps = 0; ps < 2; ++ps) {
            const int ph = 20 + 2 * ps;
            if (PHON(20) && IN(ph)) { const int ntl = (int)ctl[CW_NT]; const int t0 = ps * MOE_TP; int nm = ntl - t0; nm = nm < 0 ? 0 : (nm > MOE_TP ? MOE_TP : nm);
                JobSched<1> S; S.j[0] = mkjob(XS, wmoe, 0, 0, 2048, 2048, 16, nm, 28, 1, 1, 0, t0, 0); S.j[0].tlut = tile_l; S.j[0].eB = 21 * MiB;
                S.init(G, bx); EpiSwiglu E{HIDM, DFE, t0 * 256}; gemm_phase(lds, S, E); }
            SEAM(ph);
            if (PHON(21) && IN(ph + 1)) { const int ntl = (int)ctl[CW_NT]; const int t0 = ps * MOE_TP; int nm = ntl - t0; nm = nm < 0 ? 0 : (nm > MOE_TP ? MOE_TP : nm);
                JobSched<1> S; S.j[0] = mkjob((const char*)HIDM - (size_t)t0 * 256 * 2 * DFE, wmoe + 14 * MiB, 0, 0, 2 * DFE, 2 * DFE, 56, nm, 4, 1, 1, 0, t0, 0); S.j[0].tlut = tile_l; S.j[0].eB = 21 * MiB;
                S.init(G, bx); EpiBf E{XS, D}; gemm_phase(lds, S, E); }
            SEAM(ph + 1);
        }
        if (IN(24)) { PHASE_IDS const float* fg = args.in[I_FINALG];
            for (int t = gw; t < TL; t += NGW) { const float* g2 = modl + (size_t)(t >> 11) * 6144 + 5 * 1024; const int r1 = tok_row[t * 2], r2 = tok_row[t * 2 + 1]; const float w1 = tok_w[t * 2], w2 = tok_w[t * 2 + 1];
                f32x4 v[4]; float ss = 0.f;
#pragma unroll
                for (int j = 0; j < 4; ++j) { const int k = j * 256 + lane * 4; const f32x4 hv = *(const f32x4*)(h + (size_t)t * D + k), gg = *(const f32x4*)(g2 + k);
                    const u32x2 a = *(const u32x2*)(XS + (size_t)r1 * D + k), b = *(const u32x2*)(XS + (size_t)r2 * D + k);
                    const f32x4 av = {bflo(a.x), bfhi(a.x), bflo(a.y), bfhi(a.y)}, bv = {bflo(b.x), bfhi(b.x), bflo(b.y), bfhi(b.y)};
                    v[j] = hv + gg * (av * w1 + bv * w2); ss += v[j][0] * v[j][0] + v[j][1] * v[j][1] + v[j][2] * v[j][2] + v[j][3] * v[j][3]; }
                ss = wave_sum(ss); const float rstd = rsqrtf(ss * (1.f / D) + EPS);
#pragma unroll
                for (int j = 0; j < 4; ++j) { const int k = j * 256 + lane * 4; const f32x4 gg = *(const f32x4*)(fg + k); *(f32x4*)(h + (size_t)t * D + k) = v[j] * rstd * gg; } } }
    }
#undef IN
#undef SEAM
#undef h
#undef zs
#undef mod
#undef XA
#undef YS
#undef UX
#undef GT
#undef VL
#undef VC
#undef Sst
#undef TM
#undef HID
#undef cnt
#undef tok_e
#undef tok_w
#undef tok_pos
#undef tok_row
#undef tile_e
}
}

extern "C" void kernel_launch(void* const* d_in, const int* in_sizes, int n_in, void* d_out, int out_size, void* d_ws, size_t ws_size, hipStream_t stream) {
    const float* x = (const float*)d_in[0]; const float* c = (const float*)d_in[1]; const float* ctx = (const float*)d_in[2]; const float* cctx = (const float*)d_in[3];
    const float* wmod = (const float*)d_in[4]; const float* bmod = (const float*)d_in[5]; const float* n1g = (const float*)d_in[6]; const float* n2g = (const float*)d_in[7];
    const float* win = (const float*)d_in[8]; const float* wfour = (const float*)d_in[9];
    const float* are = (const float*)d_in[10]; const float* aim = (const float*)d_in[11]; const float* logdt = (const float*)d_in[12];
    const float* bre = (const float*)d_in[13]; const float* bim = (const float*)d_in[14]; const float* cre = (const float*)d_in[15]; const float* cim = (const float*)d_in[16];
    const float* ssmd = (const float*)d_in[17]; const float* glua = (const float*)d_in[18]; const float* glub = (const float*)d_in[19]; const float* wout = (const float*)d_in[20];
    const float* fgw = (const float*)d_in[21]; const float* fuw = (const float*)d_in[22]; const float* fdw = (const float*)d_in[23];
    const float* mrw = (const float*)d_in[24]; const float* mrb = (const float*)d_in[25]; const float* mgw = (const float*)d_in[26]; const float* muw = (const float*)d_in[27]; const float* mdw = (const float*)d_in[28];
    const float* finalg = (const float*)d_in[29];
    float* h = (float*)d_out; char* ws = (char*)d_ws;
    float* mod = (float*)(ws + WS_MOD); float* cosT = (float*)(ws + WS_COST); float* sinT = cosT + 2048;
    int* cnt = (int*)(ws + WS_CTL) + CW_CNT; int* tok_e = (int*)(ws + WS_TOKE); float* tok_w = (float*)(ws + WS_TOKW); int* tok_pos = (int*)(ws + WS_TOKPOS); int* tok_row = (int*)(ws + WS_TOKROW);
    int* tile_e = (int*)(ws + WS_TILEE); int* rowtok = (int*)(ws + WS_ROWTOK);
    float* z = (float*)(ws + WS_Z); bf16_t* XA = (bf16_t*)(ws + WS_XA); bf16_t* YS = (bf16_t*)(ws + WS_YS); bf16_t* UX = (bf16_t*)(ws + WS_UX); bf16_t* GT = (bf16_t*)(ws + WS_GT);
    bf16_t* VL = (bf16_t*)(ws + WS_VT2L); bf16_t* VC = (bf16_t*)(ws + WS_VT2C); bf16_t* TM = (bf16_t*)(ws + WS_TM); bf16_t* PF = (bf16_t*)(ws + WS_PF); bf16_t* T1 = (bf16_t*)(ws + WS_T1); bf16_t* T2 = (bf16_t*)(ws + WS_T2);
    float* Yacc = (float*)(ws + WS_YACC); bf16_t* HID = (bf16_t*)(ws + WS_HID); float* O = (float*)(ws + WS_NO); bf16_t* HQ = (bf16_t*)(ws + WS_NHQ);
    const int mask = FASTMASK;

    static int grid = 0;
    if (grid == 0) {
        int dev = 0, cus = 0; (void)hipGetDevice(&dev); (void)hipDeviceGetAttribute(&cus, hipDeviceAttributeMultiprocessorCount, dev);
        (void)hipFuncSetAttribute((const void*)mk::fwd, hipFuncAttributeMaxDynamicSharedMemorySize, mk::LDS_BYTES);
        int per_cu = 0; (void)hipOccupancyMaxActiveBlocksPerMultiprocessor(&per_cu, (const void*)mk::fwd, 512, mk::LDS_BYTES); (void)hipGetLastError();
        grid = cus > 0 ? cus : 256;
    }
    (void)hipMemsetAsync(ws + WS_CTL, 0, CTL_BYTES, stream);
    mk::Args a{};
    for (int i = 0; i < 30; ++i) a.in[i] = (const float*)d_in[i];
    a.out = h; a.ws = (unsigned char*)d_ws; a.mask = mask; a.pad = 0;
    auto fast = [&](int lo, int hi) { a.ph_lo = lo; a.ph_hi = hi; hipLaunchKernelGGL(mk::fwd, dim3(grid), dim3(512), mk::LDS_BYTES, stream, a); };
#if ONE_LAUNCH
    fast(0, mk::NPH);
#else
    hipLaunchKernelGGL(k_tables, dim3(8), dim3(256), 0, stream, cosT, sinT);
    if (mask & F_PRO) fast(0, 1);
    else { hipLaunchKernelGGL(k_mod, dim3(24, 17, 2), dim3(256), 0, stream, c, cctx, wmod, bmod, mod); hipLaunchKernelGGL(k_init, dim3(TL * D / 256), dim3(256), 0, stream, x, ctx, h, z); }
    for (int l = 0; l < 2; ++l) {
        const int pb = 1 + 10 * l; const float* modl = mod + (size_t)l * 17 * 6144; const bool need_ctx = (l == 0);
        if (mask & F_NORM) fast(pb, pb + 1);
        else hipLaunchKernelGGL(k_norm<false>, dim3(TT / 4), dim3(256), 0, stream, h, z, n1g + l * D, modl, 0, 1, XA, 0, TT, nullptr, nullptr, nullptr, nullptr);
        if (!(mask & F_INPROJ) || (mask & 0x3000)) {
            { LAbf la{XA, D, 0}; LBw lb{win + (size_t)l * D * INC, INC, 0}; EPinproj ep{PF, UX, GT}; hipLaunchKernelGGL((ngemm<LAbf, LBw, EPinproj>), dim3(INC / 64, TT / 64, 1), dim3(256), 0, stream, D, 0, la, lb, ep); }
            { LAbfZ la{PF, 512, 128}; LBdft128 lb{cosT, sinT}; EPzdft ep{VL, VC}; hipLaunchKernelGGL((ngemm<LAbfZ, LBdft128, EPzdft>), dim3(256 / 64, TT / 64, 4), dim3(256), 0, stream, 128, 0, la, lb, ep); }
        }
        if (mask & F_INPROJ) fast(pb + 1, pb + 2);
        if (mask & (F_FOUR | F_S5)) fast(pb + 2, pb + 3);
        if (!(mask & F_FOUR)) {
            { LAdftL<L> la{cosT, sinT}; LBvt2<L> lb{VL}; EPfour<L> ep{YS, TC, 1.0f / sqrtf((float)L * 128.f)}; hipLaunchKernelGGL((ngemm<LAdftL<L>, LBvt2<L>, EPfour<L>>), dim3(512 / 64, L / 64, NB), dim3(256), 0, stream, 2 * L, 0, la, lb, ep); }
            if (need_ctx) { LAdftL<LC> la{cosT, sinT}; LBvt2<LC> lb{VC}; EPfour<LC> ep{YS, 0, 1.0f / sqrtf((float)LC * 128.f)}; hipLaunchKernelGGL((ngemm<LAdftL<LC>, LBvt2<LC>, EPfour<LC>>), dim3(512 / 64, LC / 64, NB), dim3(256), 0, stream, 2 * LC, 0, la, lb, ep); }
        }
        if (mask & F_S5) fast(pb + 3, pb + 4);
        else hipLaunchKernelGGL(k_s5_naive, dim3(NB * 32), dim3(64), 0, stream, UX, are + l * 4096, aim + l * 4096, logdt + l * 64, bre + (size_t)l * 65536, bim + (size_t)l * 65536, cre + (size_t)l * 65536, cim + (size_t)l * 65536, ssmd + l * 512, Yacc, YS);
        if (mask & (F_S5 | F_GLU)) fast(pb + 4, pb + 5);
        const int r0 = need_ctx ? 0 : TC, nr = TT - r0;
        if (mask & F_GLU) fast(pb + 5, pb + 6);
        else {
            { LAbf la{YS + (size_t)r0 * 1024, 1024, 0}; LBw lb{wfour + (size_t)l * 512 * D, D, 0}; EPbf ep{T1 + (size_t)r0 * D, D, 0}; hipLaunchKernelGGL((ngemm<LAbf, LBw, EPbf>), dim3(D / 64, nr / 64, 1), dim3(256), 0, stream, 512, 0, la, lb, ep); }
            { LAbf la{YS + (size_t)r0 * 1024 + 512, 1024, 0}; LBw lb{glua + (size_t)l * 512 * D, D, 0}; EPbf ep{T2 + (size_t)r0 * D, D, 0}; hipLaunchKernelGGL((ngemm<LAbf, LBw, EPbf>), dim3(D / 64, nr / 64, 1), dim3(256), 0, stream, 512, 0, la, lb, ep); }
            { LAbf la{YS + (size_t)r0 * 1024 + 512, 1024, 0}; LBw lb{glub + (size_t)l * 512 * D, D, 0}; EPmerge ep{GT + (size_t)r0 * 2048, T1 + (size_t)r0 * D, T2 + (size_t)r0 * D, TM + (size_t)r0 * D}; hipLaunchKernelGGL((ngemm<LAbf, LBw, EPmerge>), dim3(D / 64, nr / 64, 1), dim3(256), 0, stream, 512, 0, la, lb, ep); }
        }
        if (mask & F_OUT) fast(pb + 6, pb + 7);
        else { LAbf la{TM + (size_t)r0 * D, D, 0}; LBw lb{wout + (size_t)l * D * D, D, 0}; EPres ep{h, z, modl, 2, r0}; hipLaunchKernelGGL((ngemm<LAbf, LBw, EPres>), dim3(D / 64, nr / 64, 1), dim3(256), 0, stream, D, 0, la, lb, ep); }
        if (l == 0) {
            if (mask & F_NORM) fast(pb + 7, pb + 8);
            else hipLaunchKernelGGL(k_norm<false>, dim3(TT / 4), dim3(256), 0, stream, h, z, n2g + l * D, modl, 3, 4, XA, 0, TT, nullptr, nullptr, nullptr, nullptr);
            if (mask & F_FFN) { fast(pb + 8, pb + 9); fast(pb + 9, pb + 10); }
            else {
                { LAbf la{XA, D, 0}; LBw lb{fgw, DFF, 0}; EPbf ep{HID, DFF, 0}; hipLaunchKernelGGL((ngemm<LAbf, LBw, EPbf>), dim3(DFF / 64, TT / 64, 1), dim3(256), 0, stream, D, 0, la, lb, ep); }
                { LAbf la{XA, D, 0}; LBw lb{fuw, DFF, 0}; EPswi ep{HID, DFF, 0}; hipLaunchKernelGGL((ngemm<LAbf, LBw, EPswi>), dim3(DFF / 64, TT / 64, 1), dim3(256), 0, stream, D, 0, la, lb, ep); }
                { LAbf la{HID, DFF, 0}; LBw lb{fdw, D, 0}; EPres ep{h, z, modl, 5, 0}; hipLaunchKernelGGL((ngemm<LAbf, LBw, EPres>), dim3(D / 64, TT / 64, 1), dim3(256), 0, stream, DFF, 0, la, lb, ep); }
            }
        } else if (mask & F_MOE) {
            for (int ph = 18; ph < 25; ++ph) fast(ph, ph + 1);
        } else {
            hipLaunchKernelGGL(k_moe_zero, dim3((MOEROWS + 255) / 256), dim3(256), 0, stream, cnt, rowtok);
            hipLaunchKernelGGL(k_norm<true>, dim3(TL / 4), dim3(256), 0, stream, h, z, n2g + l * D, modl, 3, 4, XA, TC, TL, mrw, mrb, tok_e, tok_w);
            hipLaunchKernelGGL(k_moe_count, dim3(TL * 2 / 256), dim3(256), 0, stream, tok_e, cnt, tok_pos);
            hipLaunchKernelGGL(k_moe_place, dim3(TL * 2 / 256), dim3(256), 0, stream, tok_e, cnt, tok_pos, tok_row, rowtok, tile_e);
            for (int q = 0; q < 4; ++q) {
                { LAgather la{XA + (size_t)TC * D, rowtok, tile_e}; LBmoe lb{mgw, tile_e, (size_t)D * DFE, DFE, q * 896, 0, 0}; EPbf ep{HQ, 896, 0}; hipLaunchKernelGGL((ngemm<LAgather, LBmoe, EPbf>), dim3(896 / 64, MOEROWS / 64, 1), dim3(256), 0, stream, D, 0, la, lb, ep); }
                { LAgather la{XA + (size_t)TC * D, rowtok, tile_e}; LBmoe lb{muw, tile_e, (size_t)D * DFE, DFE, q * 896, 0, 0}; EPswi ep{HQ, 896, 0}; hipLaunchKernelGGL((ngemm<LAgather, LBmoe, EPswi>), dim3(896 / 64, MOEROWS / 64, 1), dim3(256), 0, stream, D, 0, la, lb, ep); }
                { LAmoeh la{HQ, tile_e}; LBmoe lb{mdw, tile_e, (size_t)DFE * D, D, 0, q * 896, 0}; EPacc ep{O, q == 0, 0}; hipLaunchKernelGGL((ngemm<LAmoeh, LBmoe, EPacc>), dim3(D / 64, MOEROWS / 64, 1), dim3(256), 0, stream, 896, 0, la, lb, ep); }
            }
            hipLaunchKernelGGL(k_final, dim3(TL / 4), dim3(256), 0, stream, h, modl, O, tok_row, tok_w, finalg, (float*)d_out);
        }
    }
#endif
}
```

```cpp
#define FASTMASK 0x1FF
#define ONE_LAUNCH 1
#define RES16 1
#define DYNPRO 1
#define PRO_ORDER2 1
#define EARLY_INV 1
#define GLOBAL_REMAP 1
#include <hip/hip_runtime.h>
#include <stdint.h>
#include <math.h>

#ifndef FASTMASK
#define FASTMASK 0x0
#endif
#ifndef ONE_LAUNCH
#define ONE_LAUNCH 0
#endif

namespace {
typedef unsigned short bf16_t;
constexpr int D = 1024, NB = 16, L = 2048, LC = 256, TL = NB * L, TC = NB * LC, TT = TL + TC;
constexpr int INC = 3072, DFF = 2816, NE = 8, DFE = 3584, MOEROWS = 2 * TL + NE * 256, MOETILES = MOEROWS / 256;
constexpr int CHR = TT / 16;
constexpr float EPS = 1e-6f;
constexpr int F_PRO = 1, F_INPROJ = 2, F_FOUR = 4, F_S5 = 8, F_GLU = 16, F_OUT = 32, F_FFN = 64, F_MOE = 128, F_NORM = 256;

constexpr size_t MiB = (size_t)1 << 20, KiB = 1024;
constexpr size_t WS_CTL = 0, CTL_BYTES = 64 * KiB;
constexpr size_t WS_MOD = 128 * KiB;
constexpr size_t WS_LAMQ = 1 * MiB;
constexpr size_t WS_COST = 1 * MiB + 64 * KiB;
constexpr size_t WS_TOKE = 1 * MiB + 256 * KiB, WS_TOKW = WS_TOKE + 256 * KiB, WS_TOKPOS = WS_TOKW + 256 * KiB, WS_TOKROW = WS_TOKPOS + 256 * KiB;
constexpr size_t WS_TILEE = WS_TOKROW + 256 * KiB, WS_ROWTOK = WS_TILEE + 4 * KiB;
constexpr size_t WS_Z = 4 * MiB;
constexpr size_t WS_DFTL = 20 * MiB, WS_DFTC = 36 * MiB;
constexpr size_t WS_S5E = 37 * MiB, WS_S5TG = 41 * MiB, S5_LSTRIDE = 12 * MiB;
constexpr size_t WS_MIXW = 61 * MiB, MIXW_LSTRIDE = 12 * MiB;
constexpr size_t WS_WGU = 85 * MiB, WS_WDN = 96 * MiB;
constexpr size_t WS_UX = 102 * MiB, WS_GT = 174 * MiB, WS_S = 318 * MiB, WS_VT2L = 390 * MiB, WS_VT2C = 454 * MiB, WS_TM = 390 * MiB, WS_XA = 535 * MiB, WS_YS = 535 * MiB;
constexpr size_t WS_PF = 462 * MiB, WS_T1 = 462 * MiB, WS_YACC = 318 * MiB, WS_T2 = 318 * MiB;
constexpr size_t WS_HID = 102 * MiB;
constexpr size_t WS_XA8 = 472 * MiB;
constexpr size_t WS_POS = 462 * MiB;
constexpr size_t WS_WMOE = 4 * MiB, WS_XS = 172 * MiB, WS_HIDM = 304 * MiB;
constexpr size_t WS_W8 = 4 * MiB, W8_ESTRIDE = 10 * MiB + 512 * KiB, W8_DN = 7 * MiB;
#ifdef RES16
constexpr size_t WS_H16 = 246 * MiB;
constexpr size_t WS_XS8 = 88 * MiB, WS_XR = 154 * MiB, WS_O = 318 * MiB, WS_H8A = 450 * MiB, WS_H8B = 513 * MiB;
#else
constexpr size_t WS_XR = 535 * MiB;
constexpr size_t WS_XS8 = 88 * MiB, WS_O = 154 * MiB, WS_H8A = 286 * MiB, WS_H8B = 349 * MiB;
#endif
constexpr int MOE_TP = 132;
constexpr size_t WS_NO = 102 * MiB, WS_NHQ = 366 * MiB;
constexpr size_t WS_END = 607 * MiB;
constexpr int CW_BAR = 0, CW_CNT = 4096, CW_NT = 4096 + 64;
constexpr int CW_RDY = 4096 + 256;
constexpr int CW_PQ = 4096 + 512;

__device__ __forceinline__ float bf2f(bf16_t b) { return __uint_as_float(((unsigned)b) << 16); }
__device__ __forceinline__ bf16_t f2bf(float f) { unsigned u = __float_as_uint(f); u += 0x7FFFu + ((u >> 16) & 1u); return (bf16_t)(u >> 16); }
__device__ __forceinline__ float sigmoidf_(float v) { return 1.f / (1.f + expf(-v)); }
__device__ __forceinline__ float siluf_(float v) { return v / (1.f + expf(-v)); }
__device__ __forceinline__ float geluf_(float v) { return 0.5f * v * (1.f + tanhf(0.7978845608028654f * (v + 0.044715f * v * v * v))); }
__device__ __forceinline__ float wave_sum(float v) {
#pragma unroll
    for (int o = 32; o >= 1; o >>= 1) v += __shfl_xor(v, o);
    return v;
}
__device__ __forceinline__ size_t ux_index(int g, int row, int h) { return ((size_t)g * CHR + (row >> 4)) * 512 + (row & 15) * 16 + h; }
__device__ __forceinline__ size_t vt2_index(int row, int gk, int type) {
    if (row < TC) { const int b = row >> 8, n = row & 255; return ((size_t)(b * 512 + gk)) * 512 + type * 256 + n; }
    const int t = row - TC, b = t >> 11, n = t & 2047; return ((size_t)(b * 512 + gk)) * 4096 + type * 2048 + n;
}

#if !ONE_LAUNCH
template <class LA, class LB, class EP>
__global__ __launch_bounds__(256) void ngemm(int K, int kpad, LA la, LB lb, EP ep) {
    __shared__ float As[16][68], Bs[16][68];
    const int tx = threadIdx.x & 15, ty = threadIdx.x >> 4;
    const int m0 = blockIdx.y * 64, n0 = blockIdx.x * 64, z = blockIdx.z;
    if (!la.active(z, m0)) return;
    float acc[4][4];
#pragma unroll
    for (int i = 0; i < 4; ++i)
#pragma unroll
        for (int j = 0; j < 4; ++j) acc[i][j] = 0.f;
    for (int k0 = 0; k0 < K; k0 += 16) {
#pragma unroll
        for (int i = 0; i < 4; ++i) { const int e = threadIdx.x + i * 256; const int mm = e >> 4, kk = e & 15; As[kk][mm] = la(z, m0 + mm, k0 + kk); }
#pragma unroll
        for (int i = 0; i < 4; ++i) { const int e = threadIdx.x + i * 256; const int kk = e >> 6, nn = e & 63; Bs[kk][nn] = lb(z, m0, k0 + kk, n0 + nn); }
        __syncthreads();
#pragma unroll
        for (int kk = 0; kk < 16; ++kk) {
            float a[4], b[4];
#pragma unroll
            for (int i = 0; i < 4; ++i) { a[i] = As[kk][ty * 4 + i]; b[i] = Bs[kk][tx * 4 + i]; }
#pragma unroll
            for (int i = 0; i < 4; ++i)
#pragma unroll
                for (int j = 0; j < 4; ++j) acc[i][j] += a[i] * b[j];
        }
        __syncthreads();
    }
#pragma unroll
    for (int i = 0; i < 4; ++i)
#pragma unroll
        for (int j = 0; j < 4; ++j) ep(z, m0 + ty * 4 + i, n0 + tx * 4 + j, acc[i][j]);
}
struct LAbf { const bf16_t* p; int ld; int pad; __device__ bool active(int, int) const { return true; } __device__ float operator()(int, int m, int k) const { return bf2f(p[(size_t)m * ld + k]); } };
struct LAbfZ { const bf16_t* p; int ld; int zoff; __device__ bool active(int, int) const { return true; } __device__ float operator()(int z, int m, int k) const { return bf2f(p[(size_t)m * ld + z * zoff + k]); } };
struct LBw { const float* p; int ld; int pad; __device__ float operator()(int, int, int k, int n) const { return p[(size_t)k * ld + n]; } };
struct LBdft128 { const float* cosT; const float* sinT; __device__ float operator()(int, int, int k, int n) const { const int nn = n & 127; const int idx = ((k * nn) & 127) * 16; return n < 128 ? cosT[idx] : sinT[idx]; } };
template <int LL> struct LAdftL { const float* cosT; const float* sinT; __device__ bool active(int, int) const { return true; }
    __device__ float operator()(int, int m, int k) const { const int kk = k & (LL - 1); const int idx = ((m * kk) & (LL - 1)) * (2048 / LL); return k < LL ? cosT[idx] : -sinT[idx]; } };
template <int LL> struct LBvt2 { const bf16_t* V; __device__ float operator()(int z, int, int k, int n) const { return bf2f(V[((size_t)(z * 512 + n)) * (2 * LL) + k]); } };
struct LAgather { const bf16_t* A; const int* rowtok; const int* tile_e; __device__ bool active(int, int m0) const { return tile_e[m0 >> 8] >= 0; }
    __device__ float operator()(int, int m, int k) const { const int t = rowtok[m]; return t < 0 ? 0.f : bf2f(A[(size_t)t * D + k]); } };
struct LAmoeh { const bf16_t* H; const int* tile_e; __device__ bool active(int, int m0) const { return tile_e[m0 >> 8] >= 0; }
    __device__ float operator()(int, int m, int k) const { return bf2f(H[(size_t)m * 896 + k]); } };
struct LBmoe { const float* w; const int* tile_e; size_t estride; int ld; int coff; int roff; int pad; __device__ float operator()(int, int m0, int k, int n) const { const int e = tile_e[m0 >> 8]; return w[(size_t)e * estride + (size_t)(k + roff) * ld + coff + n]; } };

struct EPbf { bf16_t* o; int ld; int pad; __device__ void operator()(int, int m, int n, float v) const { o[(size_t)m * ld + n] = f2bf(v); } };
struct EPinproj { bf16_t* PF; bf16_t* UX; bf16_t* GT; __device__ void operator()(int, int m, int n, float v) const {
    if (n < 512) PF[(size_t)m * 512 + n] = f2bf(v); else if (n < 1024) { const int c = n - 512; UX[ux_index(c >> 4, m, c & 15)] = f2bf(v); } else GT[(size_t)m * 2048 + (n - 1024)] = f2bf(sigmoidf_(v)); } };
struct EPzdft { bf16_t* VL; bf16_t* VC; __device__ void operator()(int z, int m, int n, float v) const { (m < TC ? VC : VL)[vt2_index(m, z * 128 + (n & 127), n >> 7)] = f2bf(v); } };
template <int LL> struct EPfour { bf16_t* YS; int rowbase; float scale; __device__ void operator()(int z, int m, int n, float v) const { YS[((size_t)rowbase + z * LL + m) * 1024 + n] = f2bf(v * scale); } };
struct EPmerge { const bf16_t* GT; const bf16_t* T1; const bf16_t* T2; bf16_t* M; __device__ void operator()(int, int m, int n, float v) const {
    const float ga = bf2f(GT[(size_t)m * 2048 + n]), gb = bf2f(GT[(size_t)m * 2048 + 1024 + n]);
    const size_t o = (size_t)m * D + n; M[o] = f2bf(ga * bf2f(T1[o]) + gb * bf2f(T2[o]) * sigmoidf_(v)); } };
struct EPres { float* h; float* z; const float* mod; int gidx; int rowoff; __device__ void operator()(int, int m, int n, float v) const {
    const int r = m + rowoff; float* dst = r < TC ? z + (size_t)r * D + n : h + (size_t)(r - TC) * D + n; const int cond = r < TC ? 16 : (r - TC) / L;
    *dst += mod[(size_t)cond * 6144 + gidx * 1024 + n] * v; } };
struct EPswi { bf16_t* G; int ld; int pad; __device__ void operator()(int, int m, int n, float v) const { const size_t o = (size_t)m * ld + n; G[o] = f2bf(siluf_(bf2f(G[o])) * v); } };
struct EPacc { float* O; int first; int pad; __device__ void operator()(int, int m, int n, float v) const { const size_t o = (size_t)m * D + n; O[o] = first ? v : O[o] + v; } };

__global__ void k_tables(float* cosT, float* sinT) { const int i = blockIdx.x * blockDim.x + threadIdx.x; if (i < 2048) { cosT[i] = cospif(i / 1024.f); sinT[i] = sinpif(i / 1024.f); } }
__global__ void k_mod(const float* c, const float* cctx, const float* wmod, const float* bmod, float* mod) {
    const int col = blockIdx.x * 256 + threadIdx.x, r = blockIdx.y, l = blockIdx.z;
    const float* cond = r < 16 ? c + r * D : cctx; const float* w = wmod + (size_t)l * D * 6144;
    float acc = 0.f;
    for (int k = 0; k < D; ++k) acc += siluf_(cond[k]) * w[(size_t)k * 6144 + col];
    mod[((size_t)l * 17 + r) * 6144 + col] = acc + bmod[l * 6144 + col];
}
__global__ void k_init(const float* x, const float* ctx, float* h, float* z) {
    const size_t i = (size_t)blockIdx.x * blockDim.x + threadIdx.x;
    if (i < (size_t)TL * D) { const int d = (int)(i & 1023); const int t = (int)(i >> 10); const int n = t & (L - 1); const int r = n >> 6, col = n & 63; const int q = d >> 8, ii = d & 255;
        const float omega = 1.0f / powf(10000.f, (float)ii / 256.f); const float ang = (q < 2 ? (float)r : (float)col) * omega; h[i] = x[i] + ((q & 1) ? cosf(ang) : sinf(ang)); }
    if (i < (size_t)TC * D) z[i] = ctx[i];
}
template <bool ROUTE>
__global__ __launch_bounds__(256) void k_norm(const float* h, const float* z, const float* g, const float* mod, int shi, int sci, bf16_t* A, int row0, int nrows,
                                              const float* wr, const float* br, int* tok_e, float* tok_w) {
    const int lane = threadIdx.x & 63; const int r = row0 + blockIdx.x * 4 + (threadIdx.x >> 6); if (r >= row0 + nrows) return;
    const float* src = r < TC ? z + (size_t)r * D : h + (size_t)(r - TC) * D; const int cond = r < TC ? 16 : (r - TC) / L;
    const float* sh = mod + (size_t)cond * 6144 + shi * 1024; const float* sc = mod + (size_t)cond * 6144 + sci * 1024;
    float4 v[4]; float ss = 0.f;
#pragma unroll
    for (int j = 0; j < 4; ++j) { v[j] = *(const float4*)(src + j * 256 + lane * 4); ss += v[j].x * v[j].x + v[j].y * v[j].y + v[j].z * v[j].z + v[j].w * v[j].w; }
    ss = wave_sum(ss); const float rstd = rsqrtf(ss * (1.f / D) + EPS);
    float lg[8];
#pragma unroll
    for (int e = 0; e < 8; ++e) lg[e] = 0.f;
#pragma unroll
    for (int j = 0; j < 4; ++j) { const int k = j * 256 + lane * 4; const float4 gg = *(const float4*)(g + k), s1 = *(const float4*)(sc + k), s0 = *(const float4*)(sh + k);
        float a0 = v[j].x * rstd * gg.x * (1.f + s1.x) + s0.x, a1 = v[j].y * rstd * gg.y * (1.f + s1.y) + s0.y, a2 = v[j].z * rstd * gg.z * (1.f + s1.z) + s0.z, a3 = v[j].w * rstd * gg.w * (1.f + s1.w) + s0.w;
        ushort4 o; o.x = f2bf(a0); o.y = f2bf(a1); o.z = f2bf(a2); o.w = f2bf(a3); *(ushort4*)(A + (size_t)r * D + k) = o;
        if (ROUTE) {
#pragma unroll
            for (int e = 0; e < 8; ++e) lg[e] += a0 * wr[(k + 0) * 8 + e] + a1 * wr[(k + 1) * 8 + e] + a2 * wr[(k + 2) * 8 + e] + a3 * wr[(k + 3) * 8 + e]; } }
    if (ROUTE) {
#pragma unroll
        for (int e = 0; e < 8; ++e) lg[e] = wave_sum(lg[e]) + br[e];
        if (lane == 0) { int e1 = 0; float v1 = lg[0];
#pragma unroll
            for (int e = 1; e < 8; ++e) if (lg[e] > v1) { v1 = lg[e]; e1 = e; }
            int e2 = -1; float v2 = -3.0e38f;
#pragma unroll
            for (int e = 0; e < 8; ++e) if (e != e1 && lg[e] > v2) { v2 = lg[e]; e2 = e; }
            const float w1 = 1.f / (1.f + expf(v2 - v1)); const int t = r - TC;
            tok_e[t * 2] = e1; tok_e[t * 2 + 1] = e2; tok_w[t * 2] = w1; tok_w[t * 2 + 1] = 1.f - w1; }
    }
}
__global__ __launch_bounds__(64) void k_s5_naive(const bf16_t* UX, const float* are, const float* aim, const float* logdt, const float* bre, const float* bim, const float* cre, const float* cim,
                                                  const float* dsk, float* Yacc, bf16_t* YS) {
    const int b = blockIdx.x >> 5, g = blockIdx.x & 31, p = threadIdx.x, lane = p;
    const int hh = ((lane >> 5) & 1) * 8 + ((lane >> 4) & 1) * 4 + ((lane >> 3) & 1) * 2 + ((lane >> 2) & 1);
    for (int dir = 0; dir < 2; ++dir) {
        const int gp = (dir * 32 + g) * 64 + p;
        const float ar = are[gp], ai = aim[gp], dt = expf(logdt[dir * 32 + g]);
        const float er = expf(ar * dt), lbr = er * cosf(ai * dt), lbi = er * sinf(ai * dt);
        const float nr = lbr - 1.f, ni = lbi, den = ar * ar + ai * ai, qr = (nr * ar + ni * ai) / den, qi = (ni * ar - nr * ai) / den;
        float Br[16], Bi[16], Cr[16], Ci[16];
#pragma unroll
        for (int h = 0; h < 16; ++h) { const float x0 = bre[(size_t)gp * 16 + h], x1 = bim[(size_t)gp * 16 + h]; Br[h] = qr * x0 - qi * x1; Bi[h] = qr * x1 + qi * x0;
            Cr[h] = cre[((size_t)(dir * 32 + g) * 16 + h) * 64 + p]; Ci[h] = cim[((size_t)(dir * 32 + g) * 16 + h) * 64 + p]; }
        float xr = 0.f, xi = 0.f;
        for (int s = 0; s < LC + L; ++s) {
            int row; if (dir == 0) row = s < LC ? b * LC + s : TC + b * L + (s - LC); else row = s < LC ? b * LC + (LC - 1 - s) : TC + b * L + (L - 1 - (s - LC));
            const bf16_t* up = UX + ux_index(g, row, 0);
            float u[16];
#pragma unroll
            for (int h = 0; h < 16; ++h) u[h] = bf2f(up[h]);
            float bur = 0.f, bui = 0.f;
#pragma unroll
            for (int h = 0; h < 16; ++h) { bur += Br[h] * u[h]; bui += Bi[h] * u[h]; }
            const float nxr = lbr * xr - lbi * xi + bur, nxi = lbr * xi + lbi * xr + bui; xr = nxr; xi = nxi;
            float v[16];
#pragma unroll
            for (int h = 0; h < 16; ++h) v[h] = Cr[h] * xr - Ci[h] * xi;
#pragma unroll
            for (int st = 0; st < 4; ++st) { const int n = 8 >> st, off = 32 >> st; const bool hi = (lane & off) != 0;
#pragma unroll
                for (int j = 0; j < 8; ++j) if (j < n) { const float mine = hi ? v[j + n] : v[j]; const float other = hi ? v[j] : v[j + n]; v[j] = mine + __shfl_xor(other, off); } }
            float val = v[0]; val += __shfl_xor(val, 2); val += __shfl_xor(val, 1);
            if ((lane & 3) == 0) { const size_t o = (size_t)row * 512 + g * 16 + hh;
                if (dir == 0) Yacc[o] = val; else { const float y = Yacc[o] + val + dsk[g * 16 + hh] * bf2f(up[hh]); YS[(size_t)row * 1024 + 512 + g * 16 + hh] = f2bf(geluf_(y)); } }
        }
    }
}
__global__ void k_moe_zero(int* cnt, int* rowtok) { const int i = blockIdx.x * blockDim.x + threadIdx.x; if (i < 16) cnt[i] = 0; if (i < MOEROWS) rowtok[i] = -1; }
__global__ __launch_bounds__(256) void k_moe_count(const int* tok_e, int* cnt, int* tok_pos) {
    __shared__ int lc[8], lb[8];
    if (threadIdx.x < 8) lc[threadIdx.x] = 0; __syncthreads();
    const int i = blockIdx.x * 256 + threadIdx.x;
    const int e = tok_e[i]; const int lp = atomicAdd(&lc[e], 1); __syncthreads();
    if (threadIdx.x < 8) lb[threadIdx.x] = atomicAdd(&cnt[threadIdx.x], lc[threadIdx.x]); __syncthreads();
    tok_pos[i] = lb[e] + lp;
}
__global__ __launch_bounds__(256) void k_moe_place(const int* tok_e, const int* cnt, const int* tok_pos, int* tok_row, int* rowtok, int* tile_e) {
    int base[9]; base[0] = 0;
#pragma unroll
    for (int e = 0; e < 8; ++e) base[e + 1] = base[e] + ((cnt[e] + 255) & ~255);
    const int i = blockIdx.x * 256 + threadIdx.x; const int e = tok_e[i];
    int bs = 0;
#pragma unroll
    for (int k = 0; k < 8; ++k) if (k == e) bs = base[k];
    const int row = bs + tok_pos[i]; tok_row[i] = row; rowtok[row] = i >> 1;
    if (i < MOETILES) { int te = -1;
#pragma unroll
        for (int k = 0; k < 8; ++k) if (i * 256 >= base[k] && i * 256 < base[k + 1]) te = k;
        tile_e[i] = te; }
}
__global__ __launch_bounds__(256) void k_final(float* h, const float* mod, const float* O, const int* tok_row, const float* tok_w, const float* fg, float* out) {
    const int lane = threadIdx.x & 63; const int t = blockIdx.x * 4 + (threadIdx.x >> 6); const int cond = t / L;
    const float* g2 = mod + (size_t)cond * 6144 + 5 * 1024; const int r1 = tok_row[t * 2], r2 = tok_row[t * 2 + 1]; const float w1 = tok_w[t * 2], w2 = tok_w[t * 2 + 1];
    float4 v[4]; float ss = 0.f;
#pragma unroll
    for (int j = 0; j < 4; ++j) { const int k = j * 256 + lane * 4; const float4 hv = *(const float4*)(h + (size_t)t * D + k), a = *(const float4*)(O + (size_t)r1 * D + k), b = *(const float4*)(O + (size_t)r2 * D + k), gg = *(const float4*)(g2 + k);
        v[j].x = hv.x + gg.x * (w1 * a.x + w2 * b.x); v[j].y = hv.y + gg.y * (w1 * a.y + w2 * b.y); v[j].z = hv.z + gg.z * (w1 * a.z + w2 * b.z); v[j].w = hv.w + gg.w * (w1 * a.w + w2 * b.w);
        ss += v[j].x * v[j].x + v[j].y * v[j].y + v[j].z * v[j].z + v[j].w * v[j].w; }
    ss = wave_sum(ss); const float rstd = rsqrtf(ss * (1.f / D) + EPS);
#pragma unroll
    for (int j = 0; j < 4; ++j) { const int k = j * 256 + lane * 4; const float4 gg = *(const float4*)(fg + k); float4 o; o.x = v[j].x * rstd * gg.x; o.y = v[j].y * rstd * gg.y; o.z = v[j].z * rstd * gg.z; o.w = v[j].w * rstd * gg.w;
        *(float4*)(out + (size_t)t * D + k) = o; }
}
#endif
}


namespace mk {
#define LAS __attribute__((address_space(3)))
typedef short bf16x8 __attribute__((ext_vector_type(8)));
typedef float f32x4 __attribute__((ext_vector_type(4)));
typedef float f32x2 __attribute__((ext_vector_type(2)));
typedef unsigned u32x4 __attribute__((ext_vector_type(4)));
typedef unsigned u32x2 __attribute__((ext_vector_type(2)));
typedef int i32x4 __attribute__((ext_vector_type(4)));
typedef int i32x8 __attribute__((ext_vector_type(8)));
constexpr int BK = 64, HTB = 128 * BK * 2, STAGE_BYTES = 8 * HTB;
constexpr int MISC_OFF = STAGE_BYTES + 320, LDS_BYTES = 147456;
#ifndef FFN_ORDER
#define FFN_ORDER 8
#endif
#ifndef HID_LD
#define HID_LD DFF
#endif
constexpr int PH_L1 = 12, PH_MOE = 19, NPH = 27;

#define XB_TMO      128
#define XB_XCNT(j)  (256  + 64 * (j))
#define XB_XSUB(j)  (1280 + 64 * (j))
#define XB_XGEN(j)  (2304 + 64 * (j))
#define XB_TOP      3328
#define XB_TOPGEN   3392
#define XCD_BAR_WORDS 3456
#define XB_SPIN_CAP (1u << 18)
__device__ __forceinline__ unsigned lane_id_now() { unsigned l; asm volatile("v_mbcnt_lo_u32_b32 %0, -1, 0\n\tv_mbcnt_hi_u32_b32 %0, -1, %0" : "=v"(l)); return l; }
#define TIDX ((int)(g_wave_s * 64u + lane_id_now()))
__device__ __forceinline__ unsigned xb_ld(unsigned* p)              { return __hip_atomic_load(p, __ATOMIC_RELAXED, __HIP_MEMORY_SCOPE_AGENT); }
__device__ __forceinline__ unsigned xb_add(unsigned* p, unsigned v) { return __hip_atomic_fetch_add(p, v, __ATOMIC_RELAXED, __HIP_MEMORY_SCOPE_AGENT); }
__device__ __forceinline__ unsigned xb_xcc_id() { return (unsigned)__builtin_amdgcn_s_getreg((3 << 11) | 20) & 0xFu; }
#define XB_SPIN(cond, bar) do { unsigned _sp = 0; while (cond) { __builtin_amdgcn_s_sleep(1); \
    if ((++_sp & 255u) == 0u) { if (xb_ld(&(bar)[XB_TMO])) break; if (_sp > XB_SPIN_CAP) { atomicAdd(&(bar)[XB_TMO], 1u); break; } } } } while (0)
struct XcdBarrier { unsigned* bar; unsigned x; volatile LAS unsigned* st; };
__device__ __forceinline__ XcdBarrier xcd_barrier_post(unsigned* bar, volatile LAS unsigned* st, unsigned g_wave_s) {
    XcdBarrier b; b.bar = bar; b.x = xb_xcc_id(); b.st = st;
    if (TIDX == 0) (void)xb_add(&bar[XB_XCNT(b.x)], 1u);
    return b;
}
__device__ __forceinline__ void xcd_barrier_complete(unsigned* bar, unsigned x, unsigned& nloc, unsigned& nx) {
    const unsigned G = gridDim.x * gridDim.y * gridDim.z;
    unsigned sum, cnt, mine, sp = 0u;
    for (;;) {
        sum = 0u; cnt = 0u; mine = 0u;
#pragma unroll
        for (unsigned j = 0; j < 16; ++j) { const unsigned c = xb_ld(&bar[XB_XCNT(j)]); sum += c; cnt += (c > 0u) ? 1u : 0u; mine = (j == x) ? c : mine; }
        if (sum == G) break;
        __builtin_amdgcn_s_sleep(1);
        if ((++sp & 255u) == 0u) { if (xb_ld(&bar[XB_TMO])) break; if (sp > XB_SPIN_CAP) { atomicAdd(&bar[XB_TMO], 1u); break; } }
    }
    nloc = mine > 0u ? mine : 1u; nx = cnt > 0u ? cnt : 1u;
}
__device__ __forceinline__ void xcd_barrier(const XcdBarrier& b, unsigned g_wave_s) {
    asm volatile("s_waitcnt vmcnt(0)" ::: "memory");
    __syncthreads();
    if (TIDX == 0) {
        unsigned* bar = b.bar;
        __builtin_amdgcn_s_waitcnt(0);
        unsigned nloc = b.st[0], nx = b.st[1];
        if (nloc == 0u) { xcd_barrier_complete(bar, b.x, nloc, nx); b.st[0] = nloc; b.st[1] = nx; }
        const unsigned old = xb_add(&bar[XB_XSUB(b.x)], 1u);
        const unsigned gen = old / nloc;
#ifdef EARLY_INV
        if (old + 1u == (gen + 1u) * nloc) {
            __builtin_amdgcn_fence(__ATOMIC_RELEASE, "agent");
            asm volatile("s_waitcnt vmcnt(0)" ::: "memory");
            const unsigned og = xb_add(&bar[XB_TOP], 1u);
            const unsigned tg = og / nx;
            asm volatile("buffer_inv sc1" ::: "memory");
            if (og + 1u == (tg + 1u) * nx) xb_add(&bar[XB_TOPGEN], 1u);
            else XB_SPIN(xb_ld(&bar[XB_TOPGEN]) == tg, bar);
            xb_add(&bar[XB_XGEN(b.x)], 1u);
            asm volatile("s_waitcnt vmcnt(0)" ::: "memory");
        } else {
            asm volatile("buffer_inv sc1" ::: "memory");
            XB_SPIN(xb_ld(&bar[XB_XGEN(b.x)]) == gen, bar);
            asm volatile("s_waitcnt vmcnt(0)" ::: "memory");
        }
#else
        if (old + 1u == (gen + 1u) * nloc) {
            __builtin_amdgcn_fence(__ATOMIC_RELEASE, "agent");
            asm volatile("s_waitcnt vmcnt(0)" ::: "memory");
            const unsigned og = xb_add(&bar[XB_TOP], 1u);
            const unsigned tg = og / nx;
            if (og + 1u == (tg + 1u) * nx) xb_add(&bar[XB_TOPGEN], 1u);
            else XB_SPIN(xb_ld(&bar[XB_TOPGEN]) == tg, bar);
            __builtin_amdgcn_fence(__ATOMIC_ACQUIRE, "agent");
            xb_add(&bar[XB_XGEN(b.x)], 1u);
            asm volatile("s_waitcnt vmcnt(0)" ::: "memory");
        } else {
            XB_SPIN(xb_ld(&bar[XB_XGEN(b.x)]) == gen, bar);
            __builtin_amdgcn_fence(__ATOMIC_ACQUIRE, "agent");
            asm volatile("s_waitcnt vmcnt(0)" ::: "memory");
        }
#endif
    }
    __syncthreads();
}

__device__ __forceinline__ int lds_byte(int r, int c) { const int st = (r >> 4) * 2 + (c >> 5), rr = r & 15, cc = c & 31, ob = rr * 64 + cc * 2; return st * 1024 + (ob ^ (((ob >> 9) & 1) << 5)); }
__device__ __forceinline__ void stage_rc(int b, int& R, int& C) { const int st = b / 1024, sb = b % 1024, swz = sb ^ (((sb >> 9) & 1) << 5); R = (st >> 1) * 16 + swz / 64; C = (st & 1) * 32 + (swz % 64) / 2; }
__device__ __forceinline__ int perm32(int rho) { const int n = rho >> 4, i = rho & 15; return 8 * (i >> 2) + 4 * n + (i & 3); }
typedef __bf16 bf16x2_t __attribute__((ext_vector_type(2)));
__device__ __forceinline__ unsigned cvt_pk_bf16(float lo, float hi) { const f32x2 v = {lo, hi}; return __builtin_bit_cast(unsigned, __builtin_convertvector(v, bf16x2_t)); }
__device__ __forceinline__ u32x4 pack8(const f32x4 a, const f32x4 b) { u32x4 w; w.x = cvt_pk_bf16(a[0], a[1]); w.y = cvt_pk_bf16(a[2], a[3]); w.z = cvt_pk_bf16(b[0], b[1]); w.w = cvt_pk_bf16(b[2], b[3]); return w; }
__device__ __forceinline__ float bflo(unsigned w) { return __uint_as_float(w << 16); }
__device__ __forceinline__ float bfhi(unsigned w) { return __uint_as_float(w & 0xffff0000u); }
__device__ __forceinline__ void unpack8(const u32x4 w, f32x4& a, f32x4& b) { a[0] = bflo(w.x); a[1] = bfhi(w.x); a[2] = bflo(w.y); a[3] = bfhi(w.y); b[0] = bflo(w.z); b[1] = bfhi(w.z); b[2] = bflo(w.w); b[3] = bfhi(w.w); }
__device__ __forceinline__ float fsigmoid(float v) { return __builtin_amdgcn_rcpf(1.f + __expf(-v)); }
__device__ __forceinline__ float fgelu(float v) { return v * fsigmoid(1.5957691216057308f * (v + 0.044715f * v * v * v)); }

__device__ __forceinline__ unsigned pack4_fp8(float a, float b, float c, float d) { unsigned w = 0; w = __builtin_amdgcn_cvt_pk_fp8_f32(a, b, w, false); w = __builtin_amdgcn_cvt_pk_fp8_f32(c, d, w, true); return w; }
typedef float f32x2v __attribute__((ext_vector_type(2)));
__device__ __forceinline__ void unpack8_fp8(const u32x2 w, f32x4& a, f32x4& b) {
    const f32x2v p0 = __builtin_amdgcn_cvt_pk_f32_fp8((int)w.x, false), p1 = __builtin_amdgcn_cvt_pk_f32_fp8((int)w.x, true), p2 = __builtin_amdgcn_cvt_pk_f32_fp8((int)w.y, false), p3 = __builtin_amdgcn_cvt_pk_f32_fp8((int)w.y, true);
    a = (f32x4){p0[0], p0[1], p1[0], p1[1]}; b = (f32x4){p2[0], p2[1], p3[0], p3[1]}; }
__device__ __forceinline__ float wsum(float v, int lane) {
#pragma unroll
    for (int o = 32; o >= 1; o >>= 1) v += __builtin_bit_cast(float, __builtin_amdgcn_ds_bpermute((lane ^ o) << 2, __builtin_bit_cast(int, v)));
    return v;
}
constexpr float W8SC = 64.f, W8INV = 1.0f / 64.f;
struct Unit { const char* A; const char* B; const char* B2; unsigned lda2, ldb2; int nt, perm, kind, z, pm, pn, mir, mh; };
struct Job { const char* A; const char* B; size_t zA, zB, eB; const LAS int* tlut; unsigned lda2, ldb2; int nt, nM, nN, nZ, perm, kind, pm0, pn0, order, mirL, grp; };
__device__ __forceinline__ Job mkjob(const void* A, const void* B, size_t zA, size_t zB, unsigned lda2, unsigned ldb2, int nt, int nM, int nN, int nZ, int perm, int kind, int pm0, int pn0) {
    Job j; j.A = (const char*)A; j.B = (const char*)B; j.zA = zA; j.zB = zB; j.eB = 0; j.tlut = nullptr; j.lda2 = lda2; j.ldb2 = ldb2; j.nt = nt; j.nM = nM; j.nN = nN; j.nZ = nZ; j.perm = perm; j.kind = kind; j.pm0 = pm0; j.pn0 = pn0; j.order = 0; j.mirL = 0; j.grp = 8; return j; }
__device__ __forceinline__ void decode_unit(const Job& J, int ww, Unit& u) {
        int z, pm, pn;
        if (J.order == 1) { const int per = J.nZ * J.nN; const int q = ww / per, rem = ww - q * per; pm = J.pm0 + q; z = rem / J.nN; pn = J.pn0 + (rem - z * J.nN); }
        else { const int per = J.nM * J.nN; z = ww / per; const int rem = ww - z * per;
            const int nig = J.grp * J.nN, gid = rem / nig, fm = gid * J.grp, gsz = (J.nM - fm) < J.grp ? (J.nM - fm) : J.grp, rr = rem - gid * nig;
            pm = J.pm0 + fm + (rr % gsz); pn = J.pn0 + rr / gsz; }
        u.A = J.A + (size_t)z * J.zA + (size_t)pm * 256 * J.lda2;
        u.B = J.B + (size_t)z * J.zB + (size_t)pn * 256 * J.ldb2 + (J.tlut ? (size_t)J.tlut[pm] * J.eB : (size_t)0);
        u.B2 = u.B + (size_t)128 * J.ldb2; u.mir = 0; u.mh = 0;
        if (J.mirL) {
            u.B = J.B + (size_t)z * J.zB + (size_t)pn * 128 * J.ldb2; u.B2 = J.B + (size_t)z * J.zB + (size_t)(pn == 0 ? J.mirL / 2 : J.mirL - 128 * pn - 127) * J.ldb2; u.mir = pn == 0 ? 2 : 1; u.mh = J.mirL / 2; }
        u.lda2 = J.lda2; u.ldb2 = J.ldb2; u.nt = J.nt; u.perm = J.perm; u.kind = J.kind; u.z = z; u.pm = pm; u.pn = pn;
        { unsigned long long pc = (unsigned long long)u.B2; pc = ((unsigned long long)(unsigned)__builtin_amdgcn_readfirstlane((int)(pc >> 32)) << 32) | (unsigned)__builtin_amdgcn_readfirstlane((int)(unsigned)pc); u.B2 = (const char*)pc;
          u.mir = __builtin_amdgcn_readfirstlane(u.mir); u.mh = __builtin_amdgcn_readfirstlane(u.mh); }
        { unsigned long long pa = (unsigned long long)u.A, pb = (unsigned long long)u.B;
          pa = ((unsigned long long)(unsigned)__builtin_amdgcn_readfirstlane((int)(pa >> 32)) << 32) | (unsigned)__builtin_amdgcn_readfirstlane((int)(unsigned)pa);
          pb = ((unsigned long long)(unsigned)__builtin_amdgcn_readfirstlane((int)(pb >> 32)) << 32) | (unsigned)__builtin_amdgcn_readfirstlane((int)(unsigned)pb);
          u.A = (const char*)pa; u.B = (const char*)pb; u.lda2 = (unsigned)__builtin_amdgcn_readfirstlane((int)u.lda2); u.ldb2 = (unsigned)__builtin_amdgcn_readfirstlane((int)u.ldb2);
          u.nt = __builtin_amdgcn_readfirstlane(u.nt); u.perm = __builtin_amdgcn_readfirstlane(u.perm); u.kind = __builtin_amdgcn_readfirstlane(u.kind); u.z = __builtin_amdgcn_readfirstlane(u.z);
          u.pm = __builtin_amdgcn_readfirstlane(u.pm); u.pn = __builtin_amdgcn_readfirstlane(u.pn); }
}
template <int NJ> struct JobSched {
    Job j[NJ]; int cnt[NJ]; int total, G, c, dry = 0;
    __device__ __forceinline__ void init(int G_, int c_) { total = 0;
#pragma unroll
        for (int k = 0; k < NJ; ++k) { cnt[k] = j[k].nZ * j[k].nM * j[k].nN; total += cnt[k]; }
        G = G_; c = c_; }
    __device__ __forceinline__ int nunits() const { return total; }
    __device__ __forceinline__ bool next(int i, Unit& u) const {
        const int Lq = i * G + c; if (Lq >= total) return false;
        int w = Lq;
#ifdef GLOBAL_REMAP
        { const int q = total / 8, r = total % 8, xcd = Lq % 8, off = Lq / 8; w = (xcd < r ? xcd * (q + 1) : r * (q + 1) + (xcd - r) * q) + off; }
#else
        { const int R = (total - i * G) < G ? (total - i * G) : G; const int q = R / 8, r = R % 8, xcd = c % 8, off = c / 8; w = i * G + (xcd < r ? xcd * (q + 1) : r * (q + 1) + (xcd - r) * q) + off; }
#endif
        Job J = j[0];
        int ww = w; bool done = false;
#pragma unroll
        for (int k = 0; k < NJ; ++k) { if (!done) { if (ww < cnt[k] || k == NJ - 1) { J = j[k]; done = true; } else ww -= cnt[k]; } }
        decode_unit(J, ww, u);
        return true;
    }
};

struct BalSched {
    Job j[2]; int n0, n1, G, cp, E, base0, gH, gL, extra, nl, dry = 0;
    __device__ __forceinline__ void init(int G_, int c_) {
        G = G_; cp = (G & 7) == 0 ? (c_ & 7) * (G >> 3) + (c_ >> 3) : c_;
        n0 = j[0].nZ * j[0].nM * j[0].nN; n1 = j[1].nZ * j[1].nM * j[1].nN; base0 = n0 / G; E = n0 - base0 * G;
        const int W = (n0 * j[0].nt + n1 * j[1].nt) / G; int g = (W - (base0 + 1) * j[0].nt) / j[1].nt; g = g < 0 ? 0 : g; if (E > 0 && g * E > n1) g = n1 / E;
        nl = G - E;
        if (E > 0 && (g + 1) * E <= n1) {
            const int Ra = n1 - E * g, Rb = Ra - E;
            const int la = base0 * j[0].nt + ((Ra + nl - 1) / nl) * j[1].nt, ha = (base0 + 1) * j[0].nt + g * j[1].nt, ma = la > ha ? la : ha;
            const int lb = base0 * j[0].nt + ((Rb + nl - 1) / nl) * j[1].nt, hb = ha + j[1].nt, mb = lb > hb ? lb : hb;
            if (mb < ma) g = g + 1; }
        gH = g; const int R1 = n1 - E * gH; gL = R1 / nl; extra = R1 - gL * nl;
    }
    __device__ __forceinline__ int nunits() const { return n0 + n1; }
    __device__ __forceinline__ bool next(int i, Unit& u) const {
        const int mylong = base0 + (cp < E ? 1 : 0);
        if (i < mylong) { decode_unit(j[0], i * G + cp, u); return true; }
        const int s = i - mylong; int w;
        if (cp < E) { if (s >= gH) return false; w = s * E + cp; }
        else { const int k = cp - E; if (s < gL) w = E * gH + s * nl + k; else if (s == gL && k < extra) w = E * gH + gL * nl + k; else return false; }
        decode_unit(j[1], w, u); return true;
    }
};

struct BalLong { Job j; int G, cp, mylong, dry = 0;
    __device__ __forceinline__ int nunits() const { return mylong * G; }
    __device__ __forceinline__ bool next(int i, Unit& u) const { if (i >= mylong) return false; decode_unit(j, i * G + cp, u); return true; } };
struct BalShort { Job j; int cp, E, gH, gL, extra, nl, dry = 0;
    __device__ __forceinline__ int nunits() const { return 0; }
    __device__ __forceinline__ bool next(int s, Unit& u) const { int w;
        if (cp < E) { if (s >= gH) return false; w = s * E + cp; }
        else { const int k = cp - E; if (s < gL) w = E * gH + s * nl + k; else if (s == gL && k < extra) w = E * gH + gL * nl + k; else return false; }
        decode_unit(j, w, u); return true; } };

struct P3Sched {
    Job jq, jp, js0, js1; int G, cp, n0, n1, dry = 0;
    __device__ __forceinline__ void init(int G_, int c_) { G = G_; cp = (c_ & 7) * (G >> 3) + (c_ >> 3); n0 = js0.nZ * js0.nM * js0.nN; n1 = js1.nZ * js1.nM * js1.nN; }
    __device__ __forceinline__ int nunits() const { return 256 + n0 + n1; }
    __device__ __forceinline__ bool next(int i, Unit& u) const {
        const int k = cp >> 1;
        if ((cp & 1) == 0) { if (i > 0) return false; decode_unit(jq, k, u); return true; }
        if (i == 0) { decode_unit(jp, k, u); return true; }
        const int w = (i - 1) * 128 + k; if (w < n0) { decode_unit(js0, w, u); return true; } if (w - n0 < n1) { decode_unit(js1, w - n0, u); return true; } return false;
    }
};

template <class Epi, class Sched, bool MIR = false, bool F8 = false>
__device__ __forceinline__ void gemm_phase_(LAS unsigned char* lds, const Sched& S, const Epi& E, unsigned g_wave_s) {
    int tid = TIDX; asm volatile("" : "+v"(tid));
    const int wid = __builtin_amdgcn_readfirstlane(tid >> 6), lane = tid & 63, wr = wid >> 2, wc = wid & 3, fr = lane & 15, fq = lane >> 4;
    int R0, C0; stage_rc(tid * 16, R0, C0);
    const int Rp0 = (R0 & ~31) + perm32(R0 & 31);
    const unsigned ldsw = (unsigned)wid * 1024u;
    const int aoff = lds_byte(wr * 64 + fr, fq * 8), boff = lds_byte(wc * 32 + fr, fq * 8);
#define G_SA(b, h) (((b) * 2 + (h)) * HTB)
#define G_SB(b, h) ((4 + (b) * 2 + (h)) * HTB)
#define G_STAGE(bufoff, gbase, v0, s64) do { const char* _g1 = (const char*)(gbase); const char* _g2 = _g1 + (s64); unsigned _o1 = (v0); asm volatile("" : "+s"(_g1), "+s"(_g2), "+v"(_o1)); \
          \
        __builtin_amdgcn_global_load_lds((const unsigned*)(_g1 + _o1), (LAS unsigned*)(lds + (bufoff) + ldsw), 16, 0, 0); \
        __builtin_amdgcn_global_load_lds((const unsigned*)(_g2 + _o1), (LAS unsigned*)(lds + (bufoff) + ldsw + 8192), 16, 0, 0); } while (0)
#define G_STAGE2(bufoff, gbase, va, vb) do { \
        __builtin_amdgcn_global_load_lds((const unsigned*)((const char*)(gbase) + (va)), (LAS unsigned*)(lds + (bufoff) + ldsw), 16, 0, 0); \
        __builtin_amdgcn_global_load_lds((const unsigned*)((const char*)(gbase) + (vb)), (LAS unsigned*)(lds + (bufoff) + ldsw + 8192), 16, 0, 0); } while (0)
#define G_STAGEB1(bufoff, p1, vf, hh, p2, va, vb) do { if constexpr (MIR) G_STAGE2(bufoff, p2, va, vb); else G_STAGE(bufoff, (p1) + (hh), vf, (hh) / 2); } while (0)
#define G_VOFF2(u, va, vb) do { if constexpr (MIR) { const unsigned jj = (unsigned)((u).perm ? Rp0 : R0), c2 = (unsigned)C0 * 2u; \
        if ((u).mir == 0) { va = jj * (u).ldb2 + c2; vb = va + 64u * (u).ldb2; } \
        else if ((u).mir == 1) { va = (127u - jj) * (u).ldb2 + c2; vb = (63u - jj) * (u).ldb2 + c2; } \
        else { va = (jj == 0u ? 0u : ((unsigned)(u).mh - jj)) * (u).ldb2 + c2; vb = ((unsigned)(u).mh - jj - 64u) * (u).ldb2 + c2; } } } while (0)
#define G_LDA(dst, b, h) do { if constexpr (F8) { _Pragma("unroll") for (int m = 0; m < 4; ++m) { const i32x4 _l = *(const LAS i32x4*)(lds + G_SA(b, h) + aoff + m * 2048), _h = *(const LAS i32x4*)(lds + G_SA(b, h) + aoff + m * 2048 + 1024); \
            dst##8[m] = __builtin_shufflevector(_l, _h, 0, 1, 2, 3, 4, 5, 6, 7); } } \
        else { _Pragma("unroll") for (int m = 0; m < 4; ++m) _Pragma("unroll") for (int k = 0; k < 2; ++k) dst[m][k] = *(const LAS bf16x8*)(lds + G_SA(b, h) + aoff + m * 2048 + k * 1024); } } while (0)
#define G_LDB(dst, b, h) do { if constexpr (F8) { _Pragma("unroll") for (int n = 0; n < 2; ++n) { const i32x4 _l = *(const LAS i32x4*)(lds + G_SB(b, h) + boff + n * 2048), _h = *(const LAS i32x4*)(lds + G_SB(b, h) + boff + n * 2048 + 1024); \
            dst##8[n] = __builtin_shufflevector(_l, _h, 0, 1, 2, 3, 4, 5, 6, 7); } } \
        else { _Pragma("unroll") for (int n = 0; n < 2; ++n) _Pragma("unroll") for (int k = 0; k < 2; ++k) dst[n][k] = *(const LAS bf16x8*)(lds + G_SB(b, h) + boff + n * 2048 + k * 1024); } } while (0)
#define G_MMA(ai, bj, At, Bt) do { __builtin_amdgcn_s_setprio(1); \
        if constexpr (F8) { _Pragma("unroll") for (int m = 0; m < 4; ++m) _Pragma("unroll") for (int n = 0; n < 2; ++n) \
            acc[ai][bj][m][n] = __builtin_amdgcn_mfma_scale_f32_16x16x128_f8f6f4(Bt##8[n], At##8[m], acc[ai][bj][m][n], 0, 0, 0, 0, 0, 0); } \
        else { _Pragma("unroll") for (int m = 0; m < 4; ++m) _Pragma("unroll") for (int n = 0; n < 2; ++n) _Pragma("unroll") for (int k = 0; k < 2; ++k) \
            acc[ai][bj][m][n] = __builtin_amdgcn_mfma_f32_16x16x32_bf16(Bt[n][k], At[m][k], acc[ai][bj][m][n], 0, 0, 0); } \
        __builtin_amdgcn_s_setprio(0); } while (0)
#define G_WAIT_V(n) asm volatile("s_waitcnt vmcnt(" #n ")" ::: "memory")
#define G_WAIT_L(n) asm volatile("s_waitcnt lgkmcnt(" #n ")" ::: "memory")
#define G_BAR __builtin_amdgcn_s_barrier()
#define G_SCHED __builtin_amdgcn_sched_barrier(0)
#define G_OA(ld) ((unsigned)R0 * (ld) + (unsigned)C0 * 2u)
#define G_OB(ld, pm) ((unsigned)((pm) ? Rp0 : R0) * (ld) + (unsigned)C0 * 2u)
#define G_VOFF(u, a0, b0, ha, hb) do { a0 = (unsigned)R0 * (u).lda2 + (unsigned)C0 * 2u; b0 = (unsigned)((u).perm ? Rp0 : R0) * (u).ldb2 + (unsigned)C0 * 2u; ha = 128u * (u).lda2; hb = 128u * (u).ldb2; } while (0)
    Unit cur, nxt; int ui = 0;
    if (!S.next(0, cur)) return;
#ifdef STAGGER_TICKS
    if (S.nunits() >= 6 * (int)gridDim.x) { const unsigned long long t0 = wall_clock64(); const unsigned long long dly = (unsigned long long)(blockIdx.x & 3) * STAGGER_TICKS;
        while (wall_clock64() - t0 < dly) __builtin_amdgcn_s_sleep(8); }
#endif
    f32x4 acc[2][2][4][2];
#pragma unroll
    for (int a = 0; a < 2; ++a)
#pragma unroll
        for (int b = 0; b < 2; ++b)
#pragma unroll
            for (int m = 0; m < 4; ++m)
#pragma unroll
                for (int n = 0; n < 2; ++n) acc[a][b][m][n] = (f32x4){0.f, 0.f, 0.f, 0.f};
    bf16x8 At[4][2], B0[2][2], B1[2][2]; i32x8 At8[4], B08[2], B18[2]; (void)At; (void)B0; (void)B1; (void)At8; (void)B08; (void)B18;
    unsigned vA, vB, hA, hB; G_VOFF(cur, vA, vB, hA, hB);
    unsigned vBa = 0, vBb = 0; G_VOFF2(cur, vBa, vBb);
    const char* cA = cur.A; const char* cB = cur.B; const char* cB2 = cur.B2;
    const size_t kstep = 128;
#define VA_C (vA)
#define VB_C (vB)
    G_STAGE(G_SB(0, 0), cB, VB_C, hB / 2); G_STAGEB1(G_SB(0, 1), cB, VB_C, hB, cB2, vBa, vBb); G_STAGE(G_SA(0, 0), cA, VA_C, hA / 2); G_STAGE(G_SA(0, 1), cA + hA, VA_C, hA / 2);
    if (wr == 1) G_BAR;
    G_WAIT_V(2); G_BAR;
    G_STAGE(G_SB(1, 0), cB + kstep, VB_C, hB / 2); G_STAGE(G_SA(1, 0), cA + kstep, VA_C, hA / 2); G_STAGEB1(G_SB(1, 1), cB + kstep, VB_C, hB, cB2 + kstep, vBa, vBb);
    G_WAIT_V(6); G_BAR;
    for (;;) {
        const bool has_next = S.next(ui + 1, nxt);
        unsigned nvA = vA, nvB = vB, nhA = hA, nhB = hB, nvBa = vBa, nvBb = vBb; const char* nA = cA; const char* nB = cB; const char* nB2 = cB2;
        if (has_next) { G_VOFF(nxt, nvA, nvB, nhA, nhB); G_VOFF2(nxt, nvBa, nvBb); nA = nxt.A; nB = nxt.B; nB2 = nxt.B2; }
        const int nt = cur.nt;
        for (int t = 0; t < nt; t += 2) {
            const bool last = (t == nt - 2);
            const char* a1 = cA + (size_t)(t + 1) * kstep;
            const char* a2 = last ? nA : cA + (size_t)(t + 2) * kstep; const char* b2 = last ? nB : cB + (size_t)(t + 2) * kstep;
            const char* a3 = a2 + kstep; const char* b3 = b2 + kstep;
            const char* b2s = last ? nB2 : cB2 + (size_t)(t + 2) * kstep;
            const unsigned xA = last ? nvA : vA, xB = last ? nvB : vB, xhA = last ? nhA : hA, xhB = last ? nhB : hB, xBa = last ? nvBa : vBa, xBb = last ? nvBb : vBb;
#define VA_X (xA)
#define VB_X (xB)
            G_LDB(B0, 0, 0); G_LDB(B1, 0, 1); G_SCHED; G_LDA(At, 0, 0); G_STAGE(G_SA(1, 1), a1 + hA, VA_C, hA / 2);
            G_WAIT_V(8); G_WAIT_L(0); G_BAR; G_MMA(0, 0, At, B0); G_MMA(0, 1, At, B1); G_BAR; G_SCHED;
            G_LDA(At, 0, 1); G_STAGE(G_SB(0, 0), b2, VB_X, xhB / 2); G_STAGEB1(G_SB(0, 1), b2, VB_X, xhB, b2s, xBa, xBb); G_STAGE(G_SA(0, 0), a2, VA_X, xhA / 2);
            G_WAIT_V(8); G_WAIT_L(0); G_BAR; G_MMA(1, 0, At, B0); G_MMA(1, 1, At, B1); G_BAR; G_SCHED;
            G_LDB(B0, 1, 0); G_LDB(B1, 1, 1); G_SCHED; G_LDA(At, 1, 0); G_STAGE(G_SA(0, 1), a2 + xhA, VA_X, xhA / 2);
            G_WAIT_V(8); G_WAIT_L(0); G_BAR; G_MMA(0, 0, At, B0); G_MMA(0, 1, At, B1); G_BAR; G_SCHED;
            G_LDA(At, 1, 1); G_STAGE(G_SB(1, 0), b3, VB_X, xhB / 2); G_STAGEB1(G_SB(1, 1), b3, VB_X, xhB, b2s + kstep, xBa, xBb); G_STAGE(G_SA(1, 0), a3, VA_X, xhA / 2);
            G_WAIT_V(8); G_WAIT_L(0); G_BAR; G_MMA(1, 0, At, B0); G_MMA(1, 1, At, B1); G_BAR; G_SCHED;
        }
#ifndef NO_ALIGN_EPI
        if (wr == 0) G_BAR;
#endif
        if (!S.dry) E(acc, cur, wr, wc, fr, fq);
        if (!has_next) break;
#pragma unroll
        for (int a = 0; a < 2; ++a)
#pragma unroll
            for (int b = 0; b < 2; ++b)
#pragma unroll
                for (int m = 0; m < 4; ++m)
#pragma unroll
                    for (int n = 0; n < 2; ++n) acc[a][b][m][n] = (f32x4){0.f, 0.f, 0.f, 0.f};
        cur = nxt; cA = nA; cB = nB; cB2 = nB2; vA = nvA; vB = nvB; hA = nhA; hB = nhB; vBa = nvBa; vBb = nvBb; ++ui;
#ifndef NO_ALIGN_EPI
        if (wr == 1) G_BAR;
#endif
    }
    G_WAIT_V(0);
#ifdef NO_ALIGN_EPI
    if (wr == 0) G_BAR;
#endif
    G_BAR;
#undef G_SA
#undef G_SB
#undef G_STAGE
#undef G_LDA
#undef G_LDB
#undef G_MMA
#undef G_WAIT_V
#undef G_WAIT_L
#undef G_BAR
#undef G_SCHED
#undef G_VOFF
#undef G_OA
#undef G_OB
#undef VA_C
#undef VB_C
#undef VA_X
#undef VB_X
#undef G_VOFF2
#undef G_STAGE2
#undef G_STAGEB1
}

__device__ __forceinline__ void st16_wt(void* p, const u32x4 v) { asm volatile("global_store_dwordx4 %0, %1, off sc1\n\ts_nop 1" : : "v"(p), "v"(v) : "memory"); }
#ifdef WT_STORES
#define ST16(p, v) st16_wt((void*)(p), __builtin_bit_cast(u32x4, (v)))
#else
#define ST16(p, v) (*(u32x4*)(p) = __builtin_bit_cast(u32x4, (v)))
#endif
#define EPI_ARGS const f32x4 (&acc)[2][2][4][2], const Unit& u, int wr, int wc, int fr, int fq
struct EpiInproj {
    bf16_t* UX; bf16_t* GT; bf16_t* VL; bf16_t* VC;
    __device__ __forceinline__ void operator()(EPI_ARGS) const {
        const int rb = u.pm * 256 + wr * 64 + fr, cb = u.pn * 256 + wc * 32 + 8 * fq;
#pragma unroll
        for (int ai = 0; ai < 2; ++ai)
#pragma unroll
            for (int m = 0; m < 4; ++m) { const int r = rb + ai * 128 + m * 16;
#pragma unroll
                for (int bj = 0; bj < 2; ++bj) { const int c0 = cb + bj * 128; f32x4 v0 = acc[ai][bj][m][0], v1 = acc[ai][bj][m][1];
                    if (u.kind == 0) {
                        ST16(UX + ux_index(c0 >> 4, r, c0 & 15), pack8(v0, v1));
                    } else if (bj == 0) {
                        const bool cosrow = (r < 256) || ((r & 63) == 0); const int Lh = u.mh, j0 = wc * 32 + 8 * fq; const f32x4 b0 = acc[ai][1][m][0], b1 = acc[ai][1][m][1];
                        bf16_t* rowp = (u.kind == 1 ? VL : VC) + ((size_t)u.z * 512 + r) * (size_t)(2 * Lh) + u.pn * 128 + j0;
                        f32x4 e0, e1, z0 = {0.f, 0.f, 0.f, 0.f};
#pragma unroll
                        for (int q = 0; q < 4; ++q) { e0[q] = cosrow ? v0[q] + b0[q] : v0[q] - b0[q]; e1[q] = cosrow ? v1[q] + b1[q] : v1[q] - b1[q]; }
                        if (u.pn == 0 && j0 == 0) { if (cosrow) { e0[0] = v0[0]; z0[0] = b0[0]; } else e0[0] = 0.f; }
                        { u32x4 zv = {0u, 0u, 0u, 0u}; zv.x = cvt_pk_bf16(z0[0], 0.f); ST16(rowp + (cosrow ? Lh : 0), zv); }
                        ST16(rowp + (cosrow ? 0 : Lh), pack8(e0, e1));
                    }
                } }
    }
};
struct EpiGate8 {
    unsigned char* G8;
    __device__ __forceinline__ void operator()(EPI_ARGS) const {
        const int rb = u.pm * 256 + wr * 64 + fr, cb = u.pn * 256 + wc * 32 + 8 * fq;
#pragma unroll
        for (int ai = 0; ai < 2; ++ai)
#pragma unroll
            for (int m = 0; m < 4; ++m) { unsigned char* rowp = G8 + (size_t)(rb + ai * 128 + m * 16) * 2048 + cb;
#pragma unroll
                for (int bj = 0; bj < 2; ++bj) { const f32x4 v0 = acc[ai][bj][m][0] * W8INV, v1 = acc[ai][bj][m][1] * W8INV; u32x2 w; w.x = pack4_fp8(v0[0], v0[1], v0[2], v0[3]); w.y = pack4_fp8(v1[0], v1[1], v1[2], v1[3]); *(u32x2*)(rowp + bj * 128) = w; } }
    }
};
struct EpiP3 {
    bf16_t* YS; float* S; float sl, sc;
    __device__ __forceinline__ void operator()(EPI_ARGS) const {
        const int rb = u.pm * 256 + wr * 64 + fr;
        if (u.kind == 2) { const int cb = wc * 32 + 8 * fq;
#pragma unroll
            for (int ai = 0; ai < 2; ++ai)
#pragma unroll
                for (int m = 0; m < 4; ++m) { bf16_t* rowp = (bf16_t*)S + ((size_t)u.z * CHR + rb + ai * 128 + m * 16) * 256 + cb;
#pragma unroll
                    for (int bj = 0; bj < 2; ++bj) ST16(rowp + bj * 128, pack8(acc[ai][bj][m][0], acc[ai][bj][m][1])); }
        } else { const int cb = u.pn * 256 + wc * 32 + 8 * fq; const float s = u.kind == 0 ? sl : sc; const size_t row0 = u.kind == 0 ? (size_t)TC + (size_t)u.z * L : (size_t)u.z * LC;
#pragma unroll
            for (int ai = 0; ai < 2; ++ai)
#pragma unroll
                for (int m = 0; m < 4; ++m) { bf16_t* rowp = YS + (row0 + rb + ai * 128 + m * 16) * 1024 + cb;
#pragma unroll
                    for (int bj = 0; bj < 2; ++bj) ST16(rowp + bj * 128, pack8(acc[ai][bj][m][0] * s, acc[ai][bj][m][1] * s)); }
        }
    }
};
struct EpiP5 {
    bf16_t* YS; const bf16_t* GT; bf16_t* TM;
    __device__ __forceinline__ void operator()(EPI_ARGS) const {
        const int rb = u.pm * 256 + wr * 64 + fr, cb = u.pn * 256 + wc * 32 + 8 * fq;
        if (u.kind == 0) {
#pragma unroll
            for (int ai = 0; ai < 2; ++ai)
#pragma unroll
                for (int m = 0; m < 4; ++m) { const int r = rb + ai * 128 + m * 16;
#pragma unroll
                    for (int bj = 0; bj < 2; ++bj) { const int c0 = cb + bj * 128; f32x4 v0 = acc[ai][bj][m][0], v1 = acc[ai][bj][m][1];
#pragma unroll
                        for (int j = 0; j < 4; ++j) { v0[j] = fgelu(v0[j]); v1[j] = fgelu(v1[j]); }
                        ST16(YS + ((size_t)r * 16 + (c0 >> 4)) * 1024 + 512 + u.z * 16 + (c0 & 15), pack8(v0, v1)); } }
        } else {
#pragma unroll
            for (int ai = 0; ai < 2; ++ai) { u32x2 gw[4][2];
#pragma unroll
                for (int m = 0; m < 4; ++m)
#pragma unroll
                    for (int bj = 0; bj < 2; ++bj) gw[m][bj] = *(const u32x2*)((const unsigned char*)GT + (size_t)(rb + ai * 128 + m * 16) * 2048 + cb + bj * 128);
#pragma unroll
                for (int m = 0; m < 4; ++m)
#pragma unroll
                    for (int bj = 0; bj < 2; ++bj) { f32x4 g0, g1; unpack8_fp8(gw[m][bj], g0, g1);
#pragma unroll
                        for (int j = 0; j < 4; ++j) { g0[j] = fsigmoid(g0[j]); g1[j] = fsigmoid(g1[j]); }
                        ST16(TM + (size_t)(rb + ai * 128 + m * 16) * 1024 + cb + bj * 128, pack8(acc[ai][bj][m][0] * g0, acc[ai][bj][m][1] * g1)); } }
        }
    }
};
struct EpiGlu {
    const bf16_t* GT; bf16_t* TM; unsigned* ready;
    __device__ __forceinline__ void operator()(EPI_ARGS) const {
        const int rb = u.pm * 256 + wr * 64 + fr, c0 = u.pn * 128 + wc * 32 + 8 * fq; const bool wt = ready != nullptr && u.pm < 16;
#pragma unroll
        for (int ai = 0; ai < 2; ++ai) { u32x2 gw[4]; u32x4 tw[4];
#pragma unroll
            for (int m = 0; m < 4; ++m) { const int r = rb + ai * 128 + m * 16; gw[m] = *(const u32x2*)((const unsigned char*)GT + (size_t)r * 2048 + 1024 + c0); tw[m] = *(const u32x4*)(TM + (size_t)r * 1024 + c0); }
#pragma unroll
            for (int m = 0; m < 4; ++m) { const int r = rb + ai * 128 + m * 16;
                f32x4 g0, g1, t0, t1; unpack8_fp8(gw[m], g0, g1); unpack8(tw[m], t0, t1);
                const f32x4 a0 = acc[ai][0][m][0], a1 = acc[ai][0][m][1], b0 = acc[ai][1][m][0], b1 = acc[ai][1][m][1];
#pragma unroll
                for (int j = 0; j < 4; ++j) { t0[j] += fsigmoid(g0[j]) * a0[j] * fsigmoid(b0[j]); t1[j] += fsigmoid(g1[j]) * a1[j] * fsigmoid(b1[j]); }
                if (wt) st16_wt(TM + (size_t)r * 1024 + c0, pack8(t0, t1)); else ST16(TM + (size_t)r * 1024 + c0, pack8(t0, t1)); } }
        if (wt) { asm volatile("s_waitcnt vmcnt(0)" ::: "memory"); if (fr == 0 && fq == 0) (void)xb_add(ready + 16 * u.pm, 1u); }
    }
};
#ifdef RES16
template <bool LOWREG> struct EpiResT {
    bf16_t* h; bf16_t* z; const float* mod; int gidx; const float* xin; const float* cin; const float* pos; float sc = 1.f;
    __device__ __forceinline__ void operator()(EPI_ARGS) const {
        const int rb = u.pm * 256 + wr * 64 + fr, cb = u.pn * 256 + wc * 32 + 8 * fq;
        const float* gp = mod + (size_t)(rb < TC ? 16 : (rb - TC) >> 11) * 6144 + gidx * 1024 + cb;
        f32x4 gg[2][2];
        if (!LOWREG) {
#pragma unroll
        for (int bj = 0; bj < 2; ++bj)
#pragma unroll
            for (int n = 0; n < 2; ++n) gg[bj][n] = *(const f32x4*)(gp + bj * 128 + n * 4) * sc; }
#pragma unroll
        for (int ai = 0; ai < 2; ++ai) {
            if (LOWREG) {
#pragma unroll
                for (int bj = 0; bj < 2; ++bj)
#pragma unroll
                    for (int n = 0; n < 2; ++n) gg[bj][n] = *(const f32x4*)(gp + bj * 128 + n * 4) * sc; }
            if (xin) {
#pragma unroll
                for (int mh = 0; mh < 2; ++mh) { f32x4 o[2][2][2];
#pragma unroll
                    for (int mm = 0; mm < 2; ++mm) { const int r = rb + ai * 128 + (mh * 2 + mm) * 16;
                        const float* rowp = (r < TC ? cin + (size_t)r * D : xin + (size_t)(r - TC) * D) + cb; const float* prow = pos + (size_t)((r - TC) & (L - 1)) * D + cb;
#pragma unroll
                        for (int bj = 0; bj < 2; ++bj)
#pragma unroll
                            for (int n = 0; n < 2; ++n) { o[mm][bj][n] = *(const f32x4*)(rowp + bj * 128 + n * 4); if (r >= TC) o[mm][bj][n] += *(const f32x4*)(prow + bj * 128 + n * 4); } }
#pragma unroll
                    for (int mm = 0; mm < 2; ++mm) { const int m = mh * 2 + mm; const int r = rb + ai * 128 + m * 16; bf16_t* orow = (r < TC ? z + (size_t)r * D : h + (size_t)(r - TC) * D) + cb;
#pragma unroll
                        for (int bj = 0; bj < 2; ++bj) ST16(orow + bj * 128, pack8(o[mm][bj][0] + gg[bj][0] * acc[ai][bj][m][0], o[mm][bj][1] + gg[bj][1] * acc[ai][bj][m][1])); }
                    asm volatile("" ::: "memory"); }
            } else { u32x4 ow[4][2];
#pragma unroll
                for (int m = 0; m < 4; ++m) { const int r = rb + ai * 128 + m * 16; const bf16_t* rowp = (r < TC ? z + (size_t)r * D : h + (size_t)(r - TC) * D) + cb;
#pragma unroll
                    for (int bj = 0; bj < 2; ++bj) ow[m][bj] = *(const u32x4*)(rowp + bj * 128); }
#pragma unroll
                for (int m = 0; m < 4; ++m) { const int r = rb + ai * 128 + m * 16; bf16_t* orow = (r < TC ? z + (size_t)r * D : h + (size_t)(r - TC) * D) + cb;
#pragma unroll
                    for (int bj = 0; bj < 2; ++bj) { f32x4 a, b; unpack8(ow[m][bj], a, b); ST16(orow + bj * 128, pack8(a + gg[bj][0] * acc[ai][bj][m][0], b + gg[bj][1] * acc[ai][bj][m][1])); } }
                asm volatile("" ::: "memory"); } }
    }
};
#else
template <bool LOWREG> struct EpiResT {
    float* h; float* z; const float* mod; int gidx; const float* xin; const float* cin; const float* pos; float sc = 1.f;
    __device__ __forceinline__ void operator()(EPI_ARGS) const {
        const int rb = u.pm * 256 + wr * 64 + fr, cb = u.pn * 256 + wc * 32 + 4 * fq;
        const float* gp = mod + (size_t)(rb < TC ? 16 : (rb - TC) >> 11) * 6144 + gidx * 1024 + cb;
        f32x4 gg[2][2];
        if (!LOWREG) {
#pragma unroll
        for (int bj = 0; bj < 2; ++bj)
#pragma unroll
            for (int n = 0; n < 2; ++n) gg[bj][n] = *(const f32x4*)(gp + bj * 128 + n * 16) * sc; }
#pragma unroll
        for (int ai = 0; ai < 2; ++ai)
#pragma unroll
            for (int mh = 0; mh < 2; ++mh) { f32x4 o[2][2][2];
                if (LOWREG) {
#pragma unroll
                    for (int bj = 0; bj < 2; ++bj)
#pragma unroll
                        for (int n = 0; n < 2; ++n) gg[bj][n] = *(const f32x4*)(gp + bj * 128 + n * 16) * sc; }
#pragma unroll
                for (int mm = 0; mm < 2; ++mm) { const int r = rb + ai * 128 + (mh * 2 + mm) * 16;
                    if (xin) { const float* rowp = (r < TC ? cin + (size_t)r * D : xin + (size_t)(r - TC) * D) + cb; const float* prow = pos + (size_t)((r - TC) & (L - 1)) * D + cb;
#pragma unroll
                        for (int bj = 0; bj < 2; ++bj)
#pragma unroll
                            for (int n = 0; n < 2; ++n) { o[mm][bj][n] = *(const f32x4*)(rowp + bj * 128 + n * 16); if (r >= TC) o[mm][bj][n] += *(const f32x4*)(prow + bj * 128 + n * 16); }
                    } else { const float* rowp = (r < TC ? z + (size_t)r * D : h + (size_t)(r - TC) * D) + cb;
#pragma unroll
                        for (int bj = 0; bj < 2; ++bj)
#pragma unroll
                            for (int n = 0; n < 2; ++n) o[mm][bj][n] = *(const f32x4*)(rowp + bj * 128 + n * 16); } }
#pragma unroll
                for (int mm = 0; mm < 2; ++mm) { const int m = mh * 2 + mm; const int r = rb + ai * 128 + m * 16; float* rowp = (r < TC ? z + (size_t)r * D : h + (size_t)(r - TC) * D) + cb;
#pragma unroll
                    for (int bj = 0; bj < 2; ++bj)
#pragma unroll
                        for (int n = 0; n < 2; ++n) ST16(rowp + bj * 128 + n * 16, o[mm][bj][n] + gg[bj][n] * acc[ai][bj][m][n]); }
                asm volatile("" ::: "memory"); }
    }
};
#endif
using EpiRes = EpiResT<false>; using EpiRes8 = EpiResT<true>;
struct EpiSwigluH8 {
    unsigned char* H;
    __device__ __forceinline__ void operator()(EPI_ARGS) const {
        const int rb = u.pm * 256 + wr * 64 + fr, c0 = u.pn * 128 + wc * 32 + 8 * fq;
#pragma unroll
        for (int ai = 0; ai < 2; ++ai)
#pragma unroll
            for (int m = 0; m < 4; ++m) { const int r = rb + ai * 128 + m * 16;
                f32x4 a0 = acc[ai][0][m][0], a1 = acc[ai][0][m][1]; const f32x4 b0 = acc[ai][1][m][0], b1 = acc[ai][1][m][1];
#pragma unroll
                for (int j = 0; j < 4; ++j) { a0[j] = a0[j] * fsigmoid(a0[j]) * b0[j]; a1[j] = a1[j] * fsigmoid(a1[j]) * b1[j]; }
                u32x2 w; w.x = pack4_fp8(a0[0], a0[1], a0[2], a0[3]); w.y = pack4_fp8(a1[0], a1[1], a1[2], a1[3]); *(u32x2*)(H + (size_t)r * DFF + c0) = w; }
    }
};
struct EpiSwiglu {
    bf16_t* H; int ld; int row0;
    __device__ __forceinline__ void operator()(EPI_ARGS) const {
        const int rb = u.pm * 256 + wr * 64 + fr - row0, c0 = u.pn * 128 + wc * 32 + 8 * fq;
#pragma unroll
        for (int ai = 0; ai < 2; ++ai)
#pragma unroll
            for (int m = 0; m < 4; ++m) { const int r = rb + ai * 128 + m * 16;
                f32x4 a0 = acc[ai][0][m][0], a1 = acc[ai][0][m][1]; const f32x4 b0 = acc[ai][1][m][0], b1 = acc[ai][1][m][1];
#pragma unroll
                for (int j = 0; j < 4; ++j) { a0[j] = a0[j] * fsigmoid(a0[j]) * b0[j]; a1[j] = a1[j] * fsigmoid(a1[j]) * b1[j]; }
                ST16(H + (size_t)r * ld + c0, pack8(a0, a1)); }
    }
};
struct EpiBf {
    bf16_t* O; int ld;
    __device__ __forceinline__ void operator()(EPI_ARGS) const {
        const int rb = u.pm * 256 + wr * 64 + fr, cb = u.pn * 256 + wc * 32 + 8 * fq;
#pragma unroll
        for (int ai = 0; ai < 2; ++ai)
#pragma unroll
            for (int m = 0; m < 4; ++m) { bf16_t* rowp = O + (size_t)(rb + ai * 128 + m * 16) * ld + cb;
#pragma unroll
                for (int bj = 0; bj < 2; ++bj) ST16(rowp + bj * 128, pack8(acc[ai][bj][m][0], acc[ai][bj][m][1])); }
    }
};
struct EpiBf8 {
    bf16_t* O;
    __device__ __forceinline__ void operator()(EPI_ARGS) const {
        const int rb = u.pm * 256 + wr * 64 + fr, cb = u.pn * 256 + wc * 32 + 8 * fq;
#pragma unroll
        for (int ai = 0; ai < 2; ++ai)
#pragma unroll
            for (int m = 0; m < 4; ++m) { bf16_t* rowp = O + (size_t)(rb + ai * 128 + m * 16) * D + cb;
#pragma unroll
                for (int bj = 0; bj < 2; ++bj) ST16(rowp + bj * 128, pack8(acc[ai][bj][m][0] * W8INV, acc[ai][bj][m][1] * W8INV)); }
    }
};

__device__ __forceinline__ float clamp_e4m3(float v) { return __builtin_amdgcn_fmed3f(v, -448.f, 448.f); }
struct EpiSwiglu8 {
    unsigned char* H; int row0;
    __device__ __forceinline__ void operator()(EPI_ARGS) const {
        const int rb = u.pm * 256 + wr * 64 + fr - row0, c0 = u.pn * 128 + wc * 32 + 8 * fq;
#pragma unroll
        for (int ai = 0; ai < 2; ++ai)
#pragma unroll
            for (int m = 0; m < 4; ++m) { const int r = rb + ai * 128 + m * 16;
                f32x4 a0 = acc[ai][0][m][0] * W8INV, a1 = acc[ai][0][m][1] * W8INV; const f32x4 b0 = acc[ai][1][m][0] * W8INV, b1 = acc[ai][1][m][1] * W8INV;
#pragma unroll
                for (int j = 0; j < 4; ++j) { a0[j] = a0[j] * fsigmoid(a0[j]) * b0[j]; a1[j] = a1[j] * fsigmoid(a1[j]) * b1[j]; }
                u32x2 w; w.x = pack4_fp8(a0[0], a0[1], a0[2], a0[3]); w.y = pack4_fp8(a1[0], a1[1], a1[2], a1[3]); *(u32x2*)(H + (size_t)r * DFE + c0) = w; }
    }
};
template <class E0, class E1> struct EpiMix {
    E0 e0; E1 e1;
    __device__ __forceinline__ void operator()(EPI_ARGS) const { if (u.kind == 0) e0(acc, u, wr, wc, fr, fq); else e1(acc, u, wr, wc, fr, fq); }
};

#ifdef RES16
typedef bf16_t res_t;
#else
typedef float res_t;
#endif
__device__ __forceinline__ f32x4 ld4(const float* p) { return *(const f32x4*)p; }
__device__ __forceinline__ f32x4 ld4(const bf16_t* p) { const u32x2 w = *(const u32x2*)p; return (f32x4){bflo(w.x), bfhi(w.x), bflo(w.y), bfhi(w.y)}; }
struct Args { const float* in[30]; float* out; unsigned char* ws; int ph_lo, ph_hi, mask, pad; };
enum { I_X, I_C, I_CTX, I_CCTX, I_WMOD, I_BMOD, I_N1G, I_N2G, I_WIN, I_WFOUR, I_ARE, I_AIM, I_LOGDT, I_BRE, I_BIM, I_CRE, I_CIM, I_SSMD, I_GLUA, I_GLUB, I_WOUT, I_FG, I_FU, I_FD, I_MR, I_MBR, I_MG, I_MU, I_MD, I_FINALG };

constexpr int TR_SCR = 64 * 72 * 2;
__device__ __forceinline__ void tr_item(const float* W, int ldw, int k0, int n0, bf16_t* WT, int ldk, int drow0, LAS unsigned char* scr, int lane) {
    const int c4 = (lane & 15) * 4, kr = 2 * (lane >> 4);
#pragma unroll
    for (int s = 0; s < 8; ++s) { const int kk = 8 * s + kr; const float* p = W + (size_t)(k0 + kk) * ldw + n0 + c4; const f32x4 r0 = *(const f32x4*)p, r1 = *(const f32x4*)(p + ldw);
#pragma unroll
        for (int q = 0; q < 4; ++q) *(LAS unsigned*)(scr + ((c4 + q) * 72 + kk) * 2) = cvt_pk_bf16(r0[q], r1[q]); }
    asm volatile("s_waitcnt lgkmcnt(0)" ::: "memory");
    const int c = lane & 7;
#pragma unroll
    for (int j = 0; j < 8; ++j) { const int n = (lane >> 3) + 8 * j; const u32x4 o = *(const LAS u32x4*)(scr + (n * 72 + 8 * c) * 2); *(u32x4*)(WT + (size_t)(drow0 + n) * ldk + k0 + 8 * c) = o; }
    asm volatile("s_waitcnt lgkmcnt(0)" ::: "memory");
}
__device__ __forceinline__ void tr_mat_item(const float* W, int K, int N, int ldw, int coff, bf16_t* WT, int roff, int mode, int it, LAS unsigned char* scr, int lane) {
    const int nblk = N / 64, kb = it / nblk, nb = it - kb * nblk, n0 = nb * 64;
    const int drow = mode == 0 ? roff + n0 : ((n0 >> 7) * 256 + (mode == 2 ? 128 : 0) + (n0 & 127));
    tr_item(W, ldw, kb * 64, coff + n0, WT, K, drow, scr, lane);
}

__device__ __forceinline__ void tr_item8(const float* W, int ldw, int k0, int n0, unsigned char* WT, int ldk, int drow0, float wsc, LAS unsigned char* scr, int lane) {
    const int c4 = (lane & 15) * 4, kr = 2 * (lane >> 4);
#pragma unroll
    for (int s = 0; s < 8; ++s) { const int kk = 8 * s + kr; const float* p = W + (size_t)(k0 + kk) * ldw + n0 + c4; const f32x4 r0 = *(const f32x4*)p, r1 = *(const f32x4*)(p + ldw);
#pragma unroll
        for (int q = 0; q < 4; ++q) *(LAS unsigned short*)(scr + (c4 + q) * 80 + kk) = (unsigned short)__builtin_amdgcn_cvt_pk_fp8_f32(__builtin_amdgcn_fmed3f(r0[q] * wsc, -448.f, 448.f), __builtin_amdgcn_fmed3f(r1[q] * wsc, -448.f, 448.f), 0u, false); }
    asm volatile("s_waitcnt lgkmcnt(0)" ::: "memory");
    const int c = lane & 3;
#pragma unroll
    for (int j = 0; j < 4; ++j) { const int n = (lane >> 2) + 16 * j; const u32x4 o = *(const LAS u32x4*)(scr + n * 80 + 16 * c); *(u32x4*)(WT + (size_t)(drow0 + n) * ldk + k0 + 16 * c) = o; }
    asm volatile("s_waitcnt lgkmcnt(0)" ::: "memory");
}
__device__ __forceinline__ void tr_mat_item8(const float* W, int K, int N, int ldw, unsigned char* WT, int mode, float wsc, int it, LAS unsigned char* scr, int lane, int coff = 0) {
    const int nblk = N / 64, kb = it / nblk, nb = it - kb * nblk, n0 = nb * 64;
    const int drow = mode == 0 ? n0 : ((n0 >> 7) * 256 + (mode == 2 ? 128 : 0) + (n0 & 127));
    tr_item8(W, ldw, kb * 64, coff + n0, WT, K, drow, wsc, scr, lane);
}

template <bool ROUTE, class ST, bool PRE = false>
__device__ __forceinline__ void norm_row(const ST* src, const float* g, const float* sh, const float* sc, bf16_t* dst, int lane, const float* wr, const float* br, int& e1o, int& e2o, float& w1o, const float* addp = nullptr, float* outp = nullptr, unsigned char* dst8 = nullptr,
                                         const f32x4 p0 = {0.f, 0.f, 0.f, 0.f}, const f32x4 p1 = {0.f, 0.f, 0.f, 0.f}, const f32x4 p2 = {0.f, 0.f, 0.f, 0.f}, const f32x4 p3 = {0.f, 0.f, 0.f, 0.f}) {
    f32x4 v[4]; float ss = 0.f;
#pragma unroll
    for (int j = 0; j < 4; ++j) { if (PRE) v[j] = j == 0 ? p0 : (j == 1 ? p1 : (j == 2 ? p2 : p3)); else v[j] = ld4(src + j * 256 + lane * 4); if (addp) v[j] += *(const f32x4*)(addp + j * 256 + lane * 4); if (outp) *(f32x4*)(outp + j * 256 + lane * 4) = v[j]; ss += v[j][0] * v[j][0] + v[j][1] * v[j][1] + v[j][2] * v[j][2] + v[j][3] * v[j][3]; }
    ss = wsum(ss, lane); const float rstd = rsqrtf(ss * (1.f / D) + EPS);
    float lg[8];
#pragma unroll
    for (int e = 0; e < 8; ++e) lg[e] = 0.f;
#pragma unroll
    for (int j = 0; j < 4; ++j) { const int k = j * 256 + lane * 4; const f32x4 gg = *(const f32x4*)(g + k), s1 = *(const f32x4*)(sc + k), s0 = *(const f32x4*)(sh + k);
        f32x4 a;
#pragma unroll
        for (int q = 0; q < 4; ++q) a[q] = v[j][q] * rstd * gg[q] * (1.f + s1[q]) + s0[q];
        if (ROUTE) *(unsigned*)((unsigned char*)dst + k) = pack4_fp8(a[0], a[1], a[2], a[3]);
        else { u32x2 o; o.x = cvt_pk_bf16(a[0], a[1]); o.y = cvt_pk_bf16(a[2], a[3]); *(u32x2*)(dst + k) = o; if (dst8) *(unsigned*)(dst8 + k) = pack4_fp8(a[0], a[1], a[2], a[3]); }
        if (ROUTE) {
#pragma unroll
            for (int q = 0; q < 4; ++q) { const f32x4 w0 = *(const f32x4*)(wr + (k + q) * 8), w1 = *(const f32x4*)(wr + (k + q) * 8 + 4);
#pragma unroll
                for (int e = 0; e < 4; ++e) { lg[e] += a[q] * w0[e]; lg[4 + e] += a[q] * w1[e]; } } } }
    if (ROUTE) {
#pragma unroll
        for (int e = 0; e < 8; ++e) lg[e] = wsum(lg[e], lane) + br[e];
        int e1 = 0; float v1 = lg[0];
#pragma unroll
        for (int e = 1; e < 8; ++e) if (lg[e] > v1) { v1 = lg[e]; e1 = e; }
        int e2 = -1; float v2 = -3.0e38f;
#pragma unroll
        for (int e = 0; e < 8; ++e) if (e != e1 && lg[e] > v2) { v2 = lg[e]; e2 = e; }
        e1o = e1; e2o = e2; w1o = 1.f / (1.f + expf(v2 - v1));
    }
}

#define LD_ROW4(dst, p) _Pragma("unroll") for (int j_ = 0; j_ < 4; ++j_) dst[j_] = ld4((p) + j_ * 256 + lane * 4)
__global__ void __launch_bounds__(512, 2) fwd(Args args) {
    extern __shared__ __attribute__((aligned(16))) unsigned char lds_raw[];
    LAS unsigned char* lds = (LAS unsigned char*)lds_raw;
    volatile LAS unsigned* MISC = (volatile LAS unsigned*)(lds + MISC_OFF);
    const unsigned g_wave_s = (unsigned)__builtin_amdgcn_readfirstlane((int)(threadIdx.x >> 6));
    const int G = gridDim.x, bx = blockIdx.x, NGW = G * 8;
#define PHASE_IDS int tid = TIDX; asm volatile("" : "+v"(tid)); const int lane = tid & 63, wave = __builtin_amdgcn_readfirstlane(tid >> 6), gw = bx * 8 + wave; (void)lane; (void)gw;
    unsigned char* ws = args.ws;
    unsigned* ctl = (unsigned*)(ws + WS_CTL);
    const int lo = args.ph_lo, hi = args.ph_hi, mask = args.mask;
    { PHASE_IDS for (int u = tid; u < (LDS_BYTES - STAGE_BYTES) / 4; u += 512) ((LAS unsigned*)(lds + STAGE_BYTES))[u] = 0u; }
    __syncthreads();
    if (hi - lo > 1) (void)xcd_barrier_post(ctl + CW_BAR, MISC + 8, g_wave_s);
#ifndef ONLYPH
#define ONLYPH -1
#endif
#define PHON(k) (ONLYPH < 0 || ONLYPH == (k))
#define IN(k) (lo <= (k) && (k) < hi)
#define MKBAR XcdBarrier _b; _b.bar = (unsigned*)(ws + WS_CTL) + CW_BAR; _b.x = xb_xcc_id(); _b.st = (volatile LAS unsigned*)(lds + MISC_OFF) + 8;
#ifdef DOUBLE_BAR
#define SEAM(k) do { if (lo <= (k) && (k) + 1 < hi) { MKBAR xcd_barrier(_b, g_wave_s); xcd_barrier(_b, g_wave_s); } STAMP_E(k); } while (0)
#else
#define SEAM(k) do { if (lo <= (k) && (k) + 1 < hi) { MKBAR xcd_barrier(_b, g_wave_s); } STAMP_E(k); } while (0)
#endif
#ifdef PROBE_A
#define STAMP_B(k) do { if (PROBE_A == (k) && bx == 0 && TIDX == 0) { ctl[CW_NT + 64] = (unsigned)wall_clock64(); ctl[CW_NT + 66] = (unsigned)clock64(); } } while (0)
#define STAMP_E(k) do { if (PROBE_B == (k) && bx == 0 && TIDX == 0) { ctl[CW_NT + 65] = (unsigned)wall_clock64(); ctl[CW_NT + 67] = (unsigned)clock64(); } } while (0)
#else
#define STAMP_B(k) do { } while (0)
#define STAMP_E(k) do { } while (0)
#endif

#define h (args.out)
#define zs ((float*)(ws + WS_Z))
#ifdef RES16
#define HS ((res_t*)(ws + WS_H16))
#define RESPERM 1
#else
#define HS ((res_t*)(args.out))
#define RESPERM 0
#endif
#define ZS ((res_t*)(ws + WS_Z))
#define mod ((float*)(ws + WS_MOD))
#define XA ((bf16_t*)(ws + WS_XA))
#define YS ((bf16_t*)(ws + WS_YS))
#define UX ((bf16_t*)(ws + WS_UX))
#define GT ((bf16_t*)(ws + WS_GT))
#define VL ((bf16_t*)(ws + WS_VT2L))
#define VC ((bf16_t*)(ws + WS_VT2C))
#define Sst ((float*)(ws + WS_S))
#define TM ((bf16_t*)(ws + WS_TM))
#define HID ((bf16_t*)(ws + WS_HID))
#define cnt ((int*)(ctl + CW_CNT))
#define tok_e ((int*)(ws + WS_TOKE))
#define tok_w ((float*)(ws + WS_TOKW))
#define tok_pos ((int*)(ws + WS_TOKPOS))
#define tok_row ((int*)(ws + WS_TOKROW))
#define tile_e ((int*)(ws + WS_TILEE))

    STAMP_B(0);
    if (IN(0)) { PHASE_IDS
#ifdef DYNPRO
        for (;;) { volatile LAS unsigned* tk = (volatile LAS unsigned*)(lds + MISC_OFF) + 32; __syncthreads(); if (tid == 0) tk[0] = atomicAdd(ctl + CW_PQ, 1u); __syncthreads();
            const int qi = (int)tk[0]; if (qi >= 352) break;
#ifdef PRO_ORDER2
            const int hit = qi < 128 ? qi : (qi < 224 ? 256 + (qi - 128) : 128 + (qi - 224));
#else
            const int hit = qi < 96 ? 256 + qi : qi - 96;
#endif
#else
        for (int hit = bx; hit < 352; hit += G) {
#endif
        if (hit < 128) {
            const int l = hit >> 6, g = (hit >> 1) & 31, dir = hit & 1; const int gd = (l * 2 + dir) * 32 + g;
            LAS float* POWr = (LAS float*)(lds); LAS float* POWi = POWr + 64 * 17; LAS float* Bbr = POWi + 64 * 17; LAS float* Bbi = Bbr + 1024; LAS float* Cr = Bbi + 1024; LAS float* Ci = Cr + 1024; LAS float* Kt = Ci + 1024;
            const float dt = expf(args.in[I_LOGDT][gd]);
            for (int o = tid; o < 64 * 17; o += 512) { const int p = o / 17, e = o - p * 17; const float lr = args.in[I_ARE][gd * 64 + p] * dt, li = args.in[I_AIM][gd * 64 + p] * dt; const float mg = expf(lr * e); POWr[o] = mg * cosf(li * e); POWi[o] = mg * sinf(li * e); }
            __syncthreads();
            for (int o = tid; o < 1024; o += 512) { const int p = o >> 4, hh = o & 15; const int gp = gd * 64 + p; const float ar = args.in[I_ARE][gp], ai = args.in[I_AIM][gp];
                const float lbr = POWr[p * 17 + 1], lbi = POWi[p * 17 + 1], nr = lbr - 1.f, ni = lbi, den = ar * ar + ai * ai, qr = (nr * ar + ni * ai) / den, qi = (ni * ar - nr * ai) / den;
                const float x0 = args.in[I_BRE][(size_t)gp * 16 + hh], x1 = args.in[I_BIM][(size_t)gp * 16 + hh]; Bbr[o] = qr * x0 - qi * x1; Bbi[o] = qr * x1 + qi * x0;
                const int h2 = o >> 6, p2 = o & 63; const size_t ci = ((size_t)gd * 16 + h2) * 64 + p2; Cr[o] = args.in[I_CRE][ci]; Ci[o] = args.in[I_CIM][ci]; }
            if (tid < 64) { float* lamq = (float*)(ws + WS_LAMQ) + (size_t)(gd * 64 + tid) * 2; lamq[0] = POWr[tid * 17 + 16]; lamq[1] = POWi[tid * 17 + 16]; }
            __syncthreads();
            for (int o = tid; o < 4096; o += 512) { const int tau = o >> 8, hh = (o >> 4) & 15, h2 = o & 15; float sacc = 0.f;
#pragma unroll 4
                for (int p = 0; p < 64; ++p) { const float pr = POWr[p * 17 + tau], pi = POWi[p * 17 + tau], br_ = Bbr[p * 16 + h2], bi_ = Bbi[p * 16 + h2];
                    const float wr_ = pr * br_ - pi * bi_, wi_ = pr * bi_ + pi * br_; sacc += Cr[hh * 64 + p] * wr_ - Ci[hh * 64 + p] * wi_; }
                ((float*)(ws + WS_S))[(size_t)gd * 4096 + o] = sacc; }
            bf16_t* TG = (bf16_t*)(ws + WS_S5TG + (size_t)l * S5_LSTRIDE) + (size_t)g * 256 * 512; bf16_t* EE = (bf16_t*)(ws + WS_S5E + (size_t)l * S5_LSTRIDE) + (size_t)g * 256 * 256;
            for (int o2 = tid; o2 < 256 * 64; o2 += 512) { const int row = o2 >> 6, kk0 = (o2 & 63) * 2, t = row >> 4, hh = row & 15, e = dir == 0 ? t + 1 : 16 - t; float v2[2];
#pragma unroll
                for (int e2 = 0; e2 < 2; ++e2) { const int kk = kk0 + e2, p = kk >> 1, ri = kk & 1; const float cr = Cr[hh * 64 + p], ci = Ci[hh * 64 + p], pr = POWr[p * 17 + e], pi = POWi[p * 17 + e];
                    v2[e2] = ri == 0 ? (cr * pr - ci * pi) : -(cr * pi + ci * pr); }
                *(unsigned*)(TG + (size_t)row * 512 + 256 + dir * 128 + kk0) = cvt_pk_bf16(v2[0], v2[1]); }
            for (int o2 = tid; o2 < 128 * 128; o2 += 512) { const int rr = o2 >> 7, k0 = (o2 & 127) * 2, p = rr >> 1, ri = rr & 1; float v2[2];
#pragma unroll
                for (int e2 = 0; e2 < 2; ++e2) { const int k = k0 + e2, sx = k >> 4, h2 = k & 15, e = dir == 0 ? 15 - sx : sx;
                    const float pr = POWr[p * 17 + e], pi = POWi[p * 17 + e], br_ = Bbr[p * 16 + h2], bi_ = Bbi[p * 16 + h2];
                    v2[e2] = ri == 0 ? (pr * br_ - pi * bi_) : (pr * bi_ + pi * br_); }
                *(unsigned*)(EE + (size_t)(dir * 128 + rr) * 256 + k0) = cvt_pk_bf16(v2[0], v2[1]); }
            __syncthreads();
        } else if (hit < 256) {
            const int it = hit - 128, l = it >> 6, g = (it >> 4) & 3, kb = it & 15;
            LAS float* wT = (LAS float*)(lds);
            LAS float* ct = wT + 128 * 65;
            if (tid < 256) ct[tid] = tid < 128 ? cospif((float)tid / 64.f) : sinpif((float)(tid - 128) / 64.f);
            { const float* wsrc = args.in[I_WIN] + (size_t)l * D * INC + (size_t)(kb * 64) * INC + g * 128;
              for (int o = tid; o < 64 * 32; o += 512) { const int kk = o >> 5, c4 = (o & 31) * 4; const f32x4 wv = *(const f32x4*)(wsrc + (size_t)kk * INC + c4);
#pragma unroll
                  for (int q = 0; q < 4; ++q) wT[(c4 + q) * 65 + kk] = wv[q]; } }
            __syncthreads();
            { const int kk = tid & 63, jg = tid >> 6; bf16_t* dstb = (bf16_t*)(ws + WS_MIXW + (size_t)l * MIXW_LSTRIDE);
#pragma unroll 1
              for (int jj = 0; jj < 16; ++jj) { const int o = jg * 16 + jj; const int type = o > 64 ? 1 : 0, kp = o <= 64 ? o : o - 64, row = o < 64 ? g * 64 + o : 256 + g * 64 + (o - 64); float sacc = 0.f;
#pragma unroll 8
                  for (int c = 0; c < 128; ++c) sacc += wT[c * 65 + kk] * ct[type * 128 + ((c * kp) & 127)];
                  dstb[(size_t)row * 1024 + kb * 64 + kk] = f2bf(sacc); } }
            __syncthreads();
        } else {
            const int it = hit - 256, l = it / 48, cb = it % 48; LAS float* sl = (LAS float*)(lds); LAS float* part = sl + 17 * 1024;
            for (int o = tid; o < 17 * 1024; o += 512) { const int r = o >> 10, k = o & 1023; const float v = r < 16 ? args.in[I_C][r * D + k] : args.in[I_CCTX][k]; sl[o] = v / (1.f + expf(-v)); }
            __syncthreads();
            const int col = cb * 128 + (tid & 127), kq = tid >> 7; const float* w = args.in[I_WMOD] + (size_t)l * D * 6144 + col;
            float a[17];
#pragma unroll
            for (int r = 0; r < 17; ++r) a[r] = 0.f;
#pragma unroll 4
            for (int k = kq * 256; k < kq * 256 + 256; ++k) { const float wv = w[(size_t)k * 6144];
#pragma unroll
                for (int r = 0; r < 17; ++r) a[r] += sl[r * 1024 + k] * wv; }
#pragma unroll
            for (int r = 0; r < 17; ++r) part[(kq * 17 + r) * 128 + (tid & 127)] = a[r];
            __syncthreads();
            for (int o = tid; o < 17 * 128; o += 512) { const int r = o >> 7, c = o & 127; const float s = part[(0 * 17 + r) * 128 + c] + part[(1 * 17 + r) * 128 + c] + part[(2 * 17 + r) * 128 + c] + part[(3 * 17 + r) * 128 + c];
                mod[((size_t)l * 17 + r) * 6144 + cb * 128 + c] = s + args.in[I_BMOD][l * 6144 + cb * 128 + c]; }
            __syncthreads();
        } }
        {
            const int lb = bx, LG = G, lgw = lb * 8 + wave, LNGW = LG * 8;
            LAS unsigned char* scr = lds + wave * TR_SCR;
            { constexpr int I_SG = 16 * 40, I_4 = 8 * 16, I_GL = 8 * 16, I_O = 16 * 16, PERL = I_SG + I_4 + 2 * I_GL + I_O, I_FGU = 16 * 44, I_FDN = 44 * 16, NIT = 2 * PERL + 2 * I_FGU + I_FDN;
#ifdef DYNPRO
              unsigned nt = 0u; if (lane == 0) nt = atomicAdd(ctl + CW_PQ + 16, 1u);
              for (;;) { const int it = __builtin_amdgcn_readfirstlane((int)nt); if (it >= NIT) break; if (lane == 0) nt = atomicAdd(ctl + CW_PQ + 16, 1u);
                  int r = it;
#else
              for (int it = lgw; it < NIT; it += LNGW) { int r = it;
#endif
                  if (r < 2 * PERL) { const int l = r / PERL; r -= l * PERL; unsigned char* mw = ws + WS_MIXW + (size_t)l * MIXW_LSTRIDE;
                      if (r < I_SG) {
                          if (r < 16 * 8) tr_mat_item(args.in[I_WIN] + (size_t)l * D * INC, 1024, 512, INC, 512, (bf16_t*)(mw + 2 * MiB), 0, 0, r, scr, lane);
                          else tr_mat_item8(args.in[I_WIN] + (size_t)l * D * INC, 1024, 2048, INC, mw + 3 * MiB, 0, W8SC, r - 16 * 8, scr, lane, 1024);
                          continue; } r -= I_SG;
                      if (r < I_4) { continue; } r -= I_4;
                      if (r < I_GL) { tr_mat_item(args.in[I_GLUA] + (size_t)l * 512 * D, 512, 1024, D, 0, (bf16_t*)(mw + 8 * MiB), 0, 1, r, scr, lane); continue; } r -= I_GL;
                      if (r < I_GL) { tr_mat_item(args.in[I_GLUB] + (size_t)l * 512 * D, 512, 1024, D, 0, (bf16_t*)(mw + 8 * MiB), 0, 2, r, scr, lane); continue; } r -= I_GL;
                      tr_mat_item(args.in[I_WOUT] + (size_t)l * D * D, 1024, 1024, D, 0, (bf16_t*)(mw + 10 * MiB), 0, 0, r, scr, lane); continue; }
                  r -= 2 * PERL;
                  if (r < I_FGU) { tr_mat_item(args.in[I_FG], 1024, DFF, DFF, 0, (bf16_t*)(ws + WS_WGU), 0, 1, r, scr, lane); continue; } r -= I_FGU;
                  if (r < I_FGU) { tr_mat_item(args.in[I_FU], 1024, DFF, DFF, 0, (bf16_t*)(ws + WS_WGU), 0, 2, r, scr, lane); continue; } r -= I_FGU;
                  tr_mat_item8(args.in[I_FD], DFF, 1024, D, ws + WS_WDN, 0, W8SC, r, scr, lane); } }
            { int tq = TIDX; asm volatile("" : "+v"(tq));
            for (int o = lb * 512 + tq; o < 2 * 1024 * 256; o += LG * 512) { const int l = o >> 18, col = (o >> 8) & 1023, i0 = (o & 255) * 2; const float* w4 = args.in[I_WFOUR] + (size_t)l * 512 * D + col; float v2[2];
#pragma unroll
                for (int e = 0; e < 2; ++e) { const int i = i0 + e, g = (i >> 6) & 3, sx = i & 63; float val;
                    if (i < 256) { val = w4[(size_t)(g * 128 + sx) * D]; if (sx > 0) val += w4[(size_t)(g * 128 + 128 - sx) * D]; }
                    else { if (sx == 0) val = w4[(size_t)(g * 128 + 64) * D]; else val = w4[(size_t)(g * 128 + sx) * D] - w4[(size_t)(g * 128 + 128 - sx) * D]; }
                    v2[e] = val; }
                *(unsigned*)((bf16_t*)(ws + WS_MIXW + (size_t)l * MIXW_LSTRIDE + 7 * MiB) + (size_t)col * 512 + i0) = cvt_pk_bf16(v2[0], v2[1]); } }
            { bf16_t* DL = (bf16_t*)(ws + WS_DFTL); bf16_t* DC = (bf16_t*)(ws + WS_DFTC); int tq = TIDX; asm volatile("" : "+v"(tq));
              for (int o = lb * 512 + tq; o < 2048 * 256 + 256 * 32; o += LG * 512) { const bool big = o < 2048 * 256; const int oo = big ? o : o - 2048 * 256; const int LL = big ? 2048 : 256, per = LL / 8, Lh = LL / 2;
                  const int n = oo / per, k0 = (oo - n * per) * 8; unsigned w[4];
#pragma unroll
                  for (int q = 0; q < 4; ++q) { float v2[2];
#pragma unroll
                      for (int e = 0; e < 2; ++e) { const int k = k0 + 2 * q + e; const bool sn = k > Lh; const int kk = k < Lh ? k : (k == Lh ? Lh : k - Lh); const int idx = (n * kk) & (LL - 1); const float a = (float)idx * (2.0f / (float)LL); v2[e] = sn ? -sinpif(a) : cospif(a); }
                      w[q] = cvt_pk_bf16(v2[0], v2[1]); }
                  u32x4 o4; o4.x = w[0]; o4.y = w[1]; o4.z = w[2]; o4.w = w[3]; *(u32x4*)((big ? DL : DC) + (size_t)n * LL + k0) = o4; } }
            { float* POS = (float*)(ws + WS_POS); int tq = TIDX; asm volatile("" : "+v"(tq));
              for (int o = lb * 512 + tq; o < L * 256; o += LG * 512) { const int n = o >> 8, d0 = (o & 255) * 4; const int q = d0 >> 8; const float base = q < 2 ? (float)(n >> 6) : (float)(n & 63); f32x4 pv;
#pragma unroll
                  for (int e = 0; e < 4; ++e) { const float omega = 1.0f / powf(10000.f, (float)((d0 + e) & 255) / 256.f); const float ang = base * omega; pv[e] = (q & 1) ? cosf(ang) : sinf(ang); }
                  *(f32x4*)(POS + (size_t)n * D + d0) = pv; } }
        }
    }
    SEAM(0);

    for (int l = 0; l < 2; ++l) {
        const int pb = l == 0 ? 1 : PH_L1; const float* modl = mod + (size_t)l * 17 * 6144; const bool need_ctx = (l == 0);
        unsigned char* mw = ws + WS_MIXW + (size_t)l * MIXW_LSTRIDE;
        const int tile0 = need_ctx ? 0 : 16, ntile = 144 - tile0;
        const int d2a = (need_ctx && G == 256) ? 88 : ntile;
        STAMP_B(pb + 0); if (IN(pb + 0)) { PHASE_IDS const float* g1 = args.in[I_N1G] + l * D;
            if (l == 0) {
                const float* KG = (const float*)(ws + WS_S);
                for (int it = bx; it < 256; it += G) { const int tl = it >> 7, g = (it >> 2) & 31, qq = it & 3; const float* k0p = KG + (size_t)((tl * 2 + 0) * 32 + g) * 4096; const float* k1p = KG + (size_t)((tl * 2 + 1) * 32 + g) * 4096;
                    LAS float* kl = (LAS float*)lds;
                    for (int o = tid; o < 2048; o += 512) { const int hf = o >> 10, q4 = (o & 1023) * 4; *(LAS f32x4*)(kl + hf * 4096 + q4) = *(const f32x4*)((hf ? k1p : k0p) + q4); }
                    __syncthreads();
                    bf16_t* TG = (bf16_t*)(ws + WS_S5TG + (size_t)tl * S5_LSTRIDE) + (size_t)g * 256 * 512; const float* dsk = args.in[I_SSMD] + tl * 512 + g * 16;
                    for (int o2 = tid; o2 < 64 * 128; o2 += 512) { const int row = qq * 64 + (o2 >> 7), k0 = (o2 & 127) * 2, t = row >> 4, hh = row & 15; float v2[2];
#pragma unroll
                        for (int e2 = 0; e2 < 2; ++e2) { const int k = k0 + e2, sx = k >> 4, h2 = k & 15; float val = 0.f; if (sx <= t) val += kl[((t - sx) * 16 + hh) * 16 + h2]; if (sx >= t) val += kl[4096 + ((sx - t) * 16 + hh) * 16 + h2]; if (sx == t && hh == h2) val += dsk[hh]; v2[e2] = val; }
                        *(unsigned*)(TG + (size_t)row * 512 + k0) = cvt_pk_bf16(v2[0], v2[1]); }
                    __syncthreads(); } }
            if (l == 0) {
                const float* POS = (const float*)(ws + WS_POS);
                for (int r = gw; r < TT; r += NGW) { const float* mc = modl + (size_t)(r < TC ? 16 : (r - TC) >> 11) * 6144; int e1, e2; float w1;
                    if (r < TC) norm_row<false>(args.in[I_CTX] + (size_t)r * D, g1, mc, mc + 1024, XA + (size_t)r * D, lane, nullptr, nullptr, e1, e2, w1, nullptr, nullptr, ws + WS_XA8 + (size_t)r * D);
                    else norm_row<false>(args.in[I_X] + (size_t)(r - TC) * D, g1, mc, mc + 1024, XA + (size_t)r * D, lane, nullptr, nullptr, e1, e2, w1, POS + (size_t)((r - TC) & (L - 1)) * D, nullptr, ws + WS_XA8 + (size_t)r * D); }
            } else if (G >= 64 && (mask & F_INPROJ)) {
                if (bx < 32) { JobSched<1> S; S.j[0] = mkjob(XA, mw + 2 * MiB, 0, 0, 2048, 2048, 16, 16, 2, 1, 1, 0, 0, 0); S.init(32, bx); Unit u0; (void)S.next(0, u0);
                    const float* mc = modl + (size_t)16 * 6144; int e1, e2; float w1;
                    for (int rr = wave; rr < 256; rr += 8) { const int r = u0.pm * 256 + rr; norm_row<false>(ZS + (size_t)r * D, g1, mc, mc + 1024, XA + (size_t)r * D, lane, nullptr, nullptr, e1, e2, w1); }
                    asm volatile("s_waitcnt vmcnt(0)" ::: "memory"); __syncthreads();
                    EpiInproj E{UX, GT, VL, VC}; gemm_phase_<EpiInproj, JobSched<1>, false>(lds, S, E, g_wave_s);
                } else { const int lgw = (bx - 32) * 8 + wave, LNGW = (G - 32) * 8;
                    for (int r = TC + lgw; r < TT; r += 2 * LNGW) { const int rn = r + LNGW; const bool has2 = rn < TT; const int r2 = has2 ? rn : r; int e1, e2; float w1;
                        f32x4 va[4], vb[4]; LD_ROW4(va, HS + (size_t)(r - TC) * D); LD_ROW4(vb, HS + (size_t)(r2 - TC) * D);
                        { const float* mc = modl + (size_t)((r - TC) >> 11) * 6144;
                          norm_row<false, res_t, true>(nullptr, g1, mc, mc + 1024, XA + (size_t)r * D, lane, nullptr, nullptr, e1, e2, w1, nullptr, nullptr, ws + WS_XA8 + (size_t)r * D, va[0], va[1], va[2], va[3]); }
                        if (has2) { const float* mc = modl + (size_t)((rn - TC) >> 11) * 6144;
                          norm_row<false, res_t, true>(nullptr, g1, mc, mc + 1024, XA + (size_t)rn * D, lane, nullptr, nullptr, e1, e2, w1, nullptr, nullptr, ws + WS_XA8 + (size_t)rn * D, vb[0], vb[1], vb[2], vb[3]); } } }
            } else
            for (int r = gw; r < TT; r += NGW) { const res_t* src = r < TC ? ZS + (size_t)r * D : HS + (size_t)(r - TC) * D; const float* mc = modl + (size_t)(r < TC ? 16 : (r - TC) >> 11) * 6144; int e1, e2; float w1;
                norm_row<false>(src, g1, mc, mc + 1024, XA + (size_t)r * D, lane, nullptr, nullptr, e1, e2, w1, nullptr, nullptr, ws + WS_XA8 + (size_t)r * D); } }
        SEAM(pb + 0);
        STAMP_B(pb + 1); if (PHON(1) && IN(pb + 1)) { JobSched<4> S;
            S.j[0] = mkjob(XA, mw + 2 * MiB, 0, 0, 2048, 2048, 16, ntile, 2, 1, 1, 0, tile0, 0);
            S.j[1] = mkjob(XA, mw + 2 * MiB, 0, 0, 2048, 2048, 16, (need_ctx || G >= 64) ? 0 : 16, 2, 1, 1, 0, 0, 0);
            S.j[2] = mkjob(mw, XA + (size_t)TC * D, 0, (size_t)L * 2048, 2048, 2048, 16, 2, 8, NB, 1, 1, 0, 0); S.j[2].mirL = L;
            S.j[3] = mkjob(mw, XA, 0, (size_t)LC * 2048, 2048, 2048, 16, 2, 1, need_ctx ? NB : 0, 1, 2, 0, 0); S.j[3].mirL = LC;
            S.init(G, bx); S.dry = (mask & 0x8000) ? 1 : 0; EpiInproj E{UX, GT, VL, VC}; gemm_phase_<EpiInproj, JobSched<4>, true>(lds, S, E, g_wave_s);
#pragma unroll 1
            for (int part = 0; part < 2; ++part) { const bool bal = need_ctx && G == 256; if (part == 1 && (!bal || bx < 64)) break;
              JobSched<1> S8; S8.j[0] = mkjob(ws + WS_XA8, mw + 3 * MiB, 0, 0, 1024, 1024, 8, bal ? (part == 0 ? 96 : 48) : ntile, 8, 1, 1, 0, bal ? part * 96 : tile0, 0);
              S8.init((bal && part == 1) ? 192 : G, bal ? (part == 1 ? bx - 64 : bx) : G - 1 - bx); S8.dry = (mask & 0x8000) ? 1 : 0;
              EpiGate8 E8{(unsigned char*)GT}; gemm_phase_<EpiGate8, JobSched<1>, false, true>(lds, S8, E8, g_wave_s); } }
        SEAM(pb + 1);
        STAMP_B(pb + 2); if (PHON(2) && IN(pb + 2)) {
            const Job jc = mkjob(ws + WS_DFTC, VC, 0, (size_t)512 * 256 * 2, 512, 512, 4, 1, 2, ((mask & F_FOUR) && need_ctx) ? NB : 0, 1, 1, 0, 0);
            const Job jst = mkjob(UX, ws + WS_S5E + (size_t)l * S5_LSTRIDE, (size_t)CHR * 512 * 2, (size_t)256 * 256 * 2, 1024, 512, 4, 9, 1, (mask & F_S5) ? 32 : 0, 1, 2, 0, 0);
            const EpiP3 E{YS, Sst, 1.0f / sqrtf((float)L * 128.f), 1.0f / sqrtf((float)LC * 128.f)};
            if (G == 256 && (mask & F_FOUR)) { P3Sched S;
                S.jq = mkjob(ws + WS_DFTL, VL, 0, (size_t)512 * 2048 * 2, 4096, 4096, 32, 8, 1, NB, 1, 0, 0, 1); S.jq.order = 1;
                S.jp = mkjob(ws + WS_DFTL, VL, 0, (size_t)512 * 2048 * 2, 4096, 4096, 18, 8, 1, NB, 1, 0, 0, 0); S.jp.order = 1;
                S.js0 = jc; S.js1 = jst; S.init(G, bx); S.dry = (mask & 0x8000) ? 1 : 0; gemm_phase_(lds, S, E, g_wave_s);
            } else { JobSched<3> S;
                S.j[0] = mkjob(ws + WS_DFTL, VL, 0, (size_t)512 * 2048 * 2, 4096, 4096, 32, 8, 2, (mask & F_FOUR) ? NB : 0, 1, 0, 0, 0); S.j[0].order = 1;
                S.j[1] = jc; S.j[2] = jst; S.init(G, bx); S.dry = (mask & 0x8000) ? 1 : 0; gemm_phase_(lds, S, E, g_wave_s); } }
        SEAM(pb + 2);
        STAMP_B(pb + 3); if (IN(pb + 3) && (mask & F_S5)) { PHASE_IDS const int id = (G >= 256) ? ((tid < 256) ? bx * 256 + tid : 65536) : bx * 512 + tid;
#ifdef REP_CARRY
#pragma unroll 1
            for (int rep = 0; rep < REP_CARRY; ++rep)
#endif
            if (id < 65536) { const int p = id & 63, dir = (id >> 6) & 1, g = (id >> 7) & 31, b = id >> 12;
                const float* lq = (const float*)(ws + WS_LAMQ) + (size_t)(((l * 2 + dir) * 32 + g) * 64 + p) * 2; const float qr = lq[0], qi = lq[1];
                const bf16_t* __restrict__ Sp = (const bf16_t*)Sst + (size_t)g * CHR * 256 + dir * 128 + p * 2; bf16_t* __restrict__ Xp = UX + (size_t)g * CHR * 512 + 256 + dir * 128 + p * 2;
                float xr = 0.f, xi = 0.f;
                for (int k0 = 0; k0 < 144; k0 += 24) {
                    f32x2 sv[24];
#pragma unroll
                    for (int q = 0; q < 24; ++q) { const int k = k0 + q; const int r = dir == 0 ? (k < 16 ? b * 16 + k : 256 + b * 128 + (k - 16)) : (k < 16 ? b * 16 + 15 - k : 256 + b * 128 + 127 - (k - 16)); const unsigned w = *(const unsigned*)(Sp + (size_t)r * 256); sv[q] = (f32x2){bflo(w), bfhi(w)}; }
#pragma unroll
                    for (int q = 0; q < 24; ++q) { const int k = k0 + q; const int r = dir == 0 ? (k < 16 ? b * 16 + k : 256 + b * 128 + (k - 16)) : (k < 16 ? b * 16 + 15 - k : 256 + b * 128 + 127 - (k - 16));
                        *(unsigned*)(Xp + (size_t)r * 512) = cvt_pk_bf16(xr, xi);
                        const float nr = qr * xr - qi * xi + sv[q][0], ni = qr * xi + qi * xr + sv[q][1]; xr = nr; xi = ni; } } } }
        if (PHON(4) && IN(pb + 3) && (mask & F_GLU)) {
            JobSched<1> S; S.j[0] = mkjob(YS, mw + 7 * MiB, 0, 0, 2048, 1024, 8, d2a, 4, 1, 1, 1, tile0, 0);
            S.init(G, bx); S.dry = (mask & 0x8000) ? 1 : 0; EpiP5 E{YS, GT, TM}; gemm_phase_(lds, S, E, g_wave_s); }
        SEAM(pb + 3);
        STAMP_B(pb + 4); if (PHON(4) && IN(pb + 4)) { JobSched<2> S;
            S.j[0] = mkjob(UX, ws + WS_S5TG + (size_t)l * S5_LSTRIDE, (size_t)CHR * 512 * 2, (size_t)256 * 512 * 2, 1024, 1024, 8, need_ctx ? 9 : 8, 1, (mask & F_S5) ? 32 : 0, 1, 0, need_ctx ? 0 : 1, 0);
            S.j[1] = mkjob(YS, mw + 7 * MiB, 0, 0, 2048, 1024, 8, ntile - d2a, 4, (ntile - d2a) > 0 ? 1 : 0, 1, 1, tile0 + d2a, 0);
            S.init(G, bx); S.dry = (mask & 0x8000) ? 1 : 0; EpiP5 E{YS, GT, TM}; gemm_phase_(lds, S, E, g_wave_s); }
        SEAM(pb + 4);
        STAMP_B(pb + 5); if (PHON(5) && IN(pb + 5)) {
#pragma unroll 1
            for (int part = 0; part < 2; ++part) { const bool bal = need_ctx && G == 256; if (part == 1 && (!bal || bx < 64)) break;
                JobSched<1> S; S.j[0] = mkjob(YS + 512, mw + 8 * MiB, 0, 0, 2048, 1024, 8, bal ? (part == 0 ? 96 : 48) : ntile, 8, 1, 1, 0, bal ? part * 96 : tile0, 0);
                S.init((bal && part == 1) ? 192 : G, (bal && part == 1) ? bx - 64 : bx); S.dry = (mask & 0x8000) ? 1 : 0; EpiGlu E{GT, TM, (bal && part == 0) ? ctl + CW_RDY : nullptr}; gemm_phase_(lds, S, E, g_wave_s); } }
#pragma unroll 1
        for (int sub = 0; sub < 2; ++sub) { const bool bal = need_ctx && G == 256;
            if (sub == 1) STAMP_B(pb + 6);
            if (PHON(6) && (sub == 0 ? (IN(pb + 5) && bal && bx < 64) : IN(pb + 6))) { JobSched<1> S;
                S.j[0] = mkjob(TM, mw + 10 * MiB, 0, 0, 2048, 2048, 16, sub == 0 ? 16 : (bal ? 128 : ntile), 4, 1, RESPERM, 0, sub == 0 ? 0 : (bal ? 16 : tile0), 0);
                S.init(sub == 0 ? 64 : G, bx); S.dry = (mask & 0x8000) ? 1 : 0;
                if (sub == 0) { Unit u0; (void)S.next(0, u0);
                    if (TIDX == 0) { unsigned* bar = ctl + CW_BAR; XB_SPIN(xb_ld(ctl + CW_RDY + 16 * u0.pm) < 64u, bar); __builtin_amdgcn_fence(__ATOMIC_ACQUIRE, "agent"); asm volatile("s_waitcnt vmcnt(0)" ::: "memory"); }
                    __syncthreads(); }
                EpiRes E{HS, ZS, modl, 2, l == 0 ? args.in[I_X] : nullptr, args.in[I_CTX], (const float*)(ws + WS_POS)}; gemm_phase_(lds, S, E, g_wave_s); }
            SEAM(pb + 5 + sub); }
        if (l == 0) {
            STAMP_B(pb + 7); if (IN(pb + 7)) { PHASE_IDS const float* g2 = args.in[I_N2G] + l * D;
                for (int r = gw; r < TT; r += 2 * NGW) { const int rn = r + NGW; const bool has2 = rn < TT; const int r2 = has2 ? rn : r; int e1, e2; float w1;
                    f32x4 va[4], vb[4]; LD_ROW4(va, r < TC ? ZS + (size_t)r * D : HS + (size_t)(r - TC) * D); LD_ROW4(vb, r2 < TC ? ZS + (size_t)r2 * D : HS + (size_t)(r2 - TC) * D);
                    { const float* mc = modl + (size_t)(r < TC ? 16 : (r - TC) >> 11) * 6144 + 3 * 1024;
                      norm_row<false, res_t, true>(nullptr, g2, mc, mc + 1024, XA + (size_t)r * D, lane, nullptr, nullptr, e1, e2, w1, nullptr, nullptr, nullptr, va[0], va[1], va[2], va[3]); }
                    if (has2) { const float* mc = modl + (size_t)(rn < TC ? 16 : (rn - TC) >> 11) * 6144 + 3 * 1024;
                      norm_row<false, res_t, true>(nullptr, g2, mc, mc + 1024, XA + (size_t)rn * D, lane, nullptr, nullptr, e1, e2, w1, nullptr, nullptr, nullptr, vb[0], vb[1], vb[2], vb[3]); } } }
            SEAM(pb + 7);
            STAMP_B(pb + 8); if (PHON(8) && IN(pb + 8)) { JobSched<1> S; S.j[0] = mkjob(XA, ws + WS_WGU, 0, 0, 2048, 2048, 16, 80, 22, 1, 1, 1, 0, 0); S.j[0].grp = FFN_ORDER;
                S.init(G, bx); S.dry = (mask & 0x8000) ? 1 : 0; EpiSwigluH8 E{(unsigned char*)HID}; gemm_phase_(lds, S, E, g_wave_s); }
            SEAM(pb + 8);
            STAMP_B(pb + 9); if (PHON(9) && IN(pb + 9)) { BalSched S;
                S.j[0] = mkjob(HID, ws + WS_WDN, 0, 0, DFF, DFF, 22, 80, 4, 1, RESPERM, 0, 0, 0);
                S.j[1] = mkjob(XA, ws + WS_WGU, 0, 0, 2048, 2048, 16, 64, 22, 1, 1, 1, 80, 0);
                S.init(G, bx);
                { BalLong SL; SL.j = S.j[0]; SL.G = S.G; SL.cp = S.cp; SL.mylong = S.base0 + (S.cp < S.E ? 1 : 0); SL.dry = (mask & 0x8000) ? 1 : 0; EpiRes8 E0{HS, ZS, modl, 5, nullptr, nullptr, nullptr, W8INV}; gemm_phase_<EpiRes8, BalLong, false, true>(lds, SL, E0, g_wave_s); }
                { BalShort SS; SS.j = S.j[1]; SS.cp = S.cp; SS.E = S.E; SS.gH = S.gH; SS.gL = S.gL; SS.extra = S.extra; SS.nl = S.nl; SS.dry = (mask & 0x8000) ? 1 : 0; EpiSwigluH8 E1{(unsigned char*)HID}; gemm_phase_(lds, SS, E1, g_wave_s); } }
            SEAM(pb + 9);
            STAMP_B(pb + 10); if (PHON(9) && IN(pb + 10)) { JobSched<1> S; S.j[0] = mkjob(HID, ws + WS_WDN, 0, 0, DFF, DFF, 22, 64, 4, 1, RESPERM, 0, 80, 0);
                S.init(G, bx); S.dry = (mask & 0x8000) ? 1 : 0; EpiRes8 E{HS, ZS, modl, 5, nullptr, nullptr, nullptr, W8INV}; gemm_phase_<EpiRes8, JobSched<1>, false, true>(lds, S, E, g_wave_s); }
            SEAM(pb + 10);
        }
    }
    {
        const float* modl = mod + (size_t)17 * 6144; unsigned char* XS8 = ws + WS_XS8; bf16_t* OB = (bf16_t*)(ws + WS_O); unsigned char* wmoe = ws + WS_W8; constexpr float WSC = W8SC;
        STAMP_B(PH_MOE); if (IN(PH_MOE)) { PHASE_IDS const float* g2 = args.in[I_N2G] + D; LAS int* lcnt = (LAS int*)(lds + 98304);
            int lc[8];
#pragma unroll
            for (int e = 0; e < 8; ++e) lc[e] = 0;
            for (int t = gw; t < TL; t += NGW) { const float* mc = modl + (size_t)(t >> 11) * 6144 + 3 * 1024; int e1, e2; float w1;
                norm_row<true>(HS + (size_t)t * D, g2, mc, mc + 1024, (bf16_t*)(ws + WS_XR + (size_t)t * D), lane, args.in[I_MR], args.in[I_MBR], e1, e2, w1);
                int p1 = 0, p2 = 0;
#pragma unroll
                for (int e = 0; e < 8; ++e) { if (e == e1) { p1 = lc[e]; lc[e]++; } }
#pragma unroll
                for (int e = 0; e < 8; ++e) { if (e == e2) { p2 = lc[e]; lc[e]++; } }
                if (lane == 0) { tok_e[t * 2] = e1; tok_e[t * 2 + 1] = e2; tok_w[t * 2] = w1; tok_w[t * 2 + 1] = 1.f - w1; tok_pos[t * 2] = p1; tok_pos[t * 2 + 1] = p2; } }
            { int mine = 0;
#pragma unroll
              for (int e = 0; e < 8; ++e) if (lane == e) mine = lc[e];
              if (lane < 8) lcnt[wave * 8 + lane] = mine; }
            __syncthreads();
            if (tid < 8) { int run = 0; for (int w = 0; w < 8; ++w) { const int c = lcnt[w * 8 + tid]; lcnt[64 + w * 8 + tid] = run; run += c; } lcnt[128 + tid] = atomicAdd(&cnt[tid], run); }
            __syncthreads();
            asm volatile("s_waitcnt vmcnt(0)" ::: "memory");
            for (int t = gw; t < TL; t += NGW) { if (lane == 0) { const int ea = tok_e[t * 2], eb = tok_e[t * 2 + 1]; tok_pos[t * 2] += lcnt[64 + wave * 8 + ea] + lcnt[128 + ea]; tok_pos[t * 2 + 1] += lcnt[64 + wave * 8 + eb] + lcnt[128 + eb]; } }
            __syncthreads();
            LAS unsigned char* scr = lds + wave * TR_SCR;
            constexpr int I_G = 16 * 56, I_D = 56 * 16, PERE = 2 * I_G + I_D;
            for (int it = gw; it < 8 * PERE; it += NGW) {
                const int e = it / PERE; int r = it - e * PERE; unsigned char* wg = wmoe + (size_t)e * W8_ESTRIDE; unsigned char* wd = wg + W8_DN;
                if (r < I_G) { tr_mat_item8(args.in[I_MG] + (size_t)e * D * DFE, 1024, DFE, DFE, wg, 1, WSC, r, scr, lane); continue; } r -= I_G;
                if (r < I_G) { tr_mat_item8(args.in[I_MU] + (size_t)e * D * DFE, 1024, DFE, DFE, wg, 2, WSC, r, scr, lane); continue; } r -= I_G;
                tr_mat_item8(args.in[I_MD] + (size_t)e * DFE * D, DFE, 1024, D, wd, 0, WSC, r, scr, lane); }
        }
        SEAM(PH_MOE);
        STAMP_B(PH_MOE + 1); if (IN(PH_MOE + 1)) { PHASE_IDS int base[9]; base[0] = 0;
#pragma unroll
            for (int e = 0; e < 8; ++e) base[e + 1] = base[e] + __builtin_amdgcn_readfirstlane((cnt[e] + 255) & ~255);
            if (bx == 0) { if (tid < MOETILES) { int te = 0;
#pragma unroll
                    for (int k = 0; k < 8; ++k) if (tid * 256 >= base[k]) te = k;
                    tile_e[tid] = te; }
                if (tid == 0) ctl[CW_NT] = (unsigned)(base[8] >> 8); }
            for (int i0 = gw * 4; i0 < 2 * TL; i0 += NGW * 4) {
                int row[4]; const int4 ev = *(const int4*)(tok_e + i0), pv = *(const int4*)(tok_pos + i0); const int ee[4] = {ev.x, ev.y, ev.z, ev.w}, pp[4] = {pv.x, pv.y, pv.z, pv.w};
#pragma unroll
                for (int q = 0; q < 4; ++q) { int bs = 0;
#pragma unroll
                    for (int k = 0; k < 8; ++k) if (k == ee[q]) bs = base[k];
                    row[q] = bs + pp[q]; }
                u32x4 d0[4];
#pragma unroll
                for (int q = 0; q < 4; ++q) d0[q] = ((const u32x4*)(ws + WS_XR + (size_t)((i0 + q) >> 1) * D))[lane];
                if (lane == 0) { int4 rv; rv.x = row[0]; rv.y = row[1]; rv.z = row[2]; rv.w = row[3]; *(int4*)(tok_row + i0) = rv; }
#pragma unroll
                for (int q = 0; q < 4; ++q) *(u32x4*)(XS8 + (size_t)row[q] * D + lane * 16) = d0[q]; } }
        SEAM(PH_MOE + 1);
        LAS int* tile_l = (LAS int*)(lds + STAGE_BYTES + 1024);
        if (hi > PH_MOE + 2 && lo < PH_MOE + 7) { PHASE_IDS if (tid < MOETILES) tile_l[tid] = tile_e[tid]; __syncthreads(); }
        {
            const int ntl = (int)ctl[CW_NT]; int rem = ntl - 256; rem = rem < 0 ? 0 : (rem > 8 ? 8 : rem);
            unsigned char* H8A = ws + WS_H8A; unsigned char* H8B = ws + WS_H8B;
#define PASS_T0(p) ((p) == 0 ? 0 : 64 + rem + ((p) - 1) * 64)
#define PASS_N(p) ((p) == 0 ? 64 + rem : ((p) < 3 ? 64 : (ntl - PASS_T0(3) < 0 ? 0 : ntl - PASS_T0(3))))
#define PASS_H(p) (((p) & 1) ? H8B : H8A)
            STAMP_B(PH_MOE + 2); if (PHON(20) && IN(PH_MOE + 2)) {
                JobSched<1> S; S.j[0] = mkjob(XS8, wmoe, 0, 0, 1024, 1024, 8, PASS_N(0), 28, 1, 1, 1, 0, 0); S.j[0].tlut = tile_l; S.j[0].eB = W8_ESTRIDE;
                S.init(G, bx); S.dry = (mask & 0x8000) ? 1 : 0; EpiSwiglu8 E{H8A, 0}; gemm_phase_<EpiSwiglu8, JobSched<1>, false, true>(lds, S, E, g_wave_s); }
            SEAM(PH_MOE + 2);
            for (int p = 0; p < 3; ++p) {
                STAMP_B(PH_MOE + 3 + p); if (PHON(21) && IN(PH_MOE + 3 + p)) { const int t0 = PASS_T0(p), t1 = PASS_T0(p + 1); BalSched S;
                    S.j[0] = mkjob((const char*)PASS_H(p) - (size_t)t0 * 256 * DFE, wmoe + W8_DN, 0, 0, DFE, DFE, 28, PASS_N(p), 4, 1, 1, 0, t0, 0); S.j[0].tlut = tile_l; S.j[0].eB = W8_ESTRIDE;
                    S.j[1] = mkjob(XS8, wmoe, 0, 0, 1024, 1024, 8, PASS_N(p + 1), 28, 1, 1, 1, t1, 0); S.j[1].tlut = tile_l; S.j[1].eB = W8_ESTRIDE;
                    S.init(G, bx);
                    { BalLong SL; SL.j = S.j[0]; SL.G = S.G; SL.cp = S.cp; SL.mylong = S.base0 + (S.cp < S.E ? 1 : 0); SL.dry = (mask & 0x8000) ? 1 : 0; EpiBf8 E0{OB}; gemm_phase_<EpiBf8, BalLong, false, true>(lds, SL, E0, g_wave_s); }
                    { BalShort SS; SS.j = S.j[1]; SS.cp = S.cp; SS.E = S.E; SS.gH = S.gH; SS.gL = S.gL; SS.extra = S.extra; SS.nl = S.nl; SS.dry = (mask & 0x8000) ? 1 : 0; EpiSwiglu8 E1{PASS_H(p + 1), t1 * 256}; gemm_phase_<EpiSwiglu8, BalShort, false, true>(lds, SS, E1, g_wave_s); } }
                SEAM(PH_MOE + 3 + p);
            }
            STAMP_B(PH_MOE + 6); if (PHON(21) && IN(PH_MOE + 6)) { const int t0 = PASS_T0(3);
                JobSched<1> S; S.j[0] = mkjob((const char*)PASS_H(3) - (size_t)t0 * 256 * DFE, wmoe + W8_DN, 0, 0, DFE, DFE, 28, PASS_N(3), 4, 1, 1, 0, t0, 0); S.j[0].tlut = tile_l; S.j[0].eB = W8_ESTRIDE;
                S.init(G, bx); S.dry = (mask & 0x8000) ? 1 : 0; EpiBf8 E{OB}; gemm_phase_<EpiBf8, JobSched<1>, false, true>(lds, S, E, g_wave_s); }
            SEAM(PH_MOE + 6);
#undef PASS_T0
#undef PASS_N
#undef PASS_H
        }
        if (IN(PH_MOE + 7)) { PHASE_IDS const float* fg = args.in[I_FINALG];
#ifdef PROBE_A
            const float probe_ghz = (float)(ctl[CW_NT + 67] - ctl[CW_NT + 66]) / ((float)(ctl[CW_NT + 65] - ctl[CW_NT + 64]) * 10.0f);
            const float probe_scale = probe_ghz < 1.85f ? 1.5f : 1.0f;
#else
            const float probe_scale = 1.0f;
#endif
            for (int t0 = gw * 2; t0 < TL; t0 += NGW * 2) {
                const int4 rr = *(const int4*)(tok_row + t0 * 2); const f32x4 ww = *(const f32x4*)(tok_w + t0 * 2); const int rws[4] = {rr.x, rr.y, rr.z, rr.w};
                f32x4 v[2][4]; float ss[2] = {0.f, 0.f};
#pragma unroll
                for (int q = 0; q < 2; ++q) { const int t = t0 + q; const float* g2 = modl + (size_t)(t >> 11) * 6144 + 5 * 1024; const float w1 = ww[2 * q], w2 = ww[2 * q + 1];
#pragma unroll
                    for (int j = 0; j < 4; ++j) { const int k = j * 256 + lane * 4; const f32x4 hv = ld4(HS + (size_t)t * D + k), gg = *(const f32x4*)(g2 + k);
                        const u32x2 a = *(const u32x2*)(OB + (size_t)rws[2 * q] * D + k), b = *(const u32x2*)(OB + (size_t)rws[2 * q + 1] * D + k);
                        const f32x4 av = {bflo(a.x), bfhi(a.x), bflo(a.y), bfhi(a.y)}, bv = {bflo(b.x), bfhi(b.x), bflo(b.y), bfhi(b.y)};
                        v[q][j] = hv + gg * (av * w1 + bv * w2); ss[q] += v[q][j][0] * v[q][j][0] + v[q][j][1] * v[q][j][1] + v[q][j][2] * v[q][j][2] + v[q][j][3] * v[q][j][3]; } }
                f32x4 fgv[4];
#pragma unroll
                for (int j = 0; j < 4; ++j) fgv[j] = *(const f32x4*)(fg + j * 256 + lane * 4);
#pragma unroll
                for (int q = 0; q < 2; ++q) { const float rstd = rsqrtf(wsum(ss[q], lane) * (1.f / D) + EPS);
#pragma unroll
                    for (int j = 0; j < 4; ++j) *(f32x4*)(h + (size_t)(t0 + q) * D + j * 256 + lane * 4) = v[q][j] * (rstd * probe_scale) * fgv[j]; } } }
    }
#undef IN
#undef SEAM
#undef h
#undef zs
#undef HS
#undef ZS
#undef mod
#undef XA
#undef YS
#undef UX
#undef GT
#undef VL
#undef VC
#undef Sst
#undef TM
#undef HID
#undef cnt
#undef tok_e
#undef tok_w
#undef tok_pos
#undef tok_row
#undef tile_e
}
}

extern "C" void kernel_launch(void* const* d_in, const int* in_sizes, int n_in, void* d_out, int out_size, void* d_ws, size_t ws_size, hipStream_t stream) {
    const float* x = (const float*)d_in[0]; const float* c = (const float*)d_in[1]; const float* ctx = (const float*)d_in[2]; const float* cctx = (const float*)d_in[3];
    const float* wmod = (const float*)d_in[4]; const float* bmod = (const float*)d_in[5]; const float* n1g = (const float*)d_in[6]; const float* n2g = (const float*)d_in[7];
    const float* win = (const float*)d_in[8]; const float* wfour = (const float*)d_in[9];
    const float* are = (const float*)d_in[10]; const float* aim = (const float*)d_in[11]; const float* logdt = (const float*)d_in[12];
    const float* bre = (const float*)d_in[13]; const float* bim = (const float*)d_in[14]; const float* cre = (const float*)d_in[15]; const float* cim = (const float*)d_in[16];
    const float* ssmd = (const float*)d_in[17]; const float* glua = (const float*)d_in[18]; const float* glub = (const float*)d_in[19]; const float* wout = (const float*)d_in[20];
    const float* fgw = (const float*)d_in[21]; const float* fuw = (const float*)d_in[22]; const float* fdw = (const float*)d_in[23];
    const float* mrw = (const float*)d_in[24]; const float* mrb = (const float*)d_in[25]; const float* mgw = (const float*)d_in[26]; const float* muw = (const float*)d_in[27]; const float* mdw = (const float*)d_in[28];
    const float* finalg = (const float*)d_in[29];
    float* h = (float*)d_out; char* ws = (char*)d_ws;
    float* mod = (float*)(ws + WS_MOD); float* cosT = (float*)(ws + WS_COST); float* sinT = cosT + 2048;
    int* cnt = (int*)(ws + WS_CTL) + CW_CNT; int* tok_e = (int*)(ws + WS_TOKE); float* tok_w = (float*)(ws + WS_TOKW); int* tok_pos = (int*)(ws + WS_TOKPOS); int* tok_row = (int*)(ws + WS_TOKROW);
    int* tile_e = (int*)(ws + WS_TILEE); int* rowtok = (int*)(ws + WS_ROWTOK);
    float* z = (float*)(ws + WS_Z); bf16_t* XA = (bf16_t*)(ws + WS_XA); bf16_t* YS = (bf16_t*)(ws + WS_YS); bf16_t* UX = (bf16_t*)(ws + WS_UX); bf16_t* GT = (bf16_t*)(ws + WS_GT);
    bf16_t* VL = (bf16_t*)(ws + WS_VT2L); bf16_t* VC = (bf16_t*)(ws + WS_VT2C); bf16_t* TM = (bf16_t*)(ws + WS_TM); bf16_t* PF = (bf16_t*)(ws + WS_PF); bf16_t* T1 = (bf16_t*)(ws + WS_T1); bf16_t* T2 = (bf16_t*)(ws + WS_T2);
    float* Yacc = (float*)(ws + WS_YACC); bf16_t* HID = (bf16_t*)(ws + WS_HID); float* O = (float*)(ws + WS_NO); bf16_t* HQ = (bf16_t*)(ws + WS_NHQ);
    const int mask = FASTMASK;

    static int grid = 0;
    if (grid == 0) {
        int dev = 0, cus = 0; (void)hipGetDevice(&dev); (void)hipDeviceGetAttribute(&cus, hipDeviceAttributeMultiprocessorCount, dev);
        (void)hipFuncSetAttribute((const void*)mk::fwd, hipFuncAttributeMaxDynamicSharedMemorySize, mk::LDS_BYTES);
        int per_cu = 0; (void)hipOccupancyMaxActiveBlocksPerMultiprocessor(&per_cu, (const void*)mk::fwd, 512, mk::LDS_BYTES); (void)hipGetLastError();
        grid = cus > 0 ? cus : 256;
    }
    (void)hipMemsetAsync(ws + WS_CTL, 0, CTL_BYTES, stream);
    mk::Args a{};
    for (int i = 0; i < 30; ++i) a.in[i] = (const float*)d_in[i];
    a.out = h; a.ws = (unsigned char*)d_ws; a.mask = mask; a.pad = 0;
#ifndef REPMASK
#define REPMASK 0
#endif
    auto fast = [&](int lo, int hi) { a.ph_lo = lo; a.ph_hi = hi; hipLaunchKernelGGL(mk::fwd, dim3(grid), dim3(512), mk::LDS_BYTES, stream, a);
        if (hi == lo + 1 && ((REPMASK >> lo) & 1)) hipLaunchKernelGGL(mk::fwd, dim3(grid), dim3(512), mk::LDS_BYTES, stream, a); };
#ifdef DRYMASK
    auto fast_dry = [&](int lo) { if ((DRYMASK >> lo) & 1) { a.ph_lo = lo; a.ph_hi = lo + 1; a.mask = mask | 0x8000; hipLaunchKernelGGL(mk::fwd, dim3(grid), dim3(512), mk::LDS_BYTES, stream, a); a.mask = mask; } };
#else
    auto fast_dry = [&](int) {};
#endif
#if ONE_LAUNCH
    fast(0, mk::NPH);
#else
    hipLaunchKernelGGL(k_tables, dim3(8), dim3(256), 0, stream, cosT, sinT);
    if (mask & F_PRO) fast(0, 1);
    else { hipLaunchKernelGGL(k_mod, dim3(24, 17, 2), dim3(256), 0, stream, c, cctx, wmod, bmod, mod); hipLaunchKernelGGL(k_init, dim3(TL * D / 256), dim3(256), 0, stream, x, ctx, h, z); }
    for (int l = 0; l < 2; ++l) {
        const int pb = l == 0 ? 1 : mk::PH_L1; const float* modl = mod + (size_t)l * 17 * 6144; const bool need_ctx = (l == 0);
        if (mask & F_NORM) fast(pb, pb + 1);
        else hipLaunchKernelGGL(k_norm<false>, dim3(TT / 4), dim3(256), 0, stream, h, z, n1g + l * D, modl, 0, 1, XA, 0, TT, nullptr, nullptr, nullptr, nullptr);
        if (!(mask & F_INPROJ) || (mask & 0x3000)) {
            { LAbf la{XA, D, 0}; LBw lb{win + (size_t)l * D * INC, INC, 0}; EPinproj ep{PF, UX, GT}; hipLaunchKernelGGL((ngemm<LAbf, LBw, EPinproj>), dim3(INC / 64, TT / 64, 1), dim3(256), 0, stream, D, 0, la, lb, ep); }
            { LAbfZ la{PF, 512, 128}; LBdft128 lb{cosT, sinT}; EPzdft ep{VL, VC}; hipLaunchKernelGGL((ngemm<LAbfZ, LBdft128, EPzdft>), dim3(256 / 64, TT / 64, 4), dim3(256), 0, stream, 128, 0, la, lb, ep); }
        }
        if (mask & F_INPROJ) { fast_dry(pb + 1); fast(pb + 1, pb + 2); }
        if (mask & (F_FOUR | F_S5)) fast(pb + 2, pb + 3);
        if (!(mask & F_FOUR)) {
            { LAdftL<L> la{cosT, sinT}; LBvt2<L> lb{VL}; EPfour<L> ep{YS, TC, 1.0f / sqrtf((float)L * 128.f)}; hipLaunchKernelGGL((ngemm<LAdftL<L>, LBvt2<L>, EPfour<L>>), dim3(512 / 64, L / 64, NB), dim3(256), 0, stream, 2 * L, 0, la, lb, ep); }
            if (need_ctx) { LAdftL<LC> la{cosT, sinT}; LBvt2<LC> lb{VC}; EPfour<LC> ep{YS, 0, 1.0f / sqrtf((float)LC * 128.f)}; hipLaunchKernelGGL((ngemm<LAdftL<LC>, LBvt2<LC>, EPfour<LC>>), dim3(512 / 64, LC / 64, NB), dim3(256), 0, stream, 2 * LC, 0, la, lb, ep); }
        }
        if (mask & (F_S5 | F_GLU)) fast(pb + 3, pb + 4);
        if (!(mask & F_S5)) hipLaunchKernelGGL(k_s5_naive, dim3(NB * 32), dim3(64), 0, stream, UX, are + l * 4096, aim + l * 4096, logdt + l * 64, bre + (size_t)l * 65536, bim + (size_t)l * 65536, cre + (size_t)l * 65536, cim + (size_t)l * 65536, ssmd + l * 512, Yacc, YS);
        if (mask & (F_S5 | F_GLU)) fast(pb + 4, pb + 5);
        const int r0 = need_ctx ? 0 : TC, nr = TT - r0;
        if (mask & F_GLU) fast(pb + 5, pb + 6);
        else {
            { LAbf la{YS + (size_t)r0 * 1024, 1024, 0}; LBw lb{wfour + (size_t)l * 512 * D, D, 0}; EPbf ep{T1 + (size_t)r0 * D, D, 0}; hipLaunchKernelGGL((ngemm<LAbf, LBw, EPbf>), dim3(D / 64, nr / 64, 1), dim3(256), 0, stream, 512, 0, la, lb, ep); }
            { LAbf la{YS + (size_t)r0 * 1024 + 512, 1024, 0}; LBw lb{glua + (size_t)l * 512 * D, D, 0}; EPbf ep{T2 + (size_t)r0 * D, D, 0}; hipLaunchKernelGGL((ngemm<LAbf, LBw, EPbf>), dim3(D / 64, nr / 64, 1), dim3(256), 0, stream, 512, 0, la, lb, ep); }
            { LAbf la{YS + (size_t)r0 * 1024 + 512, 1024, 0}; LBw lb{glub + (size_t)l * 512 * D, D, 0}; EPmerge ep{GT + (size_t)r0 * 2048, T1 + (size_t)r0 * D, T2 + (size_t)r0 * D, TM + (size_t)r0 * D}; hipLaunchKernelGGL((ngemm<LAbf, LBw, EPmerge>), dim3(D / 64, nr / 64, 1), dim3(256), 0, stream, 512, 0, la, lb, ep); }
        }
        if (mask & F_OUT) fast(pb + 6, pb + 7);
        else { LAbf la{TM + (size_t)r0 * D, D, 0}; LBw lb{wout + (size_t)l * D * D, D, 0}; EPres ep{h, z, modl, 2, r0}; hipLaunchKernelGGL((ngemm<LAbf, LBw, EPres>), dim3(D / 64, nr / 64, 1), dim3(256), 0, stream, D, 0, la, lb, ep); }
        if (l == 0) {
            if (mask & F_NORM) fast(pb + 7, pb + 8);
            else hipLaunchKernelGGL(k_norm<false>, dim3(TT / 4), dim3(256), 0, stream, h, z, n2g + l * D, modl, 3, 4, XA, 0, TT, nullptr, nullptr, nullptr, nullptr);
            if (mask & F_FFN) { fast_dry(pb + 8); fast(pb + 8, pb + 9); fast(pb + 9, pb + 10); fast(pb + 10, pb + 11); }
            else {
                { LAbf la{XA, D, 0}; LBw lb{fgw, DFF, 0}; EPbf ep{HID, DFF, 0}; hipLaunchKernelGGL((ngemm<LAbf, LBw, EPbf>), dim3(DFF / 64, TT / 64, 1), dim3(256), 0, stream, D, 0, la, lb, ep); }
                { LAbf la{XA, D, 0}; LBw lb{fuw, DFF, 0}; EPswi ep{HID, DFF, 0}; hipLaunchKernelGGL((ngemm<LAbf, LBw, EPswi>), dim3(DFF / 64, TT / 64, 1), dim3(256), 0, stream, D, 0, la, lb, ep); }
                { LAbf la{HID, DFF, 0}; LBw lb{fdw, D, 0}; EPres ep{h, z, modl, 5, 0}; hipLaunchKernelGGL((ngemm<LAbf, LBw, EPres>), dim3(D / 64, TT / 64, 1), dim3(256), 0, stream, DFF, 0, la, lb, ep); }
            }
        } else if (mask & F_MOE) {
            for (int ph = mk::PH_MOE; ph < mk::NPH; ++ph) { fast_dry(ph); fast(ph, ph + 1); }
        } else {
            hipLaunchKernelGGL(k_moe_zero, dim3((MOEROWS + 255) / 256), dim3(256), 0, stream, cnt, rowtok);
            hipLaunchKernelGGL(k_norm<true>, dim3(TL / 4), dim3(256), 0, stream, h, z, n2g + l * D, modl, 3, 4, XA, TC, TL, mrw, mrb, tok_e, tok_w);
            hipLaunchKernelGGL(k_moe_count, dim3(TL * 2 / 256), dim3(256), 0, stream, tok_e, cnt, tok_pos);
            hipLaunchKernelGGL(k_moe_place, dim3(TL * 2 / 256), dim3(256), 0, stream, tok_e, cnt, tok_pos, tok_row, rowtok, tile_e);
            for (int q = 0; q < 4; ++q) {
                { LAgather la{XA + (size_t)TC * D, rowtok, tile_e}; LBmoe lb{mgw, tile_e, (size_t)D * DFE, DFE, q * 896, 0, 0}; EPbf ep{HQ, 896, 0}; hipLaunchKernelGGL((ngemm<LAgather, LBmoe, EPbf>), dim3(896 / 64, MOEROWS / 64, 1), dim3(256), 0, stream, D, 0, la, lb, ep); }
                { LAgather la{XA + (size_t)TC * D, rowtok, tile_e}; LBmoe lb{muw, tile_e, (size_t)D * DFE, DFE, q * 896, 0, 0}; EPswi ep{HQ, 896, 0}; hipLaunchKernelGGL((ngemm<LAgather, LBmoe, EPswi>), dim3(896 / 64, MOEROWS / 64, 1), dim3(256), 0, stream, D, 0, la, lb, ep); }
                { LAmoeh la{HQ, tile_e}; LBmoe lb{mdw, tile_e, (size_t)DFE * D, D, 0, q * 896, 0}; EPacc ep{O, q == 0, 0}; hipLaunchKernelGGL((ngemm<LAmoeh, LBmoe, EPacc>), dim3(D / 64, MOEROWS / 64, 1), dim3(256), 0, stream, 896, 0, la, lb, ep); }
            }
            hipLaunchKernelGGL(k_final, dim3(TL / 4), dim3(256), 0, stream, h, modl, O, tok_row, tok_w, finalg, (float*)d_out);
        }
    }
#endif
}
```

```cpp
#define FASTMASK 0x1FF
#define ONE_LAUNCH 1
#define RES16 1
#define DYNPRO 1
#define PRO_ORDER2 1
#define EARLY_INV 1
#define WSUM_DPP 1
#define GLOBAL_REMAP 1
#define MOEQ 1
#include <hip/hip_runtime.h>
#include <stdint.h>
#include <math.h>

#ifndef FASTMASK
#define FASTMASK 0x0
#endif
#ifndef ONE_LAUNCH
#define ONE_LAUNCH 0
#endif

namespace {
typedef unsigned short bf16_t;
constexpr int D = 1024, NB = 16, L = 2048, LC = 256, TL = NB * L, TC = NB * LC, TT = TL + TC;
constexpr int INC = 3072, DFF = 2816, NE = 8, DFE = 3584, MOEROWS = 2 * TL + NE * 256, MOETILES = MOEROWS / 256;
constexpr int CHR = TT / 16;
constexpr float EPS = 1e-6f;
constexpr int F_PRO = 1, F_INPROJ = 2, F_FOUR = 4, F_S5 = 8, F_GLU = 16, F_OUT = 32, F_FFN = 64, F_MOE = 128, F_NORM = 256;

constexpr size_t MiB = (size_t)1 << 20, KiB = 1024;
constexpr size_t WS_CTL = 0, CTL_BYTES = 64 * KiB;
constexpr size_t WS_MOD = 128 * KiB;
constexpr size_t WS_LAMQ = 1 * MiB;
constexpr size_t WS_COST = 1 * MiB + 64 * KiB;
constexpr size_t WS_TOKE = 1 * MiB + 256 * KiB, WS_TOKW = WS_TOKE + 256 * KiB, WS_TOKPOS = WS_TOKW + 256 * KiB, WS_TOKROW = WS_TOKPOS + 256 * KiB;
constexpr size_t WS_TILEE = WS_TOKROW + 256 * KiB, WS_ROWTOK = WS_TILEE + 4 * KiB;
constexpr size_t WS_Z = 4 * MiB;
constexpr size_t WS_DFTL = 20 * MiB, WS_DFTC = 36 * MiB;
constexpr size_t WS_S5E = 37 * MiB, WS_S5TG = 41 * MiB, S5_LSTRIDE = 12 * MiB;
constexpr size_t WS_MIXW = 61 * MiB, MIXW_LSTRIDE = 12 * MiB;
constexpr size_t WS_WGU = 85 * MiB, WS_WDN = 96 * MiB;
constexpr size_t WS_UX = 102 * MiB, WS_GT = 174 * MiB, WS_S = 318 * MiB, WS_VT2L = 390 * MiB, WS_VT2C = 454 * MiB, WS_TM = 390 * MiB, WS_XA = 535 * MiB, WS_YS = 535 * MiB;
constexpr size_t WS_PF = 462 * MiB, WS_T1 = 462 * MiB, WS_YACC = 318 * MiB, WS_T2 = 318 * MiB;
constexpr size_t WS_HID = 102 * MiB;
constexpr size_t WS_XA8 = 472 * MiB;
constexpr size_t WS_POS = 462 * MiB;
constexpr size_t WS_WMOE = 4 * MiB, WS_XS = 172 * MiB, WS_HIDM = 304 * MiB;
constexpr size_t WS_W8 = 4 * MiB, W8_ESTRIDE = 10 * MiB + 512 * KiB, W8_DN = 7 * MiB;
#ifdef RES16
constexpr size_t WS_H16 = 246 * MiB;
constexpr size_t WS_XS8 = 88 * MiB, WS_XR = 154 * MiB, WS_O = 318 * MiB, WS_H8A = 450 * MiB, WS_H8B = 513 * MiB;
#else
constexpr size_t WS_XR = 535 * MiB;
constexpr size_t WS_XS8 = 88 * MiB, WS_O = 154 * MiB, WS_H8A = 286 * MiB, WS_H8B = 349 * MiB;
#endif
constexpr int MOE_TP = 132;
constexpr size_t WS_NO = 102 * MiB, WS_NHQ = 366 * MiB;
constexpr size_t WS_END = 607 * MiB;
constexpr int CW_BAR = 0, CW_CNT = 4096, CW_NT = 4096 + 64;
constexpr int CW_RDY = 4096 + 256;
constexpr int CW_PQ = 4096 + 512;

__device__ __forceinline__ float bf2f(bf16_t b) { return __uint_as_float(((unsigned)b) << 16); }
__device__ __forceinline__ bf16_t f2bf(float f) { unsigned u = __float_as_uint(f); u += 0x7FFFu + ((u >> 16) & 1u); return (bf16_t)(u >> 16); }
__device__ __forceinline__ float sigmoidf_(float v) { return 1.f / (1.f + expf(-v)); }
__device__ __forceinline__ float siluf_(float v) { return v / (1.f + expf(-v)); }
__device__ __forceinline__ float geluf_(float v) { return 0.5f * v * (1.f + tanhf(0.7978845608028654f * (v + 0.044715f * v * v * v))); }
__device__ __forceinline__ float wave_sum(float v) {
#pragma unroll
    for (int o = 32; o >= 1; o >>= 1) v += __shfl_xor(v, o);
    return v;
}
__device__ __forceinline__ size_t ux_index(int g, int row, int h) { return ((size_t)g * CHR + (row >> 4)) * 512 + (row & 15) * 16 + h; }
__device__ __forceinline__ size_t vt2_index(int row, int gk, int type) {
    if (row < TC) { const int b = row >> 8, n = row & 255; return ((size_t)(b * 512 + gk)) * 512 + type * 256 + n; }
    const int t = row - TC, b = t >> 11, n = t & 2047; return ((size_t)(b * 512 + gk)) * 4096 + type * 2048 + n;
}

#if !ONE_LAUNCH
template <class LA, class LB, class EP>
__global__ __launch_bounds__(256) void ngemm(int K, int kpad, LA la, LB lb, EP ep) {
    __shared__ float As[16][68], Bs[16][68];
    const int tx = threadIdx.x & 15, ty = threadIdx.x >> 4;
    const int m0 = blockIdx.y * 64, n0 = blockIdx.x * 64, z = blockIdx.z;
    if (!la.active(z, m0)) return;
    float acc[4][4];
#pragma unroll
    for (int i = 0; i < 4; ++i)
#pragma unroll
        for (int j = 0; j < 4; ++j) acc[i][j] = 0.f;
    for (int k0 = 0; k0 < K; k0 += 16) {
#pragma unroll
        for (int i = 0; i < 4; ++i) { const int e = threadIdx.x + i * 256; const int mm = e >> 4, kk = e & 15; As[kk][mm] = la(z, m0 + mm, k0 + kk); }
#pragma unroll
        for (int i = 0; i < 4; ++i) { const int e = threadIdx.x + i * 256; const int kk = e >> 6, nn = e & 63; Bs[kk][nn] = lb(z, m0, k0 + kk, n0 + nn); }
        __syncthreads();
#pragma unroll
        for (int kk = 0; kk < 16; ++kk) {
            float a[4], b[4];
#pragma unroll
            for (int i = 0; i < 4; ++i) { a[i] = As[kk][ty * 4 + i]; b[i] = Bs[kk][tx * 4 + i]; }
#pragma unroll
            for (int i = 0; i < 4; ++i)
#pragma unroll
                for (int j = 0; j < 4; ++j) acc[i][j] += a[i] * b[j];
        }
        __syncthreads();
    }
#pragma unroll
    for (int i = 0; i < 4; ++i)
#pragma unroll
        for (int j = 0; j < 4; ++j) ep(z, m0 + ty * 4 + i, n0 + tx * 4 + j, acc[i][j]);
}
struct LAbf { const bf16_t* p; int ld; int pad; __device__ bool active(int, int) const { return true; } __device__ float operator()(int, int m, int k) const { return bf2f(p[(size_t)m * ld + k]); } };
struct LAbfZ { const bf16_t* p; int ld; int zoff; __device__ bool active(int, int) const { return true; } __device__ float operator()(int z, int m, int k) const { return bf2f(p[(size_t)m * ld + z * zoff + k]); } };
struct LBw { const float* p; int ld; int pad; __device__ float operator()(int, int, int k, int n) const { return p[(size_t)k * ld + n]; } };
struct LBdft128 { const float* cosT; const float* sinT; __device__ float operator()(int, int, int k, int n) const { const int nn = n & 127; const int idx = ((k * nn) & 127) * 16; return n < 128 ? cosT[idx] : sinT[idx]; } };
template <int LL> struct LAdftL { const float* cosT; const float* sinT; __device__ bool active(int, int) const { return true; }
    __device__ float operator()(int, int m, int k) const { const int kk = k & (LL - 1); const int idx = ((m * kk) & (LL - 1)) * (2048 / LL); return k < LL ? cosT[idx] : -sinT[idx]; } };
template <int LL> struct LBvt2 { const bf16_t* V; __device__ float operator()(int z, int, int k, int n) const { return bf2f(V[((size_t)(z * 512 + n)) * (2 * LL) + k]); } };
struct LAgather { const bf16_t* A; const int* rowtok; const int* tile_e; __device__ bool active(int, int m0) const { return tile_e[m0 >> 8] >= 0; }
    __device__ float operator()(int, int m, int k) const { const int t = rowtok[m]; return t < 0 ? 0.f : bf2f(A[(size_t)t * D + k]); } };
struct LAmoeh { const bf16_t* H; const int* tile_e; __device__ bool active(int, int m0) const { return tile_e[m0 >> 8] >= 0; }
    __device__ float operator()(int, int m, int k) const { return bf2f(H[(size_t)m * 896 + k]); } };
struct LBmoe { const float* w; const int* tile_e; size_t estride; int ld; int coff; int roff; int pad; __device__ float operator()(int, int m0, int k, int n) const { const int e = tile_e[m0 >> 8]; return w[(size_t)e * estride + (size_t)(k + roff) * ld + coff + n]; } };

struct EPbf { bf16_t* o; int ld; int pad; __device__ void operator()(int, int m, int n, float v) const { o[(size_t)m * ld + n] = f2bf(v); } };
struct EPinproj { bf16_t* PF; bf16_t* UX; bf16_t* GT; __device__ void operator()(int, int m, int n, float v) const {
    if (n < 512) PF[(size_t)m * 512 + n] = f2bf(v); else if (n < 1024) { const int c = n - 512; UX[ux_index(c >> 4, m, c & 15)] = f2bf(v); } else GT[(size_t)m * 2048 + (n - 1024)] = f2bf(sigmoidf_(v)); } };
struct EPzdft { bf16_t* VL; bf16_t* VC; __device__ void operator()(int z, int m, int n, float v) const { (m < TC ? VC : VL)[vt2_index(m, z * 128 + (n & 127), n >> 7)] = f2bf(v); } };
template <int LL> struct EPfour { bf16_t* YS; int rowbase; float scale; __device__ void operator()(int z, int m, int n, float v) const { YS[((size_t)rowbase + z * LL + m) * 1024 + n] = f2bf(v * scale); } };
struct EPmerge { const bf16_t* GT; const bf16_t* T1; const bf16_t* T2; bf16_t* M; __device__ void operator()(int, int m, int n, float v) const {
    const float ga = bf2f(GT[(size_t)m * 2048 + n]), gb = bf2f(GT[(size_t)m * 2048 + 1024 + n]);
    const size_t o = (size_t)m * D + n; M[o] = f2bf(ga * bf2f(T1[o]) + gb * bf2f(T2[o]) * sigmoidf_(v)); } };
struct EPres { float* h; float* z; const float* mod; int gidx; int rowoff; __device__ void operator()(int, int m, int n, float v) const {
    const int r = m + rowoff; float* dst = r < TC ? z + (size_t)r * D + n : h + (size_t)(r - TC) * D + n; const int cond = r < TC ? 16 : (r - TC) / L;
    *dst += mod[(size_t)cond * 6144 + gidx * 1024 + n] * v; } };
struct EPswi { bf16_t* G; int ld; int pad; __device__ void operator()(int, int m, int n, float v) const { const size_t o = (size_t)m * ld + n; G[o] = f2bf(siluf_(bf2f(G[o])) * v); } };
struct EPacc { float* O; int first; int pad; __device__ void operator()(int, int m, int n, float v) const { const size_t o = (size_t)m * D + n; O[o] = first ? v : O[o] + v; } };

__global__ void k_tables(float* cosT, float* sinT) { const int i = blockIdx.x * blockDim.x + threadIdx.x; if (i < 2048) { cosT[i] = cospif(i / 1024.f); sinT[i] = sinpif(i / 1024.f); } }
__global__ void k_mod(const float* c, const float* cctx, const float* wmod, const float* bmod, float* mod) {
    const int col = blockIdx.x * 256 + threadIdx.x, r = blockIdx.y, l = blockIdx.z;
    const float* cond = r < 16 ? c + r * D : cctx; const float* w = wmod + (size_t)l * D * 6144;
    float acc = 0.f;
    for (int k = 0; k < D; ++k) acc += siluf_(cond[k]) * w[(size_t)k * 6144 + col];
    mod[((size_t)l * 17 + r) * 6144 + col] = acc + bmod[l * 6144 + col];
}
__global__ void k_init(const float* x, const float* ctx, float* h, float* z) {
    const size_t i = (size_t)blockIdx.x * blockDim.x + threadIdx.x;
    if (i < (size_t)TL * D) { const int d = (int)(i & 1023); const int t = (int)(i >> 10); const int n = t & (L - 1); const int r = n >> 6, col = n & 63; const int q = d >> 8, ii = d & 255;
        const float omega = 1.0f / powf(10000.f, (float)ii / 256.f); const float ang = (q < 2 ? (float)r : (float)col) * omega; h[i] = x[i] + ((q & 1) ? cosf(ang) : sinf(ang)); }
    if (i < (size_t)TC * D) z[i] = ctx[i];
}
template <bool ROUTE>
__global__ __launch_bounds__(256) void k_norm(const float* h, const float* z, const float* g, const float* mod, int shi, int sci, bf16_t* A, int row0, int nrows,
                                              const float* wr, const float* br, int* tok_e, float* tok_w) {
    const int lane = threadIdx.x & 63; const int r = row0 + blockIdx.x * 4 + (threadIdx.x >> 6); if (r >= row0 + nrows) return;
    const float* src = r < TC ? z + (size_t)r * D : h + (size_t)(r - TC) * D; const int cond = r < TC ? 16 : (r - TC) / L;
    const float* sh = mod + (size_t)cond * 6144 + shi * 1024; const float* sc = mod + (size_t)cond * 6144 + sci * 1024;
    float4 v[4]; float ss = 0.f;
#pragma unroll
    for (int j = 0; j < 4; ++j) { v[j] = *(const float4*)(src + j * 256 + lane * 4); ss += v[j].x * v[j].x + v[j].y * v[j].y + v[j].z * v[j].z + v[j].w * v[j].w; }
    ss = wave_sum(ss); const float rstd = rsqrtf(ss * (1.f / D) + EPS);
    float lg[8];
#pragma unroll
    for (int e = 0; e < 8; ++e) lg[e] = 0.f;
#pragma unroll
    for (int j = 0; j < 4; ++j) { const int k = j * 256 + lane * 4; const float4 gg = *(const float4*)(g + k), s1 = *(const float4*)(sc + k), s0 = *(const float4*)(sh + k);
        float a0 = v[j].x * rstd * gg.x * (1.f + s1.x) + s0.x, a1 = v[j].y * rstd * gg.y * (1.f + s1.y) + s0.y, a2 = v[j].z * rstd * gg.z * (1.f + s1.z) + s0.z, a3 = v[j].w * rstd * gg.w * (1.f + s1.w) + s0.w;
        ushort4 o; o.x = f2bf(a0); o.y = f2bf(a1); o.z = f2bf(a2); o.w = f2bf(a3); *(ushort4*)(A + (size_t)r * D + k) = o;
        if (ROUTE) {
#pragma unroll
            for (int e = 0; e < 8; ++e) lg[e] += a0 * wr[(k + 0) * 8 + e] + a1 * wr[(k + 1) * 8 + e] + a2 * wr[(k + 2) * 8 + e] + a3 * wr[(k + 3) * 8 + e]; } }
    if (ROUTE) {
#pragma unroll
        for (int e = 0; e < 8; ++e) lg[e] = wave_sum(lg[e]) + br[e];
        if (lane == 0) { int e1 = 0; float v1 = lg[0];
#pragma unroll
            for (int e = 1; e < 8; ++e) if (lg[e] > v1) { v1 = lg[e]; e1 = e; }
            int e2 = -1; float v2 = -3.0e38f;
#pragma unroll
            for (int e = 0; e < 8; ++e) if (e != e1 && lg[e] > v2) { v2 = lg[e]; e2 = e; }
            const float w1 = 1.f / (1.f + expf(v2 - v1)); const int t = r - TC;
            tok_e[t * 2] = e1; tok_e[t * 2 + 1] = e2; tok_w[t * 2] = w1; tok_w[t * 2 + 1] = 1.f - w1; }
    }
}
__global__ __launch_bounds__(64) void k_s5_naive(const bf16_t* UX, const float* are, const float* aim, const float* logdt, const float* bre, const float* bim, const float* cre, const float* cim,
                                                  const float* dsk, float* Yacc, bf16_t* YS) {
    const int b = blockIdx.x >> 5, g = blockIdx.x & 31, p = threadIdx.x, lane = p;
    const int hh = ((lane >> 5) & 1) * 8 + ((lane >> 4) & 1) * 4 + ((lane >> 3) & 1) * 2 + ((lane >> 2) & 1);
    for (int dir = 0; dir < 2; ++dir) {
        const int gp = (dir * 32 + g) * 64 + p;
        const float ar = are[gp], ai = aim[gp], dt = expf(logdt[dir * 32 + g]);
        const float er = expf(ar * dt), lbr = er * cosf(ai * dt), lbi = er * sinf(ai * dt);
        const float nr = lbr - 1.f, ni = lbi, den = ar * ar + ai * ai, qr = (nr * ar + ni * ai) / den, qi = (ni * ar - nr * ai) / den;
        float Br[16], Bi[16], Cr[16], Ci[16];
#pragma unroll
        for (int h = 0; h < 16; ++h) { const float x0 = bre[(size_t)gp * 16 + h], x1 = bim[(size_t)gp * 16 + h]; Br[h] = qr * x0 - qi * x1; Bi[h] = qr * x1 + qi * x0;
            Cr[h] = cre[((size_t)(dir * 32 + g) * 16 + h) * 64 + p]; Ci[h] = cim[((size_t)(dir * 32 + g) * 16 + h) * 64 + p]; }
        float xr = 0.f, xi = 0.f;
        for (int s = 0; s < LC + L; ++s) {
            int row; if (dir == 0) row = s < LC ? b * LC + s : TC + b * L + (s - LC); else row = s < LC ? b * LC + (LC - 1 - s) : TC + b * L + (L - 1 - (s - LC));
            const bf16_t* up = UX + ux_index(g, row, 0);
            float u[16];
#pragma unroll
            for (int h = 0; h < 16; ++h) u[h] = bf2f(up[h]);
            float bur = 0.f, bui = 0.f;
#pragma unroll
            for (int h = 0; h < 16; ++h) { bur += Br[h] * u[h]; bui += Bi[h] * u[h]; }
            const float nxr = lbr * xr - lbi * xi + bur, nxi = lbr * xi + lbi * xr + bui; xr = nxr; xi = nxi;
            float v[16];
#pragma unroll
            for (int h = 0; h < 16; ++h) v[h] = Cr[h] * xr - Ci[h] * xi;
#pragma unroll
            for (int st = 0; st < 4; ++st) { const int n = 8 >> st, off = 32 >> st; const bool hi = (lane & off) != 0;
#pragma unroll
                for (int j = 0; j < 8; ++j) if (j < n) { const float mine = hi ? v[j + n] : v[j]; const float other = hi ? v[j] : v[j + n]; v[j] = mine + __shfl_xor(other, off); } }
            float val = v[0]; val += __shfl_xor(val, 2); val += __shfl_xor(val, 1);
            if ((lane & 3) == 0) { const size_t o = (size_t)row * 512 + g * 16 + hh;
                if (dir == 0) Yacc[o] = val; else { const float y = Yacc[o] + val + dsk[g * 16 + hh] * bf2f(up[hh]); YS[(size_t)row * 1024 + 512 + g * 16 + hh] = f2bf(geluf_(y)); } }
        }
    }
}
__global__ void k_moe_zero(int* cnt, int* rowtok) { const int i = blockIdx.x * blockDim.x + threadIdx.x; if (i < 16) cnt[i] = 0; if (i < MOEROWS) rowtok[i] = -1; }
__global__ __launch_bounds__(256) void k_moe_count(const int* tok_e, int* cnt, int* tok_pos) {
    __shared__ int lc[8], lb[8];
    if (threadIdx.x < 8) lc[threadIdx.x] = 0; __syncthreads();
    const int i = blockIdx.x * 256 + threadIdx.x;
    const int e = tok_e[i]; const int lp = atomicAdd(&lc[e], 1); __syncthreads();
    if (threadIdx.x < 8) lb[threadIdx.x] = atomicAdd(&cnt[threadIdx.x], lc[threadIdx.x]); __syncthreads();
    tok_pos[i] = lb[e] + lp;
}
__global__ __launch_bounds__(256) void k_moe_place(const int* tok_e, const int* cnt, const int* tok_pos, int* tok_row, int* rowtok, int* tile_e) {
    int base[9]; base[0] = 0;
#pragma unroll
    for (int e = 0; e < 8; ++e) base[e + 1] = base[e] + ((cnt[e] + 255) & ~255);
    const int i = blockIdx.x * 256 + threadIdx.x; const int e = tok_e[i];
    int bs = 0;
#pragma unroll
    for (int k = 0; k < 8; ++k) if (k == e) bs = base[k];
    const int row = bs + tok_pos[i]; tok_row[i] = row; rowtok[row] = i >> 1;
    if (i < MOETILES) { int te = -1;
#pragma unroll
        for (int k = 0; k < 8; ++k) if (i * 256 >= base[k] && i * 256 < base[k + 1]) te = k;
        tile_e[i] = te; }
}
__global__ __launch_bounds__(256) void k_final(float* h, const float* mod, const float* O, const int* tok_row, const float* tok_w, const float* fg, float* out) {
    const int lane = threadIdx.x & 63; const int t = blockIdx.x * 4 + (threadIdx.x >> 6); const int cond = t / L;
    const float* g2 = mod + (size_t)cond * 6144 + 5 * 1024; const int r1 = tok_row[t * 2], r2 = tok_row[t * 2 + 1]; const float w1 = tok_w[t * 2], w2 = tok_w[t * 2 + 1];
    float4 v[4]; float ss = 0.f;
#pragma unroll
    for (int j = 0; j < 4; ++j) { const int k = j * 256 + lane * 4; const float4 hv = *(const float4*)(h + (size_t)t * D + k), a = *(const float4*)(O + (size_t)r1 * D + k), b = *(const float4*)(O + (size_t)r2 * D + k), gg = *(const float4*)(g2 + k);
        v[j].x = hv.x + gg.x * (w1 * a.x + w2 * b.x); v[j].y = hv.y + gg.y * (w1 * a.y + w2 * b.y); v[j].z = hv.z + gg.z * (w1 * a.z + w2 * b.z); v[j].w = hv.w + gg.w * (w1 * a.w + w2 * b.w);
        ss += v[j].x * v[j].x + v[j].y * v[j].y + v[j].z * v[j].z + v[j].w * v[j].w; }
    ss = wave_sum(ss); const float rstd = rsqrtf(ss * (1.f / D) + EPS);
#pragma unroll
    for (int j = 0; j < 4; ++j) { const int k = j * 256 + lane * 4; const float4 gg = *(const float4*)(fg + k); float4 o; o.x = v[j].x * rstd * gg.x; o.y = v[j].y * rstd * gg.y; o.z = v[j].z * rstd * gg.z; o.w = v[j].w * rstd * gg.w;
        *(float4*)(out + (size_t)t * D + k) = o; }
}
#endif
}


namespace mk {
#define LAS __attribute__((address_space(3)))
typedef short bf16x8 __attribute__((ext_vector_type(8)));
typedef float f32x4 __attribute__((ext_vector_type(4)));
typedef float f32x2 __attribute__((ext_vector_type(2)));
typedef unsigned u32x4 __attribute__((ext_vector_type(4)));
typedef unsigned u32x2 __attribute__((ext_vector_type(2)));
typedef int i32x4 __attribute__((ext_vector_type(4)));
typedef int i32x8 __attribute__((ext_vector_type(8)));
constexpr int BK = 64, HTB = 128 * BK * 2, STAGE_BYTES = 8 * HTB;
constexpr int MISC_OFF = STAGE_BYTES + 320, LDS_BYTES = 147456;
#ifndef FFN_ORDER
#define FFN_ORDER 8
#endif
#ifndef HID_LD
#define HID_LD DFF
#endif
constexpr int PH_L1 = 12, PH_MOE = 19, NPH = 27;

#define XB_TMO      128
#define XB_XCNT(j)  (256  + 64 * (j))
#define XB_XSUB(j)  (1280 + 64 * (j))
#define XB_XGEN(j)  (2304 + 64 * (j))
#define XB_TOP      3328
#define XB_TOPGEN   3392
#define XCD_BAR_WORDS 3456
#define XB_SPIN_CAP (1u << 18)
__device__ __forceinline__ unsigned lane_id_now() { unsigned l; asm volatile("v_mbcnt_lo_u32_b32 %0, -1, 0\n\tv_mbcnt_hi_u32_b32 %0, -1, %0" : "=v"(l)); return l; }
#define TIDX ((int)(g_wave_s * 64u + lane_id_now()))
__device__ __forceinline__ unsigned xb_ld(unsigned* p)              { return __hip_atomic_load(p, __ATOMIC_RELAXED, __HIP_MEMORY_SCOPE_AGENT); }
__device__ __forceinline__ unsigned xb_add(unsigned* p, unsigned v) { return __hip_atomic_fetch_add(p, v, __ATOMIC_RELAXED, __HIP_MEMORY_SCOPE_AGENT); }
__device__ __forceinline__ unsigned xb_xcc_id() { return (unsigned)__builtin_amdgcn_s_getreg((3 << 11) | 20) & 0xFu; }
#define XB_SPIN(cond, bar) do { unsigned _sp = 0; while (cond) { __builtin_amdgcn_s_sleep(1); \
    if ((++_sp & 255u) == 0u) { if (xb_ld(&(bar)[XB_TMO])) break; if (_sp > XB_SPIN_CAP) { atomicAdd(&(bar)[XB_TMO], 1u); break; } } } } while (0)
struct XcdBarrier { unsigned* bar; unsigned x; volatile LAS unsigned* st; };
__device__ __forceinline__ XcdBarrier xcd_barrier_post(unsigned* bar, volatile LAS unsigned* st, unsigned g_wave_s) {
    XcdBarrier b; b.bar = bar; b.x = xb_xcc_id(); b.st = st;
    if (TIDX == 0) (void)xb_add(&bar[XB_XCNT(b.x)], 1u);
    return b;
}
__device__ __forceinline__ void xcd_barrier_complete(unsigned* bar, unsigned x, unsigned& nloc, unsigned& nx) {
    const unsigned G = gridDim.x * gridDim.y * gridDim.z;
    unsigned sum, cnt, mine, sp = 0u;
    for (;;) {
        sum = 0u; cnt = 0u; mine = 0u;
#pragma unroll
        for (unsigned j = 0; j < 16; ++j) { const unsigned c = xb_ld(&bar[XB_XCNT(j)]); sum += c; cnt += (c > 0u) ? 1u : 0u; mine = (j == x) ? c : mine; }
        if (sum == G) break;
        __builtin_amdgcn_s_sleep(1);
        if ((++sp & 255u) == 0u) { if (xb_ld(&bar[XB_TMO])) break; if (sp > XB_SPIN_CAP) { atomicAdd(&bar[XB_TMO], 1u); break; } }
    }
    nloc = mine > 0u ? mine : 1u; nx = cnt > 0u ? cnt : 1u;
}
__device__ __forceinline__ void xcd_barrier(const XcdBarrier& b, unsigned g_wave_s) {
    asm volatile("s_waitcnt vmcnt(0)" ::: "memory");
    __syncthreads();
    if (TIDX == 0) {
        unsigned* bar = b.bar;
        __builtin_amdgcn_s_waitcnt(0);
        unsigned nloc = b.st[0], nx = b.st[1];
        if (nloc == 0u) { xcd_barrier_complete(bar, b.x, nloc, nx); b.st[0] = nloc; b.st[1] = nx; }
        const unsigned old = xb_add(&bar[XB_XSUB(b.x)], 1u);
        const unsigned gen = old / nloc;
#ifdef EARLY_INV
        if (old + 1u == (gen + 1u) * nloc) {
            __builtin_amdgcn_fence(__ATOMIC_RELEASE, "agent");
            asm volatile("s_waitcnt vmcnt(0)" ::: "memory");
            const unsigned og = xb_add(&bar[XB_TOP], 1u);
            const unsigned tg = og / nx;
            asm volatile("buffer_inv sc1" ::: "memory");
            if (og + 1u == (tg + 1u) * nx) xb_add(&bar[XB_TOPGEN], 1u);
            else XB_SPIN(xb_ld(&bar[XB_TOPGEN]) == tg, bar);
            xb_add(&bar[XB_XGEN(b.x)], 1u);
            asm volatile("s_waitcnt vmcnt(0)" ::: "memory");
        } else {
            asm volatile("buffer_inv sc1" ::: "memory");
            XB_SPIN(xb_ld(&bar[XB_XGEN(b.x)]) == gen, bar);
            asm volatile("s_waitcnt vmcnt(0)" ::: "memory");
        }
#else
        if (old + 1u == (gen + 1u) * nloc) {
            __builtin_amdgcn_fence(__ATOMIC_RELEASE, "agent");
            asm volatile("s_waitcnt vmcnt(0)" ::: "memory");
            const unsigned og = xb_add(&bar[XB_TOP], 1u);
            const unsigned tg = og / nx;
            if (og + 1u == (tg + 1u) * nx) xb_add(&bar[XB_TOPGEN], 1u);
            else XB_SPIN(xb_ld(&bar[XB_TOPGEN]) == tg, bar);
            __builtin_amdgcn_fence(__ATOMIC_ACQUIRE, "agent");
            xb_add(&bar[XB_XGEN(b.x)], 1u);
            asm volatile("s_waitcnt vmcnt(0)" ::: "memory");
        } else {
            XB_SPIN(xb_ld(&bar[XB_XGEN(b.x)]) == gen, bar);
            __builtin_amdgcn_fence(__ATOMIC_ACQUIRE, "agent");
            asm volatile("s_waitcnt vmcnt(0)" ::: "memory");
        }
#endif
    }
    __syncthreads();
}

__device__ __forceinline__ int lds_byte(int r, int c) { const int st = (r >> 4) * 2 + (c >> 5), rr = r & 15, cc = c & 31, ob = rr * 64 + cc * 2; return st * 1024 + (ob ^ (((ob >> 9) & 1) << 5)); }
__device__ __forceinline__ void stage_rc(int b, int& R, int& C) { const int st = b / 1024, sb = b % 1024, swz = sb ^ (((sb >> 9) & 1) << 5); R = (st >> 1) * 16 + swz / 64; C = (st & 1) * 32 + (swz % 64) / 2; }
__device__ __forceinline__ int perm32(int rho) { const int n = rho >> 4, i = rho & 15; return 8 * (i >> 2) + 4 * n + (i & 3); }
typedef __bf16 bf16x2_t __attribute__((ext_vector_type(2)));
__device__ __forceinline__ unsigned cvt_pk_bf16(float lo, float hi) { const f32x2 v = {lo, hi}; return __builtin_bit_cast(unsigned, __builtin_convertvector(v, bf16x2_t)); }
__device__ __forceinline__ u32x4 pack8(const f32x4 a, const f32x4 b) { u32x4 w; w.x = cvt_pk_bf16(a[0], a[1]); w.y = cvt_pk_bf16(a[2], a[3]); w.z = cvt_pk_bf16(b[0], b[1]); w.w = cvt_pk_bf16(b[2], b[3]); return w; }
__device__ __forceinline__ float bflo(unsigned w) { return __uint_as_float(w << 16); }
__device__ __forceinline__ float bfhi(unsigned w) { return __uint_as_float(w & 0xffff0000u); }
__device__ __forceinline__ void unpack8(const u32x4 w, f32x4& a, f32x4& b) { a[0] = bflo(w.x); a[1] = bfhi(w.x); a[2] = bflo(w.y); a[3] = bfhi(w.y); b[0] = bflo(w.z); b[1] = bfhi(w.z); b[2] = bflo(w.w); b[3] = bfhi(w.w); }
__device__ __forceinline__ float fsigmoid(float v) { return __builtin_amdgcn_rcpf(1.f + __expf(-v)); }
__device__ __forceinline__ float fgelu(float v) { return v * fsigmoid(1.5957691216057308f * (v + 0.044715f * v * v * v)); }

__device__ __forceinline__ unsigned pack4_fp8(float a, float b, float c, float d) { unsigned w = 0; w = __builtin_amdgcn_cvt_pk_fp8_f32(a, b, w, false); w = __builtin_amdgcn_cvt_pk_fp8_f32(c, d, w, true); return w; }
typedef float f32x2v __attribute__((ext_vector_type(2)));
__device__ __forceinline__ void unpack8_fp8(const u32x2 w, f32x4& a, f32x4& b) {
    const f32x2v p0 = __builtin_amdgcn_cvt_pk_f32_fp8((int)w.x, false), p1 = __builtin_amdgcn_cvt_pk_f32_fp8((int)w.x, true), p2 = __builtin_amdgcn_cvt_pk_f32_fp8((int)w.y, false), p3 = __builtin_amdgcn_cvt_pk_f32_fp8((int)w.y, true);
    a = (f32x4){p0[0], p0[1], p1[0], p1[1]}; b = (f32x4){p2[0], p2[1], p3[0], p3[1]}; }
#ifdef WSUM_DPP
__device__ __forceinline__ float wsum(float v, int lane) {
    (void)lane;
#define WS_DPP(x, ctrl, rmask) __builtin_bit_cast(float, __builtin_amdgcn_update_dpp(0, __builtin_bit_cast(int, (x)), (ctrl), (rmask), 0xf, true))
    v += WS_DPP(v, 0xB1, 0xf);
    v += WS_DPP(v, 0x4E, 0xf);
    v += WS_DPP(v, 0x141, 0xf);
    v += WS_DPP(v, 0x140, 0xf);
    v += WS_DPP(v, 0x142, 0xa);
    v += WS_DPP(v, 0x143, 0xc);
#undef WS_DPP
    return __builtin_bit_cast(float, __builtin_amdgcn_readlane(__builtin_bit_cast(int, v), 63));
}
#else
__device__ __forceinline__ float wsum(float v, int lane) {
#pragma unroll
    for (int o = 32; o >= 1; o >>= 1) v += __builtin_bit_cast(float, __builtin_amdgcn_ds_bpermute((lane ^ o) << 2, __builtin_bit_cast(int, v)));
    return v;
}
#endif
__device__ __forceinline__ const float* pos_ptr(const float* pr, int n, int col) { return col < 512 ? pr + (size_t)(n >> 6) * 512 + col : pr + (size_t)(32 + (n & 63)) * 512 + (col - 512); }
constexpr int COSTAB_OFF = STAGE_BYTES + 4096;
constexpr float W8SC = 64.f, W8INV = 1.0f / 64.f;
struct Unit { const char* A; const char* B; const char* B2; unsigned lda2, ldb2; int nt, perm, kind, z, pm, pn, mir, mh; };
struct Job { const char* A; const char* B; size_t zA, zB, eB; const LAS int* tlut; unsigned lda2, ldb2; int nt, nM, nN, nZ, perm, kind, pm0, pn0, order, mirL, grp; };
__device__ __forceinline__ Job mkjob(const void* A, const void* B, size_t zA, size_t zB, unsigned lda2, unsigned ldb2, int nt, int nM, int nN, int nZ, int perm, int kind, int pm0, int pn0) {
    Job j; j.A = (const char*)A; j.B = (const char*)B; j.zA = zA; j.zB = zB; j.eB = 0; j.tlut = nullptr; j.lda2 = lda2; j.ldb2 = ldb2; j.nt = nt; j.nM = nM; j.nN = nN; j.nZ = nZ; j.perm = perm; j.kind = kind; j.pm0 = pm0; j.pn0 = pn0; j.order = 0; j.mirL = 0; j.grp = 8; return j; }
__device__ __forceinline__ void decode_unit(const Job& J, int ww, Unit& u) {
        int z, pm, pn;
        if (J.order == 1) { const int per = J.nZ * J.nN; const int q = ww / per, rem = ww - q * per; pm = J.pm0 + q; z = rem / J.nN; pn = J.pn0 + (rem - z * J.nN); }
        else { const int per = J.nM * J.nN; z = ww / per; const int rem = ww - z * per;
            const int nig = J.grp * J.nN, gid = rem / nig, fm = gid * J.grp, gsz = (J.nM - fm) < J.grp ? (J.nM - fm) : J.grp, rr = rem - gid * nig;
            pm = J.pm0 + fm + (rr % gsz); pn = J.pn0 + rr / gsz; }
        u.A = J.A + (size_t)z * J.zA + (size_t)pm * 256 * J.lda2;
        u.B = J.B + (size_t)z * J.zB + (size_t)pn * 256 * J.ldb2 + (J.tlut ? (size_t)J.tlut[pm] * J.eB : (size_t)0);
        u.B2 = u.B + (size_t)128 * J.ldb2; u.mir = 0; u.mh = 0;
        if (J.mirL) {
            u.B = J.B + (size_t)z * J.zB + (size_t)pn * 128 * J.ldb2; u.B2 = J.B + (size_t)z * J.zB + (size_t)(pn == 0 ? J.mirL / 2 : J.mirL - 128 * pn - 127) * J.ldb2; u.mir = pn == 0 ? 2 : 1; u.mh = J.mirL / 2; }
        u.lda2 = J.lda2; u.ldb2 = J.ldb2; u.nt = J.nt; u.perm = J.perm; u.kind = J.kind; u.z = z; u.pm = pm; u.pn = pn;
        { unsigned long long pc = (unsigned long long)u.B2; pc = ((unsigned long long)(unsigned)__builtin_amdgcn_readfirstlane((int)(pc >> 32)) << 32) | (unsigned)__builtin_amdgcn_readfirstlane((int)(unsigned)pc); u.B2 = (const char*)pc;
          u.mir = __builtin_amdgcn_readfirstlane(u.mir); u.mh = __builtin_amdgcn_readfirstlane(u.mh); }
        { unsigned long long pa = (unsigned long long)u.A, pb = (unsigned long long)u.B;
          pa = ((unsigned long long)(unsigned)__builtin_amdgcn_readfirstlane((int)(pa >> 32)) << 32) | (unsigned)__builtin_amdgcn_readfirstlane((int)(unsigned)pa);
          pb = ((unsigned long long)(unsigned)__builtin_amdgcn_readfirstlane((int)(pb >> 32)) << 32) | (unsigned)__builtin_amdgcn_readfirstlane((int)(unsigned)pb);
          u.A = (const char*)pa; u.B = (const char*)pb; u.lda2 = (unsigned)__builtin_amdgcn_readfirstlane((int)u.lda2); u.ldb2 = (unsigned)__builtin_amdgcn_readfirstlane((int)u.ldb2);
          u.nt = __builtin_amdgcn_readfirstlane(u.nt); u.perm = __builtin_amdgcn_readfirstlane(u.perm); u.kind = __builtin_amdgcn_readfirstlane(u.kind); u.z = __builtin_amdgcn_readfirstlane(u.z);
          u.pm = __builtin_amdgcn_readfirstlane(u.pm); u.pn = __builtin_amdgcn_readfirstlane(u.pn); }
}
template <int NJ> struct JobSched {
    Job j[NJ]; int cnt[NJ]; int total, G, c, dry = 0;
    __device__ __forceinline__ void init(int G_, int c_) { total = 0;
#pragma unroll
        for (int k = 0; k < NJ; ++k) { cnt[k] = j[k].nZ * j[k].nM * j[k].nN; total += cnt[k]; }
        G = G_; c = c_; }
    __device__ __forceinline__ int nunits() const { return total; }
    __device__ __forceinline__ bool next(int i, Unit& u) const {
        const int Lq = i * G + c; if (Lq >= total) return false;
        int w = Lq;
#ifdef GLOBAL_REMAP
        { const int q = total / 8, r = total % 8, xcd = Lq % 8, off = Lq / 8; w = (xcd < r ? xcd * (q + 1) : r * (q + 1) + (xcd - r) * q) + off; }
#else
        { const int R = (total - i * G) < G ? (total - i * G) : G; const int q = R / 8, r = R % 8, xcd = c % 8, off = c / 8; w = i * G + (xcd < r ? xcd * (q + 1) : r * (q + 1) + (xcd - r) * q) + off; }
#endif
        Job J = j[0];
        int ww = w; bool done = false;
#pragma unroll
        for (int k = 0; k < NJ; ++k) { if (!done) { if (ww < cnt[k] || k == NJ - 1) { J = j[k]; done = true; } else ww -= cnt[k]; } }
        decode_unit(J, ww, u);
        return true;
    }
};

struct BalSched {
    Job j[2]; int n0, n1, G, cp, E, base0, gH, gL, extra, nl, dry = 0;
    __device__ __forceinline__ void init(int G_, int c_) {
        G = G_; cp = (G & 7) == 0 ? (c_ & 7) * (G >> 3) + (c_ >> 3) : c_;
        n0 = j[0].nZ * j[0].nM * j[0].nN; n1 = j[1].nZ * j[1].nM * j[1].nN; base0 = n0 / G; E = n0 - base0 * G;
        const int W = (n0 * j[0].nt + n1 * j[1].nt) / G; int g = (W - (base0 + 1) * j[0].nt) / j[1].nt; g = g < 0 ? 0 : g; if (E > 0 && g * E > n1) g = n1 / E;
        nl = G - E;
        if (E > 0 && (g + 1) * E <= n1) {
            const int Ra = n1 - E * g, Rb = Ra - E;
            const int la = base0 * j[0].nt + ((Ra + nl - 1) / nl) * j[1].nt, ha = (base0 + 1) * j[0].nt + g * j[1].nt, ma = la > ha ? la : ha;
            const int lb = base0 * j[0].nt + ((Rb + nl - 1) / nl) * j[1].nt, hb = ha + j[1].nt, mb = lb > hb ? lb : hb;
            if (mb < ma) g = g + 1; }
        gH = g; const int R1 = n1 - E * gH; gL = R1 / nl; extra = R1 - gL * nl;
    }
    __device__ __forceinline__ int nunits() const { return n0 + n1; }
    __device__ __forceinline__ bool next(int i, Unit& u) const {
        const int mylong = base0 + (cp < E ? 1 : 0);
        if (i < mylong) { decode_unit(j[0], i * G + cp, u); return true; }
        const int s = i - mylong; int w;
        if (cp < E) { if (s >= gH) return false; w = s * E + cp; }
        else { const int k = cp - E; if (s < gL) w = E * gH + s * nl + k; else if (s == gL && k < extra) w = E * gH + gL * nl + k; else return false; }
        decode_unit(j[1], w, u); return true;
    }
};

struct BalLong { Job j; int G, cp, mylong, dry = 0;
    __device__ __forceinline__ int nunits() const { return mylong * G; }
    __device__ __forceinline__ bool next(int i, Unit& u) const { if (i >= mylong) return false; decode_unit(j, i * G + cp, u); return true; } };
struct BalShort { Job j; int cp, E, gH, gL, extra, nl, dry = 0;
    __device__ __forceinline__ int nunits() const { return 0; }
    __device__ __forceinline__ bool next(int s, Unit& u) const { int w;
        if (cp < E) { if (s >= gH) return false; w = s * E + cp; }
        else { const int k = cp - E; if (s < gL) w = E * gH + s * nl + k; else if (s == gL && k < extra) w = E * gH + gL * nl + k; else return false; }
        decode_unit(j, w, u); return true; } };

struct P3Sched {
    Job jq, jp, js0, js1; int G, cp, n0, n1, dry = 0;
    __device__ __forceinline__ void init(int G_, int c_) { G = G_; cp = (c_ & 7) * (G >> 3) + (c_ >> 3); n0 = js0.nZ * js0.nM * js0.nN; n1 = js1.nZ * js1.nM * js1.nN; }
    __device__ __forceinline__ int nunits() const { return 256 + n0 + n1; }
    __device__ __forceinline__ bool next(int i, Unit& u) const {
        const int k = cp >> 1;
        if ((cp & 1) == 0) { if (i > 0) return false; decode_unit(jq, k, u); return true; }
        if (i == 0) { decode_unit(jp, k, u); return true; }
        const int w = (i - 1) * 128 + k; if (w < n0) { decode_unit(js0, w, u); return true; } if (w - n0 < n1) { decode_unit(js1, w - n0, u); return true; } return false;
    }
};

template <class Epi, class Sched, bool MIR = false, bool F8 = false>
__device__ __forceinline__ void gemm_phase_(LAS unsigned char* lds, const Sched& S, const Epi& E, unsigned g_wave_s) {
    int tid = TIDX; asm volatile("" : "+v"(tid));
    const int wid = __builtin_amdgcn_readfirstlane(tid >> 6), lane = tid & 63, wr = wid >> 2, wc = wid & 3, fr = lane & 15, fq = lane >> 4;
    int R0, C0; stage_rc(tid * 16, R0, C0);
    const int Rp0 = (R0 & ~31) + perm32(R0 & 31);
    const unsigned ldsw = (unsigned)wid * 1024u;
    const int aoff = lds_byte(wr * 64 + fr, fq * 8), boff = lds_byte(wc * 32 + fr, fq * 8);
#define G_SA(b, h) (((b) * 2 + (h)) * HTB)
#define G_SB(b, h) ((4 + (b) * 2 + (h)) * HTB)
#define G_STAGE(bufoff, gbase, v0, s64) do { const char* _g1 = (const char*)(gbase); const char* _g2 = _g1 + (s64); unsigned _o1 = (v0); asm volatile("" : "+s"(_g1), "+s"(_g2), "+v"(_o1)); \
          \
        __builtin_amdgcn_global_load_lds((const unsigned*)(_g1 + _o1), (LAS unsigned*)(lds + (bufoff) + ldsw), 16, 0, 0); \
        __builtin_amdgcn_global_load_lds((const unsigned*)(_g2 + _o1), (LAS unsigned*)(lds + (bufoff) + ldsw + 8192), 16, 0, 0); } while (0)
#define G_STAGE2(bufoff, gbase, va, vb) do { \
        __builtin_amdgcn_global_load_lds((const unsigned*)((const char*)(gbase) + (va)), (LAS unsigned*)(lds + (bufoff) + ldsw), 16, 0, 0); \
        __builtin_amdgcn_global_load_lds((const unsigned*)((const char*)(gbase) + (vb)), (LAS unsigned*)(lds + (bufoff) + ldsw + 8192), 16, 0, 0); } while (0)
#define G_STAGEB1(bufoff, p1, vf, hh, p2, va, vb) do { if constexpr (MIR) G_STAGE2(bufoff, p2, va, vb); else G_STAGE(bufoff, (p1) + (hh), vf, (hh) / 2); } while (0)
#define G_VOFF2(u, va, vb) do { if constexpr (MIR) { const unsigned jj = (unsigned)((u).perm ? Rp0 : R0), c2 = (unsigned)C0 * 2u; \
        if ((u).mir == 0) { va = jj * (u).ldb2 + c2; vb = va + 64u * (u).ldb2; } \
        else if ((u).mir == 1) { va = (127u - jj) * (u).ldb2 + c2; vb = (63u - jj) * (u).ldb2 + c2; } \
        else { va = (jj == 0u ? 0u : ((unsigned)(u).mh - jj)) * (u).ldb2 + c2; vb = ((unsigned)(u).mh - jj - 64u) * (u).ldb2 + c2; } } } while (0)
#define G_LDA(dst, b, h) do { if constexpr (F8) { _Pragma("unroll") for (int m = 0; m < 4; ++m) { const i32x4 _l = *(const LAS i32x4*)(lds + G_SA(b, h) + aoff + m * 2048), _h = *(const LAS i32x4*)(lds + G_SA(b, h) + aoff + m * 2048 + 1024); \
            dst##8[m] = __builtin_shufflevector(_l, _h, 0, 1, 2, 3, 4, 5, 6, 7); } } \
        else { _Pragma("unroll") for (int m = 0; m < 4; ++m) _Pragma("unroll") for (int k = 0; k < 2; ++k) dst[m][k] = *(const LAS bf16x8*)(lds + G_SA(b, h) + aoff + m * 2048 + k * 1024); } } while (0)
#define G_LDB(dst, b, h) do { if constexpr (F8) { _Pragma("unroll") for (int n = 0; n < 2; ++n) { const i32x4 _l = *(const LAS i32x4*)(lds + G_SB(b, h) + boff + n * 2048), _h = *(const LAS i32x4*)(lds + G_SB(b, h) + boff + n * 2048 + 1024); \
            dst##8[n] = __builtin_shufflevector(_l, _h, 0, 1, 2, 3, 4, 5, 6, 7); } } \
        else { _Pragma("unroll") for (int n = 0; n < 2; ++n) _Pragma("unroll") for (int k = 0; k < 2; ++k) dst[n][k] = *(const LAS bf16x8*)(lds + G_SB(b, h) + boff + n * 2048 + k * 1024); } } while (0)
#define G_MMA(ai, bj, At, Bt) do { __builtin_amdgcn_s_setprio(1); \
        if constexpr (F8) { _Pragma("unroll") for (int m = 0; m < 4; ++m) _Pragma("unroll") for (int n = 0; n < 2; ++n) \
            acc[ai][bj][m][n] = __builtin_amdgcn_mfma_scale_f32_16x16x128_f8f6f4(Bt##8[n], At##8[m], acc[ai][bj][m][n], 0, 0, 0, 0, 0, 0); } \
        else { _Pragma("unroll") for (int m = 0; m < 4; ++m) _Pragma("unroll") for (int n = 0; n < 2; ++n) _Pragma("unroll") for (int k = 0; k < 2; ++k) \
            acc[ai][bj][m][n] = __builtin_amdgcn_mfma_f32_16x16x32_bf16(Bt[n][k], At[m][k], acc[ai][bj][m][n], 0, 0, 0); } \
        __builtin_amdgcn_s_setprio(0); } while (0)
#define G_WAIT_V(n) asm volatile("s_waitcnt vmcnt(" #n ")" ::: "memory")
#define G_WAIT_L(n) asm volatile("s_waitcnt lgkmcnt(" #n ")" ::: "memory")
#define G_BAR __builtin_amdgcn_s_barrier()
#define G_SCHED __builtin_amdgcn_sched_barrier(0)
#define G_OA(ld) ((unsigned)R0 * (ld) + (unsigned)C0 * 2u)
#define G_OB(ld, pm) ((unsigned)((pm) ? Rp0 : R0) * (ld) + (unsigned)C0 * 2u)
#define G_VOFF(u, a0, b0, ha, hb) do { a0 = (unsigned)R0 * (u).lda2 + (unsigned)C0 * 2u; b0 = (unsigned)((u).perm ? Rp0 : R0) * (u).ldb2 + (unsigned)C0 * 2u; ha = 128u * (u).lda2; hb = 128u * (u).ldb2; } while (0)
    Unit cur, nxt; int ui = 0;
    if (!S.next(0, cur)) return;
#ifdef STAGGER_TICKS
    if (S.nunits() >= 6 * (int)gridDim.x) { const unsigned long long t0 = wall_clock64(); const unsigned long long dly = (unsigned long long)(blockIdx.x & 3) * STAGGER_TICKS;
        while (wall_clock64() - t0 < dly) __builtin_amdgcn_s_sleep(8); }
#endif
    f32x4 acc[2][2][4][2];
#pragma unroll
    for (int a = 0; a < 2; ++a)
#pragma unroll
        for (int b = 0; b < 2; ++b)
#pragma unroll
            for (int m = 0; m < 4; ++m)
#pragma unroll
                for (int n = 0; n < 2; ++n) acc[a][b][m][n] = (f32x4){0.f, 0.f, 0.f, 0.f};
    bf16x8 At[4][2], B0[2][2], B1[2][2]; i32x8 At8[4], B08[2], B18[2]; (void)At; (void)B0; (void)B1; (void)At8; (void)B08; (void)B18;
    unsigned vA, vB, hA, hB; G_VOFF(cur, vA, vB, hA, hB);
    unsigned vBa = 0, vBb = 0; G_VOFF2(cur, vBa, vBb);
    const char* cA = cur.A; const char* cB = cur.B; const char* cB2 = cur.B2;
    const size_t kstep = 128;
#define VA_C (vA)
#define VB_C (vB)
    G_STAGE(G_SB(0, 0), cB, VB_C, hB / 2); G_STAGEB1(G_SB(0, 1), cB, VB_C, hB, cB2, vBa, vBb); G_STAGE(G_SA(0, 0), cA, VA_C, hA / 2); G_STAGE(G_SA(0, 1), cA + hA, VA_C, hA / 2);
    if (wr == 1) G_BAR;
    G_WAIT_V(2); G_BAR;
    G_STAGE(G_SB(1, 0), cB + kstep, VB_C, hB / 2); G_STAGE(G_SA(1, 0), cA + kstep, VA_C, hA / 2); G_STAGEB1(G_SB(1, 1), cB + kstep, VB_C, hB, cB2 + kstep, vBa, vBb);
    G_WAIT_V(6); G_BAR;
    for (;;) {
        const bool has_next = S.next(ui + 1, nxt);
        unsigned nvA = vA, nvB = vB, nhA = hA, nhB = hB, nvBa = vBa, nvBb = vBb; const char* nA = cA; const char* nB = cB; const char* nB2 = cB2;
        if (has_next) { G_VOFF(nxt, nvA, nvB, nhA, nhB); G_VOFF2(nxt, nvBa, nvBb); nA = nxt.A; nB = nxt.B; nB2 = nxt.B2; }
        const int nt = cur.nt;
        for (int t = 0; t < nt; t += 2) {
            const bool last = (t == nt - 2);
            const char* a1 = cA + (size_t)(t + 1) * kstep;
            const char* a2 = last ? nA : cA + (size_t)(t + 2) * kstep; const char* b2 = last ? nB : cB + (size_t)(t + 2) * kstep;
            const char* a3 = a2 + kstep; const char* b3 = b2 + kstep;
            const char* b2s = last ? nB2 : cB2 + (size_t)(t + 2) * kstep;
            const unsigned xA = last ? nvA : vA, xB = last ? nvB : vB, xhA = last ? nhA : hA, xhB = last ? nhB : hB, xBa = last ? nvBa : vBa, xBb = last ? nvBb : vBb;
#define VA_X (xA)
#define VB_X (xB)
            G_LDB(B0, 0, 0); G_LDB(B1, 0, 1); G_SCHED; G_LDA(At, 0, 0); G_STAGE(G_SA(1, 1), a1 + hA, VA_C, hA / 2);
            G_WAIT_V(8); G_WAIT_L(0); G_BAR; G_MMA(0, 0, At, B0); G_MMA(0, 1, At, B1); G_BAR; G_SCHED;
            G_LDA(At, 0, 1); G_STAGE(G_SB(0, 0), b2, VB_X, xhB / 2); G_STAGEB1(G_SB(0, 1), b2, VB_X, xhB, b2s, xBa, xBb); G_STAGE(G_SA(0, 0), a2, VA_X, xhA / 2);
            G_WAIT_V(8); G_WAIT_L(0); G_BAR; G_MMA(1, 0, At, B0); G_MMA(1, 1, At, B1); G_BAR; G_SCHED;
            G_LDB(B0, 1, 0); G_LDB(B1, 1, 1); G_SCHED; G_LDA(At, 1, 0); G_STAGE(G_SA(0, 1), a2 + xhA, VA_X, xhA / 2);
            G_WAIT_V(8); G_WAIT_L(0); G_BAR; G_MMA(0, 0, At, B0); G_MMA(0, 1, At, B1); G_BAR; G_SCHED;
            G_LDA(At, 1, 1); G_STAGE(G_SB(1, 0), b3, VB_X, xhB / 2); G_STAGEB1(G_SB(1, 1), b3, VB_X, xhB, b2s + kstep, xBa, xBb); G_STAGE(G_SA(1, 0), a3, VA_X, xhA / 2);
            G_WAIT_V(8); G_WAIT_L(0); G_BAR; G_MMA(1, 0, At, B0); G_MMA(1, 1, At, B1); G_BAR; G_SCHED;
        }
#ifndef NO_ALIGN_EPI
        if (wr == 0) G_BAR;
#endif
        if (!S.dry) E(acc, cur, wr, wc, fr, fq);
        if (!has_next) break;
#pragma unroll
        for (int a = 0; a < 2; ++a)
#pragma unroll
            for (int b = 0; b < 2; ++b)
#pragma unroll
                for (int m = 0; m < 4; ++m)
#pragma unroll
                    for (int n = 0; n < 2; ++n) acc[a][b][m][n] = (f32x4){0.f, 0.f, 0.f, 0.f};
        cur = nxt; cA = nA; cB = nB; cB2 = nB2; vA = nvA; vB = nvB; hA = nhA; hB = nhB; vBa = nvBa; vBb = nvBb; ++ui;
#ifndef NO_ALIGN_EPI
        if (wr == 1) G_BAR;
#endif
    }
    G_WAIT_V(0);
#ifdef NO_ALIGN_EPI
    if (wr == 0) G_BAR;
#endif
    G_BAR;
#undef G_SA
#undef G_SB
#undef G_STAGE
#undef G_LDA
#undef G_LDB
#undef G_MMA
#undef G_WAIT_V
#undef G_WAIT_L
#undef G_BAR
#undef G_SCHED
#undef G_VOFF
#undef G_OA
#undef G_OB
#undef VA_C
#undef VB_C
#undef VA_X
#undef VB_X
#undef G_VOFF2
#undef G_STAGE2
#undef G_STAGEB1
}

__device__ __forceinline__ void st16_wt(void* p, const u32x4 v) { asm volatile("global_store_dwordx4 %0, %1, off sc1\n\ts_nop 1" : : "v"(p), "v"(v) : "memory"); }
#ifdef WT_STORES
#define ST16(p, v) st16_wt((void*)(p), __builtin_bit_cast(u32x4, (v)))
#else
#define ST16(p, v) (*(u32x4*)(p) = __builtin_bit_cast(u32x4, (v)))
#endif
#define EPI_ARGS const f32x4 (&acc)[2][2][4][2], const Unit& u, int wr, int wc, int fr, int fq
struct EpiInproj {
    bf16_t* UX; bf16_t* GT; bf16_t* VL; bf16_t* VC;
    __device__ __forceinline__ void operator()(EPI_ARGS) const {
        const int rb = u.pm * 256 + wr * 64 + fr, cb = u.pn * 256 + wc * 32 + 8 * fq;
#pragma unroll
        for (int ai = 0; ai < 2; ++ai)
#pragma unroll
            for (int m = 0; m < 4; ++m) { const int r = rb + ai * 128 + m * 16;
#pragma unroll
                for (int bj = 0; bj < 2; ++bj) { const int c0 = cb + bj * 128; f32x4 v0 = acc[ai][bj][m][0], v1 = acc[ai][bj][m][1];
                    if (u.kind == 0) {
                        ST16(UX + ux_index(c0 >> 4, r, c0 & 15), pack8(v0, v1));
                    } else if (bj == 0) {
                        const bool cosrow = (r < 256) || ((r & 63) == 0); const int Lh = u.mh, j0 = wc * 32 + 8 * fq; const f32x4 b0 = acc[ai][1][m][0], b1 = acc[ai][1][m][1];
                        bf16_t* rowp = (u.kind == 1 ? VL : VC) + ((size_t)u.z * 512 + r) * (size_t)(2 * Lh) + u.pn * 128 + j0;
                        f32x4 e0, e1, z0 = {0.f, 0.f, 0.f, 0.f};
#pragma unroll
                        for (int q = 0; q < 4; ++q) { e0[q] = cosrow ? v0[q] + b0[q] : v0[q] - b0[q]; e1[q] = cosrow ? v1[q] + b1[q] : v1[q] - b1[q]; }
                        if (u.pn == 0 && j0 == 0) { if (cosrow) { e0[0] = v0[0]; z0[0] = b0[0]; } else e0[0] = 0.f; }
                        { u32x4 zv = {0u, 0u, 0u, 0u}; zv.x = cvt_pk_bf16(z0[0], 0.f); ST16(rowp + (cosrow ? Lh : 0), zv); }
                        ST16(rowp + (cosrow ? 0 : Lh), pack8(e0, e1));
                    }
                } }
    }
};
struct EpiGate8 {
    unsigned char* G8;
    __device__ __forceinline__ void operator()(EPI_ARGS) const {
        const int rb = u.pm * 256 + wr * 64 + fr, cb = u.pn * 256 + wc * 32 + 8 * fq;
#pragma unroll
        for (int ai = 0; ai < 2; ++ai)
#pragma unroll
            for (int m = 0; m < 4; ++m) { unsigned char* rowp = G8 + (size_t)(rb + ai * 128 + m * 16) * 2048 + cb;
#pragma unroll
                for (int bj = 0; bj < 2; ++bj) { const f32x4 v0 = acc[ai][bj][m][0] * W8INV, v1 = acc[ai][bj][m][1] * W8INV; u32x2 w; w.x = pack4_fp8(v0[0], v0[1], v0[2], v0[3]); w.y = pack4_fp8(v1[0], v1[1], v1[2], v1[3]); *(u32x2*)(rowp + bj * 128) = w; } }
    }
};
struct EpiP3 {
    bf16_t* YS; float* S; float sl, sc;
    __device__ __forceinline__ void operator()(EPI_ARGS) const {
        const int rb = u.pm * 256 + wr * 64 + fr;
        if (u.kind == 2) { const int cb = wc * 32 + 8 * fq;
#pragma unroll
            for (int ai = 0; ai < 2; ++ai)
#pragma unroll
                for (int m = 0; m < 4; ++m) { bf16_t* rowp = (bf16_t*)S + ((size_t)u.z * CHR + rb + ai * 128 + m * 16) * 256 + cb;
#pragma unroll
                    for (int bj = 0; bj < 2; ++bj) ST16(rowp + bj * 128, pack8(acc[ai][bj][m][0], acc[ai][bj][m][1])); }
        } else { const int cb = u.pn * 256 + wc * 32 + 8 * fq; const float s = u.kind == 0 ? sl : sc; const size_t row0 = u.kind == 0 ? (size_t)TC + (size_t)u.z * L : (size_t)u.z * LC;
#pragma unroll
            for (int ai = 0; ai < 2; ++ai)
#pragma unroll
                for (int m = 0; m < 4; ++m) { bf16_t* rowp = YS + (row0 + rb + ai * 128 + m * 16) * 1024 + cb;
#pragma unroll
                    for (int bj = 0; bj < 2; ++bj) ST16(rowp + bj * 128, pack8(acc[ai][bj][m][0] * s, acc[ai][bj][m][1] * s)); }
        }
    }
};
struct EpiP5 {
    bf16_t* YS; const bf16_t* GT; bf16_t* TM;
    __device__ __forceinline__ void operator()(EPI_ARGS) const {
        const int rb = u.pm * 256 + wr * 64 + fr, cb = u.pn * 256 + wc * 32 + 8 * fq;
        if (u.kind == 0) {
#pragma unroll
            for (int ai = 0; ai < 2; ++ai)
#pragma unroll
                for (int m = 0; m < 4; ++m) { const int r = rb + ai * 128 + m * 16;
#pragma unroll
                    for (int bj = 0; bj < 2; ++bj) { const int c0 = cb + bj * 128; f32x4 v0 = acc[ai][bj][m][0], v1 = acc[ai][bj][m][1];
#pragma unroll
                        for (int j = 0; j < 4; ++j) { v0[j] = fgelu(v0[j]); v1[j] = fgelu(v1[j]); }
                        ST16(YS + ((size_t)r * 16 + (c0 >> 4)) * 1024 + 512 + u.z * 16 + (c0 & 15), pack8(v0, v1)); } }
        } else {
#pragma unroll
            for (int ai = 0; ai < 2; ++ai) { u32x2 gw[4][2];
#pragma unroll
                for (int m = 0; m < 4; ++m)
#pragma unroll
                    for (int bj = 0; bj < 2; ++bj) gw[m][bj] = *(const u32x2*)((const unsigned char*)GT + (size_t)(rb + ai * 128 + m * 16) * 2048 + cb + bj * 128);
#pragma unroll
                for (int m = 0; m < 4; ++m)
#pragma unroll
                    for (int bj = 0; bj < 2; ++bj) { f32x4 g0, g1; unpack8_fp8(gw[m][bj], g0, g1);
#pragma unroll
                        for (int j = 0; j < 4; ++j) { g0[j] = fsigmoid(g0[j]); g1[j] = fsigmoid(g1[j]); }
                        ST16(TM + (size_t)(rb + ai * 128 + m * 16) * 1024 + cb + bj * 128, pack8(acc[ai][bj][m][0] * g0, acc[ai][bj][m][1] * g1)); } }
        }
    }
};
struct EpiGlu {
    const bf16_t* GT; bf16_t* TM; unsigned* ready;
    __device__ __forceinline__ void operator()(EPI_ARGS) const {
        const int rb = u.pm * 256 + wr * 64 + fr, c0 = u.pn * 128 + wc * 32 + 8 * fq; const bool wt = ready != nullptr && u.pm < 16;
#pragma unroll
        for (int ai = 0; ai < 2; ++ai) { u32x2 gw[4]; u32x4 tw[4];
#pragma unroll
            for (int m = 0; m < 4; ++m) { const int r = rb + ai * 128 + m * 16; gw[m] = *(const u32x2*)((const unsigned char*)GT + (size_t)r * 2048 + 1024 + c0); tw[m] = *(const u32x4*)(TM + (size_t)r * 1024 + c0); }
#pragma unroll
            for (int m = 0; m < 4; ++m) { const int r = rb + ai * 128 + m * 16;
                f32x4 g0, g1, t0, t1; unpack8_fp8(gw[m], g0, g1); unpack8(tw[m], t0, t1);
                const f32x4 a0 = acc[ai][0][m][0], a1 = acc[ai][0][m][1], b0 = acc[ai][1][m][0], b1 = acc[ai][1][m][1];
#pragma unroll
                for (int j = 0; j < 4; ++j) { t0[j] += fsigmoid(g0[j]) * a0[j] * fsigmoid(b0[j]); t1[j] += fsigmoid(g1[j]) * a1[j] * fsigmoid(b1[j]); }
                if (wt) st16_wt(TM + (size_t)r * 1024 + c0, pack8(t0, t1)); else ST16(TM + (size_t)r * 1024 + c0, pack8(t0, t1)); } }
        if (wt) { asm volatile("s_waitcnt vmcnt(0)" ::: "memory"); if (fr == 0 && fq == 0) (void)xb_add(ready + 16 * u.pm, 1u); }
    }
};
#ifdef RES16
template <bool LOWREG> struct EpiResT {
    bf16_t* h; bf16_t* z; const float* mod; int gidx; const float* xin; const float* cin; const float* pos; float sc = 1.f;
    __device__ __forceinline__ void operator()(EPI_ARGS) const {
        const int rb = u.pm * 256 + wr * 64 + fr, cb = u.pn * 256 + wc * 32 + 8 * fq;
        const float* gp = mod + (size_t)(rb < TC ? 16 : (rb - TC) >> 11) * 6144 + gidx * 1024 + cb;
        f32x4 gg[2][2];
        if (!LOWREG) {
#pragma unroll
        for (int bj = 0; bj < 2; ++bj)
#pragma unroll
            for (int n = 0; n < 2; ++n) gg[bj][n] = *(const f32x4*)(gp + bj * 128 + n * 4) * sc; }
#pragma unroll
        for (int ai = 0; ai < 2; ++ai) {
            if (LOWREG) {
#pragma unroll
                for (int bj = 0; bj < 2; ++bj)
#pragma unroll
                    for (int n = 0; n < 2; ++n) gg[bj][n] = *(const f32x4*)(gp + bj * 128 + n * 4) * sc; }
            if (xin) {
#pragma unroll
                for (int mh = 0; mh < 2; ++mh) { f32x4 o[2][2][2];
#pragma unroll
                    for (int mm = 0; mm < 2; ++mm) { const int r = rb + ai * 128 + (mh * 2 + mm) * 16;
                        const float* rowp = (r < TC ? cin + (size_t)r * D : xin + (size_t)(r - TC) * D) + cb; const float* prow = pos_ptr(pos, (r - TC) & (L - 1), cb);
#pragma unroll
                        for (int bj = 0; bj < 2; ++bj)
#pragma unroll
                            for (int n = 0; n < 2; ++n) { o[mm][bj][n] = *(const f32x4*)(rowp + bj * 128 + n * 4); if (r >= TC) o[mm][bj][n] += *(const f32x4*)(prow + bj * 128 + n * 4); } }
#pragma unroll
                    for (int mm = 0; mm < 2; ++mm) { const int m = mh * 2 + mm; const int r = rb + ai * 128 + m * 16; bf16_t* orow = (r < TC ? z + (size_t)r * D : h + (size_t)(r - TC) * D) + cb;
#pragma unroll
                        for (int bj = 0; bj < 2; ++bj) ST16(orow + bj * 128, pack8(o[mm][bj][0] + gg[bj][0] * acc[ai][bj][m][0], o[mm][bj][1] + gg[bj][1] * acc[ai][bj][m][1])); }
                    asm volatile("" ::: "memory"); }
            } else { u32x4 ow[4][2];
#pragma unroll
                for (int m = 0; m < 4; ++m) { const int r = rb + ai * 128 + m * 16; const bf16_t* rowp = (r < TC ? z + (size_t)r * D : h + (size_t)(r - TC) * D) + cb;
#pragma unroll
                    for (int bj = 0; bj < 2; ++bj) ow[m][bj] = *(const u32x4*)(rowp + bj * 128); }
#pragma unroll
                for (int m = 0; m < 4; ++m) { const int r = rb + ai * 128 + m * 16; bf16_t* orow = (r < TC ? z + (size_t)r * D : h + (size_t)(r - TC) * D) + cb;
#pragma unroll
                    for (int bj = 0; bj < 2; ++bj) { f32x4 a, b; unpack8(ow[m][bj], a, b); ST16(orow + bj * 128, pack8(a + gg[bj][0] * acc[ai][bj][m][0], b + gg[bj][1] * acc[ai][bj][m][1])); } }
                asm volatile("" ::: "memory"); } }
    }
};
#else
template <bool LOWREG> struct EpiResT {
    float* h; float* z; const float* mod; int gidx; const float* xin; const float* cin; const float* pos; float sc = 1.f;
    __device__ __forceinline__ void operator()(EPI_ARGS) const {
        const int rb = u.pm * 256 + wr * 64 + fr, cb = u.pn * 256 + wc * 32 + 4 * fq;
        const float* gp = mod + (size_t)(rb < TC ? 16 : (rb - TC) >> 11) * 6144 + gidx * 1024 + cb;
        f32x4 gg[2][2];
        if (!LOWREG) {
#pragma unroll
        for (int bj = 0; bj < 2; ++bj)
#pragma unroll
            for (int n = 0; n < 2; ++n) gg[bj][n] = *(const f32x4*)(gp + bj * 128 + n * 16) * sc; }
#pragma unroll
        for (int ai = 0; ai < 2; ++ai)
#pragma unroll
            for (int mh = 0; mh < 2; ++mh) { f32x4 o[2][2][2];
                if (LOWREG) {
#pragma unroll
                    for (int bj = 0; bj < 2; ++bj)
#pragma unroll
                        for (int n = 0; n < 2; ++n) gg[bj][n] = *(const f32x4*)(gp + bj * 128 + n * 16) * sc; }
#pragma unroll
                for (int mm = 0; mm < 2; ++mm) { const int r = rb + ai * 128 + (mh * 2 + mm) * 16;
                    if (xin) { const float* rowp = (r < TC ? cin + (size_t)r * D : xin + (size_t)(r - TC) * D) + cb; const float* prow = pos_ptr(pos, (r - TC) & (L - 1), cb);
#pragma unroll
                        for (int bj = 0; bj < 2; ++bj)
#pragma unroll
                            for (int n = 0; n < 2; ++n) { o[mm][bj][n] = *(const f32x4*)(rowp + bj * 128 + n * 16); if (r >= TC) o[mm][bj][n] += *(const f32x4*)(prow + bj * 128 + n * 16); }
                    } else { const float* rowp = (r < TC ? z + (size_t)r * D : h + (size_t)(r - TC) * D) + cb;
#pragma unroll
                        for (int bj = 0; bj < 2; ++bj)
#pragma unroll
                            for (int n = 0; n < 2; ++n) o[mm][bj][n] = *(const f32x4*)(rowp + bj * 128 + n * 16); } }
#pragma unroll
                for (int mm = 0; mm < 2; ++mm) { const int m = mh * 2 + mm; const int r = rb + ai * 128 + m * 16; float* rowp = (r < TC ? z + (size_t)r * D : h + (size_t)(r - TC) * D) + cb;
#pragma unroll
                    for (int bj = 0; bj < 2; ++bj)
#pragma unroll
                        for (int n = 0; n < 2; ++n) ST16(rowp + bj * 128 + n * 16, o[mm][bj][n] + gg[bj][n] * acc[ai][bj][m][n]); }
                asm volatile("" ::: "memory"); }
    }
};
#endif
using EpiRes = EpiResT<false>; using EpiRes8 = EpiResT<true>;
struct EpiSwigluH8 {
    unsigned char* H;
    __device__ __forceinline__ void operator()(EPI_ARGS) const {
        const int rb = u.pm * 256 + wr * 64 + fr, c0 = u.pn * 128 + wc * 32 + 8 * fq;
#pragma unroll
        for (int ai = 0; ai < 2; ++ai)
#pragma unroll
            for (int m = 0; m < 4; ++m) { const int r = rb + ai * 128 + m * 16;
                f32x4 a0 = acc[ai][0][m][0], a1 = acc[ai][0][m][1]; const f32x4 b0 = acc[ai][1][m][0], b1 = acc[ai][1][m][1];
#pragma unroll
                for (int j = 0; j < 4; ++j) { a0[j] = a0[j] * fsigmoid(a0[j]) * b0[j]; a1[j] = a1[j] * fsigmoid(a1[j]) * b1[j]; }
                u32x2 w; w.x = pack4_fp8(a0[0], a0[1], a0[2], a0[3]); w.y = pack4_fp8(a1[0], a1[1], a1[2], a1[3]); *(u32x2*)(H + (size_t)r * DFF + c0) = w; }
    }
};
struct EpiSwiglu {
    bf16_t* H; int ld; int row0;
    __device__ __forceinline__ void operator()(EPI_ARGS) const {
        const int rb = u.pm * 256 + wr * 64 + fr - row0, c0 = u.pn * 128 + wc * 32 + 8 * fq;
#pragma unroll
        for (int ai = 0; ai < 2; ++ai)
#pragma unroll
            for (int m = 0; m < 4; ++m) { const int r = rb + ai * 128 + m * 16;
                f32x4 a0 = acc[ai][0][m][0], a1 = acc[ai][0][m][1]; const f32x4 b0 = acc[ai][1][m][0], b1 = acc[ai][1][m][1];
#pragma unroll
                for (int j = 0; j < 4; ++j) { a0[j] = a0[j] * fsigmoid(a0[j]) * b0[j]; a1[j] = a1[j] * fsigmoid(a1[j]) * b1[j]; }
                ST16(H + (size_t)r * ld + c0, pack8(a0, a1)); }
    }
};
struct EpiBf {
    bf16_t* O; int ld;
    __device__ __forceinline__ void operator()(EPI_ARGS) const {
        const int rb = u.pm * 256 + wr * 64 + fr, cb = u.pn * 256 + wc * 32 + 8 * fq;
#pragma unroll
        for (int ai = 0; ai < 2; ++ai)
#pragma unroll
            for (int m = 0; m < 4; ++m) { bf16_t* rowp = O + (size_t)(rb + ai * 128 + m * 16) * ld + cb;
#pragma unroll
                for (int bj = 0; bj < 2; ++bj) ST16(rowp + bj * 128, pack8(acc[ai][bj][m][0], acc[ai][bj][m][1])); }
    }
};
struct EpiBf8 {
    bf16_t* O;
    __device__ __forceinline__ void operator()(EPI_ARGS) const {
        const int rb = u.pm * 256 + wr * 64 + fr, cb = u.pn * 256 + wc * 32 + 8 * fq;
#pragma unroll
        for (int ai = 0; ai < 2; ++ai)
#pragma unroll
            for (int m = 0; m < 4; ++m) { bf16_t* rowp = O + (size_t)(rb + ai * 128 + m * 16) * D + cb;
#pragma unroll
                for (int bj = 0; bj < 2; ++bj) ST16(rowp + bj * 128, pack8(acc[ai][bj][m][0] * W8INV, acc[ai][bj][m][1] * W8INV)); }
    }
};

__device__ __forceinline__ float clamp_e4m3(float v) { return __builtin_amdgcn_fmed3f(v, -448.f, 448.f); }
struct EpiSwiglu8 {
    unsigned char* H; int row0;
    __device__ __forceinline__ void operator()(EPI_ARGS) const {
        const int rb = u.pm * 256 + wr * 64 + fr - row0, c0 = u.pn * 128 + wc * 32 + 8 * fq;
#pragma unroll
        for (int ai = 0; ai < 2; ++ai)
#pragma unroll
            for (int m = 0; m < 4; ++m) { const int r = rb + ai * 128 + m * 16;
                f32x4 a0 = acc[ai][0][m][0] * W8INV, a1 = acc[ai][0][m][1] * W8INV; const f32x4 b0 = acc[ai][1][m][0] * W8INV, b1 = acc[ai][1][m][1] * W8INV;
#pragma unroll
                for (int j = 0; j < 4; ++j) { a0[j] = a0[j] * fsigmoid(a0[j]) * b0[j]; a1[j] = a1[j] * fsigmoid(a1[j]) * b1[j]; }
                u32x2 w; w.x = pack4_fp8(a0[0], a0[1], a0[2], a0[3]); w.y = pack4_fp8(a1[0], a1[1], a1[2], a1[3]); *(u32x2*)(H + (size_t)r * DFE + c0) = w; }
    }
};
template <class E0, class E1> struct EpiMix {
    E0 e0; E1 e1;
    __device__ __forceinline__ void operator()(EPI_ARGS) const { if (u.kind == 0) e0(acc, u, wr, wc, fr, fq); else e1(acc, u, wr, wc, fr, fq); }
};

#ifdef RES16
typedef bf16_t res_t;
#else
typedef float res_t;
#endif
__device__ __forceinline__ f32x4 ld4(const float* p) { return *(const f32x4*)p; }
__device__ __forceinline__ f32x4 ld4(const bf16_t* p) { const u32x2 w = *(const u32x2*)p; return (f32x4){bflo(w.x), bfhi(w.x), bflo(w.y), bfhi(w.y)}; }
struct Args { const float* in[30]; float* out; unsigned char* ws; int ph_lo, ph_hi, mask, pad; };
enum { I_X, I_C, I_CTX, I_CCTX, I_WMOD, I_BMOD, I_N1G, I_N2G, I_WIN, I_WFOUR, I_ARE, I_AIM, I_LOGDT, I_BRE, I_BIM, I_CRE, I_CIM, I_SSMD, I_GLUA, I_GLUB, I_WOUT, I_FG, I_FU, I_FD, I_MR, I_MBR, I_MG, I_MU, I_MD, I_FINALG };

constexpr int TR_SCR = 64 * 72 * 2;
__device__ __forceinline__ void tr_item(const float* W, int ldw, int k0, int n0, bf16_t* WT, int ldk, int drow0, LAS unsigned char* scr, int lane) {
    const int c4 = (lane & 15) * 4, kr = 2 * (lane >> 4);
#pragma unroll
    for (int s = 0; s < 8; ++s) { const int kk = 8 * s + kr; const float* p = W + (size_t)(k0 + kk) * ldw + n0 + c4; const f32x4 r0 = *(const f32x4*)p, r1 = *(const f32x4*)(p + ldw);
#pragma unroll
        for (int q = 0; q < 4; ++q) *(LAS unsigned*)(scr + ((c4 + q) * 72 + kk) * 2) = cvt_pk_bf16(r0[q], r1[q]); }
    asm volatile("s_waitcnt lgkmcnt(0)" ::: "memory");
    const int c = lane & 7;
#pragma unroll
    for (int j = 0; j < 8; ++j) { const int n = (lane >> 3) + 8 * j; const u32x4 o = *(const LAS u32x4*)(scr + (n * 72 + 8 * c) * 2); *(u32x4*)(WT + (size_t)(drow0 + n) * ldk + k0 + 8 * c) = o; }
    asm volatile("s_waitcnt lgkmcnt(0)" ::: "memory");
}
__device__ __forceinline__ void tr_mat_item(const float* W, int K, int N, int ldw, int coff, bf16_t* WT, int roff, int mode, int it, LAS unsigned char* scr, int lane) {
    const int nblk = N / 64, kb = it / nblk, nb = it - kb * nblk, n0 = nb * 64;
    const int drow = mode == 0 ? roff + n0 : ((n0 >> 7) * 256 + (mode == 2 ? 128 : 0) + (n0 & 127));
    tr_item(W, ldw, kb * 64, coff + n0, WT, K, drow, scr, lane);
}

__device__ __forceinline__ void tr_item8(const float* W, int ldw, int k0, int n0, unsigned char* WT, int ldk, int drow0, float wsc, LAS unsigned char* scr, int lane) {
    const int c4 = (lane & 15) * 4, kr = 2 * (lane >> 4);
#pragma unroll
    for (int s = 0; s < 8; ++s) { const int kk = 8 * s + kr; const float* p = W + (size_t)(k0 + kk) * ldw + n0 + c4; const f32x4 r0 = *(const f32x4*)p, r1 = *(const f32x4*)(p + ldw);
#pragma unroll
        for (int q = 0; q < 4; ++q) *(LAS unsigned short*)(scr + (c4 + q) * 80 + kk) = (unsigned short)__builtin_amdgcn_cvt_pk_fp8_f32(__builtin_amdgcn_fmed3f(r0[q] * wsc, -448.f, 448.f), __builtin_amdgcn_fmed3f(r1[q] * wsc, -448.f, 448.f), 0u, false); }
    asm volatile("s_waitcnt lgkmcnt(0)" ::: "memory");
    const int c = lane & 3;
#pragma unroll
    for (int j = 0; j < 4; ++j) { const int n = (lane >> 2) + 16 * j; const u32x4 o = *(const LAS u32x4*)(scr + n * 80 + 16 * c); *(u32x4*)(WT + (size_t)(drow0 + n) * ldk + k0 + 16 * c) = o; }
    asm volatile("s_waitcnt lgkmcnt(0)" ::: "memory");
}
__device__ __forceinline__ void tr_mat_item8(const float* W, int K, int N, int ldw, unsigned char* WT, int mode, float wsc, int it, LAS unsigned char* scr, int lane, int coff = 0) {
    const int nblk = N / 64, kb = it / nblk, nb = it - kb * nblk, n0 = nb * 64;
    const int drow = mode == 0 ? n0 : ((n0 >> 7) * 256 + (mode == 2 ? 128 : 0) + (n0 & 127));
    tr_item8(W, ldw, kb * 64, coff + n0, WT, K, drow, wsc, scr, lane);
}

template <bool ROUTE, class ST>
__device__ __forceinline__ void norm_row(const ST* src, const float* g, const float* sh, const float* sc, bf16_t* dst, int lane, const float* wr, const float* br, int& e1o, int& e2o, float& w1o, const float* addp = nullptr, float* outp = nullptr, unsigned char* dst8 = nullptr, int addn = 0) {
    f32x4 v[4]; float ss = 0.f;
#pragma unroll
    for (int j = 0; j < 4; ++j) { v[j] = ld4(src + j * 256 + lane * 4); if (addp) v[j] += *(const f32x4*)(pos_ptr(addp, addn, j * 256) + lane * 4); if (outp) *(f32x4*)(outp + j * 256 + lane * 4) = v[j]; ss += v[j][0] * v[j][0] + v[j][1] * v[j][1] + v[j][2] * v[j][2] + v[j][3] * v[j][3]; }
    ss = wsum(ss, lane); const float rstd = rsqrtf(ss * (1.f / D) + EPS);
    float lg[8];
#pragma unroll
    for (int e = 0; e < 8; ++e) lg[e] = 0.f;
#pragma unroll
    for (int j = 0; j < 4; ++j) { const int k = j * 256 + lane * 4; const f32x4 gg = *(const f32x4*)(g + k), s1 = *(const f32x4*)(sc + k), s0 = *(const f32x4*)(sh + k);
        f32x4 a;
#pragma unroll
        for (int q = 0; q < 4; ++q) a[q] = v[j][q] * rstd * gg[q] * (1.f + s1[q]) + s0[q];
        if (ROUTE) *(unsigned*)((unsigned char*)dst + k) = pack4_fp8(a[0], a[1], a[2], a[3]);
        else { u32x2 o; o.x = cvt_pk_bf16(a[0], a[1]); o.y = cvt_pk_bf16(a[2], a[3]); *(u32x2*)(dst + k) = o; if (dst8) *(unsigned*)(dst8 + k) = pack4_fp8(a[0], a[1], a[2], a[3]); }
        if (ROUTE) {
#pragma unroll
            for (int q = 0; q < 4; ++q) { const f32x4 w0 = *(const f32x4*)(wr + (k + q) * 8), w1 = *(const f32x4*)(wr + (k + q) * 8 + 4);
#pragma unroll
                for (int e = 0; e < 4; ++e) { lg[e] += a[q] * w0[e]; lg[4 + e] += a[q] * w1[e]; } } } }
    if (ROUTE) {
#pragma unroll
        for (int e = 0; e < 8; ++e) lg[e] = wsum(lg[e], lane) + br[e];
        int e1 = 0; float v1 = lg[0];
#pragma unroll
        for (int e = 1; e < 8; ++e) if (lg[e] > v1) { v1 = lg[e]; e1 = e; }
        int e2 = -1; float v2 = -3.0e38f;
#pragma unroll
        for (int e = 0; e < 8; ++e) if (e != e1 && lg[e] > v2) { v2 = lg[e]; e2 = e; }
        e1o = e1; e2o = e2; w1o = 1.f / (1.f + expf(v2 - v1));
    }
}

#define NORM_ROW_P(SRC, ADDP, ADDN, DST, DST8) do { f32x4 v_[4]; float ss_ = 0.f; \
    _Pragma("unroll") for (int j_ = 0; j_ < 4; ++j_) { v_[j_] = ld4((SRC) + j_ * 256 + lane * 4); if ((ADDP) != nullptr) v_[j_] += *(const f32x4*)(pos_ptr((const float*)(ADDP), (ADDN), j_ * 256) + lane * 4); \
        ss_ += v_[j_][0] * v_[j_][0] + v_[j_][1] * v_[j_][1] + v_[j_][2] * v_[j_][2] + v_[j_][3] * v_[j_][3]; } \
    ss_ = wsum(ss_, lane); const float rstd_ = rsqrtf(ss_ * (1.f / D) + EPS); \
    _Pragma("unroll") for (int j_ = 0; j_ < 4; ++j_) { const int k_ = j_ * 256 + lane * 4; f32x4 a_; \
        _Pragma("unroll") for (int q_ = 0; q_ < 4; ++q_) a_[q_] = v_[j_][q_] * rstd_ * pg[j_][q_] * (1.f + pc[j_][q_]) + ph[j_][q_]; \
        { u32x2 o_; o_.x = cvt_pk_bf16(a_[0], a_[1]); o_.y = cvt_pk_bf16(a_[2], a_[3]); *(u32x2*)((DST) + k_) = o_; } \
        if ((DST8) != nullptr) *(unsigned*)((unsigned char*)(DST8) + k_) = pack4_fp8(a_[0], a_[1], a_[2], a_[3]); } } while (0)
#define NP_LOAD_G(gp) _Pragma("unroll") for (int j_ = 0; j_ < 4; ++j_) pg[j_] = *(const f32x4*)((gp) + j_ * 256 + lane * 4)
#define NP_LOAD_C(mcp) _Pragma("unroll") for (int j_ = 0; j_ < 4; ++j_) { pc[j_] = *(const f32x4*)((mcp) + 1024 + j_ * 256 + lane * 4); ph[j_] = *(const f32x4*)((mcp) + j_ * 256 + lane * 4); }
#define NP_ARGS pg[0], pg[1], pg[2], pg[3], pc[0], pc[1], pc[2], pc[3], ph[0], ph[1], ph[2], ph[3]
__global__ void __launch_bounds__(512, 2) fwd(Args args) {
    extern __shared__ __attribute__((aligned(16))) unsigned char lds_raw[];
    LAS unsigned char* lds = (LAS unsigned char*)lds_raw;
    volatile LAS unsigned* MISC = (volatile LAS unsigned*)(lds + MISC_OFF);
    const unsigned g_wave_s = (unsigned)__builtin_amdgcn_readfirstlane((int)(threadIdx.x >> 6));
    const int G = gridDim.x, bx = blockIdx.x, NGW = G * 8;
#define PHASE_IDS int tid = TIDX; asm volatile("" : "+v"(tid)); const int lane = tid & 63, wave = __builtin_amdgcn_readfirstlane(tid >> 6), gw = bx * 8 + wave; (void)lane; (void)gw;
    unsigned char* ws = args.ws;
    unsigned* ctl = (unsigned*)(ws + WS_CTL);
    const int lo = args.ph_lo, hi = args.ph_hi, mask = args.mask;
    { PHASE_IDS for (int u = tid; u < (LDS_BYTES - STAGE_BYTES) / 4; u += 512) ((LAS unsigned*)(lds + STAGE_BYTES))[u] = 0u; }
    __syncthreads();
    { PHASE_IDS if (args.ph_lo == 0) for (int u = tid; u < 2048; u += 512) ((LAS float*)(lds + COSTAB_OFF))[u] = cospif((float)u * (2.0f / 2048.f)); }
    __syncthreads();
    if (hi - lo > 1) (void)xcd_barrier_post(ctl + CW_BAR, MISC + 8, g_wave_s);
#ifndef ONLYPH
#define ONLYPH -1
#endif
#define PHON(k) (ONLYPH < 0 || ONLYPH == (k))
#define IN(k) (lo <= (k) && (k) < hi)
#define MKBAR XcdBarrier _b; _b.bar = (unsigned*)(ws + WS_CTL) + CW_BAR; _b.x = xb_xcc_id(); _b.st = (volatile LAS unsigned*)(lds + MISC_OFF) + 8;
#ifdef DOUBLE_BAR
#define SEAM(k) do { if (lo <= (k) && (k) + 1 < hi) { MKBAR xcd_barrier(_b, g_wave_s); xcd_barrier(_b, g_wave_s); } STAMP_E(k); } while (0)
#else
#define SEAM(k) do { if (lo <= (k) && (k) + 1 < hi) { MKBAR xcd_barrier(_b, g_wave_s); } STAMP_E(k); } while (0)
#endif
#ifdef PROBE_A
#define STAMP_B(k) do { if (PROBE_A == (k) && bx == 0 && TIDX == 0) { ctl[CW_NT + 64] = (unsigned)wall_clock64(); ctl[CW_NT + 66] = (unsigned)clock64(); } } while (0)
#define STAMP_E(k) do { if (PROBE_B == (k) && bx == 0 && TIDX == 0) { ctl[CW_NT + 65] = (unsigned)wall_clock64(); ctl[CW_NT + 67] = (unsigned)clock64(); } } while (0)
#else
#define STAMP_B(k) do { } while (0)
#define STAMP_E(k) do { } while (0)
#endif

#define h (args.out)
#define zs ((float*)(ws + WS_Z))
#ifdef RES16
#define HS ((res_t*)(ws + WS_H16))
#define RESPERM 1
#else
#define HS ((res_t*)(args.out))
#define RESPERM 0
#endif
#define ZS ((res_t*)(ws + WS_Z))
#define mod ((float*)(ws + WS_MOD))
#define XA ((bf16_t*)(ws + WS_XA))
#define YS ((bf16_t*)(ws + WS_YS))
#define UX ((bf16_t*)(ws + WS_UX))
#define GT ((bf16_t*)(ws + WS_GT))
#define VL ((bf16_t*)(ws + WS_VT2L))
#define VC ((bf16_t*)(ws + WS_VT2C))
#define Sst ((float*)(ws + WS_S))
#define TM ((bf16_t*)(ws + WS_TM))
#define HID ((bf16_t*)(ws + WS_HID))
#define cnt ((int*)(ctl + CW_CNT))
#define tok_e ((int*)(ws + WS_TOKE))
#define tok_w ((float*)(ws + WS_TOKW))
#define tok_pos ((int*)(ws + WS_TOKPOS))
#define tok_row ((int*)(ws + WS_TOKROW))
#define tile_e ((int*)(ws + WS_TILEE))

    STAMP_B(0);
    if (IN(0)) { PHASE_IDS
#ifdef DYNPRO
        for (;;) { volatile LAS unsigned* tk = (volatile LAS unsigned*)(lds + MISC_OFF) + 32; __syncthreads(); if (tid == 0) tk[0] = atomicAdd(ctl + CW_PQ, 1u); __syncthreads();
            const int qi = (int)tk[0]; if (qi >= 352) break;
#ifdef PRO_ORDER2
            const int hit = qi < 128 ? qi : (qi < 224 ? 256 + (qi - 128) : 128 + (qi - 224));
#else
            const int hit = qi < 96 ? 256 + qi : qi - 96;
#endif
#else
        for (int hit = bx; hit < 352; hit += G) {
#endif
        if (hit < 128) {
            const int l = hit >> 6, g = (hit >> 1) & 31, dir = hit & 1; const int gd = (l * 2 + dir) * 32 + g;
            LAS float* POWr = (LAS float*)(lds); LAS float* POWi = POWr + 64 * 17; LAS float* Bbr = POWi + 64 * 17; LAS float* Bbi = Bbr + 1024; LAS float* Cr = Bbi + 1024; LAS float* Ci = Cr + 1024; LAS float* Kt = Ci + 1024;
            const float dt = expf(args.in[I_LOGDT][gd]);
            for (int o = tid; o < 64 * 17; o += 512) { const int p = o / 17, e = o - p * 17; const float lr = args.in[I_ARE][gd * 64 + p] * dt, li = args.in[I_AIM][gd * 64 + p] * dt; const float mg = expf(lr * e); POWr[o] = mg * cosf(li * e); POWi[o] = mg * sinf(li * e); }
            __syncthreads();
            for (int o = tid; o < 1024; o += 512) { const int p = o >> 4, hh = o & 15; const int gp = gd * 64 + p; const float ar = args.in[I_ARE][gp], ai = args.in[I_AIM][gp];
                const float lbr = POWr[p * 17 + 1], lbi = POWi[p * 17 + 1], nr = lbr - 1.f, ni = lbi, den = ar * ar + ai * ai, qr = (nr * ar + ni * ai) / den, qi = (ni * ar - nr * ai) / den;
                const float x0 = args.in[I_BRE][(size_t)gp * 16 + hh], x1 = args.in[I_BIM][(size_t)gp * 16 + hh]; Bbr[o] = qr * x0 - qi * x1; Bbi[o] = qr * x1 + qi * x0;
                const int h2 = o >> 6, p2 = o & 63; const size_t ci = ((size_t)gd * 16 + h2) * 64 + p2; Cr[o] = args.in[I_CRE][ci]; Ci[o] = args.in[I_CIM][ci]; }
            if (tid < 64) { float* lamq = (float*)(ws + WS_LAMQ) + (size_t)(gd * 64 + tid) * 2; lamq[0] = POWr[tid * 17 + 16]; lamq[1] = POWi[tid * 17 + 16]; }
            __syncthreads();
            { const int hh = (tid >> 4) & 15, h2 = tid & 15, t0 = tid >> 8; float sacc[8];
#pragma unroll
              for (int i = 0; i < 8; ++i) sacc[i] = 0.f;
#pragma unroll 2
              for (int p = 0; p < 64; ++p) { const float br_ = Bbr[p * 16 + h2], bi_ = Bbi[p * 16 + h2], cr_ = Cr[hh * 64 + p], ci_ = Ci[hh * 64 + p];
                  const float ur = cr_ * br_ - ci_ * bi_, ui = cr_ * bi_ + ci_ * br_;
#pragma unroll
                  for (int i = 0; i < 8; ++i) { const float pr = POWr[p * 17 + t0 + 2 * i], pi = POWi[p * 17 + t0 + 2 * i]; sacc[i] += pr * ur - pi * ui; } }
#pragma unroll
              for (int i = 0; i < 8; ++i) ((float*)(ws + WS_S))[(size_t)gd * 4096 + tid + 512 * i] = sacc[i]; }
            bf16_t* TG = (bf16_t*)(ws + WS_S5TG + (size_t)l * S5_LSTRIDE) + (size_t)g * 256 * 512; bf16_t* EE = (bf16_t*)(ws + WS_S5E + (size_t)l * S5_LSTRIDE) + (size_t)g * 256 * 256;
            for (int o2 = tid; o2 < 256 * 64; o2 += 512) { const int row = o2 >> 6, kk0 = (o2 & 63) * 2, t = row >> 4, hh = row & 15, e = dir == 0 ? t + 1 : 16 - t; float v2[2];
#pragma unroll
                for (int e2 = 0; e2 < 2; ++e2) { const int kk = kk0 + e2, p = kk >> 1, ri = kk & 1; const float cr = Cr[hh * 64 + p], ci = Ci[hh * 64 + p], pr = POWr[p * 17 + e], pi = POWi[p * 17 + e];
                    v2[e2] = ri == 0 ? (cr * pr - ci * pi) : -(cr * pi + ci * pr); }
                *(unsigned*)(TG + (size_t)row * 512 + 256 + dir * 128 + kk0) = cvt_pk_bf16(v2[0], v2[1]); }
            for (int o2 = tid; o2 < 128 * 128; o2 += 512) { const int rr = o2 >> 7, k0 = (o2 & 127) * 2, p = rr >> 1, ri = rr & 1; float v2[2];
#pragma unroll
                for (int e2 = 0; e2 < 2; ++e2) { const int k = k0 + e2, sx = k >> 4, h2 = k & 15, e = dir == 0 ? 15 - sx : sx;
                    const float pr = POWr[p * 17 + e], pi = POWi[p * 17 + e], br_ = Bbr[p * 16 + h2], bi_ = Bbi[p * 16 + h2];
                    v2[e2] = ri == 0 ? (pr * br_ - pi * bi_) : (pr * bi_ + pi * br_); }
                *(unsigned*)(EE + (size_t)(dir * 128 + rr) * 256 + k0) = cvt_pk_bf16(v2[0], v2[1]); }
            __syncthreads();
        } else if (hit < 256) {
            const int it = hit - 128, l = it >> 6, g = (it >> 4) & 3, kb = it & 15;
            LAS float* wT = (LAS float*)(lds);
            LAS float* ct = wT + 128 * 65;
            if (tid < 256) ct[tid] = tid < 128 ? cospif((float)tid / 64.f) : sinpif((float)(tid - 128) / 64.f);
            { const float* wsrc = args.in[I_WIN] + (size_t)l * D * INC + (size_t)(kb * 64) * INC + g * 128;
              for (int o = tid; o < 64 * 32; o += 512) { const int kk = o >> 5, c4 = (o & 31) * 4; const f32x4 wv = *(const f32x4*)(wsrc + (size_t)kk * INC + c4);
#pragma unroll
                  for (int q = 0; q < 4; ++q) wT[(c4 + q) * 65 + kk] = wv[q]; } }
            __syncthreads();
            { const int kk = tid & 63, jg = tid >> 6; bf16_t* dstb = (bf16_t*)(ws + WS_MIXW + (size_t)l * MIXW_LSTRIDE);
#pragma unroll 1
              for (int jj = 0; jj < 16; jj += 4) {
                  int ty[4], kp[4], row[4]; float sa[4];
#pragma unroll
                  for (int q = 0; q < 4; ++q) { const int o = jg * 16 + jj + q; ty[q] = (o > 64 ? 1 : 0) * 128; kp[q] = o <= 64 ? o : o - 64; row[q] = o < 64 ? g * 64 + o : 256 + g * 64 + (o - 64); sa[q] = 0.f; }
#pragma unroll 4
                  for (int c = 0; c < 128; ++c) { const float wv = wT[c * 65 + kk];
#pragma unroll
                      for (int q = 0; q < 4; ++q) sa[q] += wv * ct[ty[q] + ((c * kp[q]) & 127)]; }
#pragma unroll
                  for (int q = 0; q < 4; ++q) dstb[(size_t)row[q] * 1024 + kb * 64 + kk] = f2bf(sa[q]); } }
            __syncthreads();
        } else {
            const int it = hit - 256, l = it / 48, cb = it % 48; LAS float* sl = (LAS float*)(lds); LAS float* part = sl + 17 * 1024;
            for (int o = tid; o < 17 * 1024; o += 512) { const int r = o >> 10, k = o & 1023; const float v = r < 16 ? args.in[I_C][r * D + k] : args.in[I_CCTX][k]; sl[o] = v / (1.f + expf(-v)); }
            __syncthreads();
            const int col = cb * 128 + (tid & 127), kq = tid >> 7; const float* w = args.in[I_WMOD] + (size_t)l * D * 6144 + col;
            float a[17];
#pragma unroll
            for (int r = 0; r < 17; ++r) a[r] = 0.f;
#pragma unroll 4
            for (int k = kq * 256; k < kq * 256 + 256; k += 8) { float wv[8];
#pragma unroll
                for (int q = 0; q < 8; ++q) wv[q] = w[(size_t)(k + q) * 6144];
#pragma unroll
                for (int r = 0; r < 17; ++r) { const f32x4 s0 = *(const LAS f32x4*)(sl + r * 1024 + k), s1 = *(const LAS f32x4*)(sl + r * 1024 + k + 4);
                    a[r] += s0[0] * wv[0] + s0[1] * wv[1] + s0[2] * wv[2] + s0[3] * wv[3] + s1[0] * wv[4] + s1[1] * wv[5] + s1[2] * wv[6] + s1[3] * wv[7]; } }
#pragma unroll
            for (int r = 0; r < 17; ++r) part[(kq * 17 + r) * 128 + (tid & 127)] = a[r];
            __syncthreads();
            for (int o = tid; o < 17 * 128; o += 512) { const int r = o >> 7, c = o & 127; const float s = part[(0 * 17 + r) * 128 + c] + part[(1 * 17 + r) * 128 + c] + part[(2 * 17 + r) * 128 + c] + part[(3 * 17 + r) * 128 + c];
                mod[((size_t)l * 17 + r) * 6144 + cb * 128 + c] = s + args.in[I_BMOD][l * 6144 + cb * 128 + c]; }
            __syncthreads();
        } }
        {
            const int lb = bx, LG = G, lgw = lb * 8 + wave, LNGW = LG * 8;
            LAS unsigned char* scr = lds + wave * TR_SCR;
            { constexpr int I_SG = 16 * 40, I_4 = 8 * 16, I_GL = 8 * 16, I_O = 16 * 16, PERL = I_SG + I_4 + 2 * I_GL + I_O, I_FGU = 16 * 44, I_FDN = 44 * 16, NIT = 2 * PERL + 2 * I_FGU + I_FDN;
#ifdef DYNPRO
              static_assert(NIT % 16 == 0, "light items split evenly over the sixteen queues");
              unsigned* const qw = ctl + CW_PQ + 16 + 64 * (bx & 15); const int qsel = bx & 15;
              unsigned nt = 0u; if (lane == 0) nt = atomicAdd(qw, 1u);
              for (;;) { const int tq_ = __builtin_amdgcn_readfirstlane((int)nt); if (tq_ >= NIT / 16) break; if (lane == 0) nt = atomicAdd(qw, 1u);
                  const int it = tq_ * 16 + qsel;
                  int r = it;
#else
              for (int it = lgw; it < NIT; it += LNGW) { int r = it;
#endif
                  if (r < 2 * PERL) { const int l = r / PERL; r -= l * PERL; unsigned char* mw = ws + WS_MIXW + (size_t)l * MIXW_LSTRIDE;
                      if (r < I_SG) {
                          if (r < 16 * 8) tr_mat_item(args.in[I_WIN] + (size_t)l * D * INC, 1024, 512, INC, 512, (bf16_t*)(mw + 2 * MiB), 0, 0, r, scr, lane);
                          else tr_mat_item8(args.in[I_WIN] + (size_t)l * D * INC, 1024, 2048, INC, mw + 3 * MiB, 0, W8SC, r - 16 * 8, scr, lane, 1024);
                          continue; } r -= I_SG;
                      if (r < I_4) { continue; } r -= I_4;
                      if (r < I_GL) { tr_mat_item(args.in[I_GLUA] + (size_t)l * 512 * D, 512, 1024, D, 0, (bf16_t*)(mw + 8 * MiB), 0, 1, r, scr, lane); continue; } r -= I_GL;
                      if (r < I_GL) { tr_mat_item(args.in[I_GLUB] + (size_t)l * 512 * D, 512, 1024, D, 0, (bf16_t*)(mw + 8 * MiB), 0, 2, r, scr, lane); continue; } r -= I_GL;
                      tr_mat_item(args.in[I_WOUT] + (size_t)l * D * D, 1024, 1024, D, 0, (bf16_t*)(mw + 10 * MiB), 0, 0, r, scr, lane); continue; }
                  r -= 2 * PERL;
                  if (r < I_FGU) { tr_mat_item(args.in[I_FG], 1024, DFF, DFF, 0, (bf16_t*)(ws + WS_WGU), 0, 1, r, scr, lane); continue; } r -= I_FGU;
                  if (r < I_FGU) { tr_mat_item(args.in[I_FU], 1024, DFF, DFF, 0, (bf16_t*)(ws + WS_WGU), 0, 2, r, scr, lane); continue; } r -= I_FGU;
                  tr_mat_item8(args.in[I_FD], DFF, 1024, D, ws + WS_WDN, 0, W8SC, r, scr, lane); } }
            { int tq = TIDX; asm volatile("" : "+v"(tq));
            for (int o = lb * 512 + tq; o < 2 * 1024 * 256; o += LG * 512) { const int l = o >> 18, col = (o >> 8) & 1023, i0 = (o & 255) * 2; const float* w4 = args.in[I_WFOUR] + (size_t)l * 512 * D + col; float v2[2];
#pragma unroll
                for (int e = 0; e < 2; ++e) { const int i = i0 + e, g = (i >> 6) & 3, sx = i & 63; float val;
                    if (i < 256) { val = w4[(size_t)(g * 128 + sx) * D]; if (sx > 0) val += w4[(size_t)(g * 128 + 128 - sx) * D]; }
                    else { if (sx == 0) val = w4[(size_t)(g * 128 + 64) * D]; else val = w4[(size_t)(g * 128 + sx) * D] - w4[(size_t)(g * 128 + 128 - sx) * D]; }
                    v2[e] = val; }
                *(unsigned*)((bf16_t*)(ws + WS_MIXW + (size_t)l * MIXW_LSTRIDE + 7 * MiB) + (size_t)col * 512 + i0) = cvt_pk_bf16(v2[0], v2[1]); } }
            { bf16_t* DL = (bf16_t*)(ws + WS_DFTL); bf16_t* DC = (bf16_t*)(ws + WS_DFTC); int tq = TIDX; asm volatile("" : "+v"(tq));
              for (int o = lb * 512 + tq; o < 2048 * 256 + 256 * 32; o += LG * 512) { const bool big = o < 2048 * 256; const int oo = big ? o : o - 2048 * 256; const int LL = big ? 2048 : 256, per = LL / 8, Lh = LL / 2;
                  const int n = oo / per, k0 = (oo - n * per) * 8; unsigned w[4];
#pragma unroll
                  for (int q = 0; q < 4; ++q) { float v2[2];
#pragma unroll
                      for (int e = 0; e < 2; ++e) { const int k = k0 + 2 * q + e; const bool sn = k > Lh; const int kk = k < Lh ? k : (k == Lh ? Lh : k - Lh); const int idx = (n * kk) & (LL - 1);
                          v2[e] = ((const LAS float*)(lds + COSTAB_OFF))[(idx * (big ? 1 : 8) + (sn ? 512 : 0)) & 2047]; }
                      w[q] = cvt_pk_bf16(v2[0], v2[1]); }
                  u32x4 o4; o4.x = w[0]; o4.y = w[1]; o4.z = w[2]; o4.w = w[3]; *(u32x4*)((big ? DL : DC) + (size_t)n * LL + k0) = o4; } }
            { float* POS = (float*)(ws + WS_POS); int tq = TIDX; asm volatile("" : "+v"(tq));
              for (int o = lb * 512 + tq; o < 96 * 128; o += LG * 512) { const int row = o >> 7, c4 = (o & 127) * 4; const float base = row < 32 ? (float)row : (float)(row - 32); f32x4 pv;
#pragma unroll
                  for (int e = 0; e < 4; ++e) { const float omega = 1.0f / powf(10000.f, (float)((c4 + e) & 255) / 256.f); const float ang = base * omega; pv[e] = (c4 >= 256) ? cosf(ang) : sinf(ang); }
                  *(f32x4*)(POS + (size_t)row * 512 + c4) = pv; } }
        }
    }
    SEAM(0);

    for (int l = 0; l < 2; ++l) {
        const int pb = l == 0 ? 1 : PH_L1; const float* modl = mod + (size_t)l * 17 * 6144; const bool need_ctx = (l == 0);
        unsigned char* mw = ws + WS_MIXW + (size_t)l * MIXW_LSTRIDE;
        const int tile0 = need_ctx ? 0 : 16, ntile = 144 - tile0;
        const int d2a = (need_ctx && G == 256) ? 88 : ntile;
        STAMP_B(pb + 0); if (IN(pb + 0)) { PHASE_IDS const float* g1 = args.in[I_N1G] + l * D;
            if (l == 0) {
                const float* KG = (const float*)(ws + WS_S);
                for (int it = bx; it < 256; it += G) { const int tl = it >> 7, g = (it >> 2) & 31, qq = it & 3; const float* k0p = KG + (size_t)((tl * 2 + 0) * 32 + g) * 4096; const float* k1p = KG + (size_t)((tl * 2 + 1) * 32 + g) * 4096;
                    LAS float* kl = (LAS float*)lds;
                    for (int o = tid; o < 2048; o += 512) { const int hf = o >> 10, q4 = (o & 1023) * 4; *(LAS f32x4*)(kl + hf * 4096 + q4) = *(const f32x4*)((hf ? k1p : k0p) + q4); }
                    __syncthreads();
                    bf16_t* TG = (bf16_t*)(ws + WS_S5TG + (size_t)tl * S5_LSTRIDE) + (size_t)g * 256 * 512; const float* dsk = args.in[I_SSMD] + tl * 512 + g * 16;
                    for (int o2 = tid; o2 < 64 * 128; o2 += 512) { const int row = qq * 64 + (o2 >> 7), k0 = (o2 & 127) * 2, t = row >> 4, hh = row & 15; float v2[2];
#pragma unroll
                        for (int e2 = 0; e2 < 2; ++e2) { const int k = k0 + e2, sx = k >> 4, h2 = k & 15; float val = 0.f; if (sx <= t) val += kl[((t - sx) * 16 + hh) * 16 + h2]; if (sx >= t) val += kl[4096 + ((sx - t) * 16 + hh) * 16 + h2]; if (sx == t && hh == h2) val += dsk[hh]; v2[e2] = val; }
                        *(unsigned*)(TG + (size_t)row * 512 + k0) = cvt_pk_bf16(v2[0], v2[1]); }
                    __syncthreads(); } }
            if (l == 0) {
                const float* POS = (const float*)(ws + WS_POS);
                if ((TT % NGW) == 0) { const int rpw = TT / NGW, r0 = gw * rpw, r1 = r0 + rpw; f32x4 pg[4], pc[4], ph[4]; NP_LOAD_G(g1);
                    for (int rs = r0; rs < r1;) { const int c = rs < TC ? 16 : (rs - TC) >> 11; int re = rs < TC ? TC : TC + (c + 1) * 2048; re = re < r1 ? re : r1; NP_LOAD_C(modl + (size_t)c * 6144);
                        if (rs < TC) { for (int r = rs; r < re; ++r) NORM_ROW_P(args.in[I_CTX] + (size_t)r * D, (const float*)nullptr, 0, XA + (size_t)r * D, ws + WS_XA8 + (size_t)r * D); }
                        else { for (int r = rs; r < re; ++r) NORM_ROW_P(args.in[I_X] + (size_t)(r - TC) * D, POS, (r - TC) & (L - 1), XA + (size_t)r * D, ws + WS_XA8 + (size_t)r * D); }
                        rs = re; }
                } else
                for (int r = gw; r < TT; r += NGW) { const float* mc = modl + (size_t)(r < TC ? 16 : (r - TC) >> 11) * 6144; int e1, e2; float w1;
                    if (r < TC) norm_row<false>(args.in[I_CTX] + (size_t)r * D, g1, mc, mc + 1024, XA + (size_t)r * D, lane, nullptr, nullptr, e1, e2, w1, nullptr, nullptr, ws + WS_XA8 + (size_t)r * D);
                    else norm_row<false>(args.in[I_X] + (size_t)(r - TC) * D, g1, mc, mc + 1024, XA + (size_t)r * D, lane, nullptr, nullptr, e1, e2, w1, POS, nullptr, ws + WS_XA8 + (size_t)r * D, (r - TC) & (L - 1)); }
            } else if (G >= 64 && (mask & F_INPROJ)) {
                if (bx < 32) { JobSched<1> S; S.j[0] = mkjob(XA, mw + 2 * MiB, 0, 0, 2048, 2048, 16, 16, 2, 1, 1, 0, 0, 0); S.init(32, bx); Unit u0; (void)S.next(0, u0);
                    asm volatile("s_waitcnt vmcnt(0)" ::: "memory"); __syncthreads();
                    EpiInproj E{UX, GT, VL, VC}; gemm_phase_<EpiInproj, JobSched<1>, false>(lds, S, E, g_wave_s);
                } else { const int lgw = (bx - 32) * 8 + wave, LNGW = (G - 32) * 8;
                    const int ch = (TL + LNGW - 1) / LNGW, r0 = TC + lgw * ch; int r1 = r0 + ch; r1 = r1 < TT ? r1 : TT; f32x4 pg[4], pc[4], ph[4]; NP_LOAD_G(g1);
                    for (int rs = r0; rs < r1;) { const int c = (rs - TC) >> 11; int re = TC + (c + 1) * 2048; re = re < r1 ? re : r1; NP_LOAD_C(modl + (size_t)c * 6144);
                        for (int r = rs; r < re; ++r) NORM_ROW_P(HS + (size_t)(r - TC) * D, (const float*)nullptr, 0, XA + (size_t)r * D, ws + WS_XA8 + (size_t)r * D);
                        rs = re; } }
            } else
            for (int r = gw; r < TT; r += NGW) { const res_t* src = r < TC ? ZS + (size_t)r * D : HS + (size_t)(r - TC) * D; const float* mc = modl + (size_t)(r < TC ? 16 : (r - TC) >> 11) * 6144; int e1, e2; float w1;
                norm_row<false>(src, g1, mc, mc + 1024, XA + (size_t)r * D, lane, nullptr, nullptr, e1, e2, w1, nullptr, nullptr, ws + WS_XA8 + (size_t)r * D); } }
        SEAM(pb + 0);
        STAMP_B(pb + 1); if (PHON(1) && IN(pb + 1)) { JobSched<4> S;
            S.j[0] = mkjob(XA, mw + 2 * MiB, 0, 0, 2048, 2048, 16, ntile, 2, 1, 1, 0, tile0, 0);
            S.j[1] = mkjob(XA, mw + 2 * MiB, 0, 0, 2048, 2048, 16, (need_ctx || G >= 64) ? 0 : 16, 2, 1, 1, 0, 0, 0);
            S.j[2] = mkjob(mw, XA + (size_t)TC * D, 0, (size_t)L * 2048, 2048, 2048, 16, 2, 8, NB, 1, 1, 0, 0); S.j[2].mirL = L;
            S.j[3] = mkjob(mw, XA, 0, (size_t)LC * 2048, 2048, 2048, 16, 2, 1, need_ctx ? NB : 0, 1, 2, 0, 0); S.j[3].mirL = LC;
            S.init(G, bx); S.dry = (mask & 0x8000) ? 1 : 0; EpiInproj E{UX, GT, VL, VC}; gemm_phase_<EpiInproj, JobSched<4>, true>(lds, S, E, g_wave_s);
#pragma unroll 1
            for (int part = 0; part < 2; ++part) { const bool bal = need_ctx && G == 256; if (part == 1 && (!bal || bx < 64)) break;
              JobSched<1> S8; S8.j[0] = mkjob(ws + WS_XA8, mw + 3 * MiB, 0, 0, 1024, 1024, 8, bal ? (part == 0 ? 96 : 48) : ntile, 8, 1, 1, 0, bal ? part * 96 : tile0, 0);
              S8.init((bal && part == 1) ? 192 : G, bal ? (part == 1 ? bx - 64 : bx) : G - 1 - bx); S8.dry = (mask & 0x8000) ? 1 : 0;
              EpiGate8 E8{(unsigned char*)GT}; gemm_phase_<EpiGate8, JobSched<1>, false, true>(lds, S8, E8, g_wave_s); } }
        SEAM(pb + 1);
        STAMP_B(pb + 2); if (PHON(2) && IN(pb + 2)) {
            const Job jc = mkjob(ws + WS_DFTC, VC, 0, (size_t)512 * 256 * 2, 512, 512, 4, 1, 2, ((mask & F_FOUR) && need_ctx) ? NB : 0, 1, 1, 0, 0);
            const Job jst = mkjob(UX, ws + WS_S5E + (size_t)l * S5_LSTRIDE, (size_t)CHR * 512 * 2, (size_t)256 * 256 * 2, 1024, 512, 4, 9, 1, (mask & F_S5) ? 32 : 0, 1, 2, 0, 0);
            const EpiP3 E{YS, Sst, 1.0f / sqrtf((float)L * 128.f), 1.0f / sqrtf((float)LC * 128.f)};
            if (G == 256 && (mask & F_FOUR)) { P3Sched S;
                S.jq = mkjob(ws + WS_DFTL, VL, 0, (size_t)512 * 2048 * 2, 4096, 4096, 32, 8, 1, NB, 1, 0, 0, 1); S.jq.order = 1;
                S.jp = mkjob(ws + WS_DFTL, VL, 0, (size_t)512 * 2048 * 2, 4096, 4096, 18, 8, 1, NB, 1, 0, 0, 0); S.jp.order = 1;
                S.js0 = jc; S.js1 = jst; S.init(G, bx); S.dry = (mask & 0x8000) ? 1 : 0; gemm_phase_(lds, S, E, g_wave_s);
            } else { JobSched<3> S;
                S.j[0] = mkjob(ws + WS_DFTL, VL, 0, (size_t)512 * 2048 * 2, 4096, 4096, 32, 8, 2, (mask & F_FOUR) ? NB : 0, 1, 0, 0, 0); S.j[0].order = 1;
                S.j[1] = jc; S.j[2] = jst; S.init(G, bx); S.dry = (mask & 0x8000) ? 1 : 0; gemm_phase_(lds, S, E, g_wave_s); } }
        SEAM(pb + 2);
        STAMP_B(pb + 3); if (IN(pb + 3) && (mask & F_S5)) { PHASE_IDS const int id = (G >= 256) ? ((tid < 256) ? bx * 256 + tid : 65536) : bx * 512 + tid;
#ifdef REP_CARRY
#pragma unroll 1
            for (int rep = 0; rep < REP_CARRY; ++rep)
#endif
            if (id < 65536) { const int p = id & 63, dir = (id >> 6) & 1, g = (id >> 7) & 31, b = id >> 12;
                const float* lq = (const float*)(ws + WS_LAMQ) + (size_t)(((l * 2 + dir) * 32 + g) * 64 + p) * 2; const float qr = lq[0], qi = lq[1];
                const bf16_t* __restrict__ Sp = (const bf16_t*)Sst + (size_t)g * CHR * 256 + dir * 128 + p * 2; bf16_t* __restrict__ Xp = UX + (size_t)g * CHR * 512 + 256 + dir * 128 + p * 2;
                float xr = 0.f, xi = 0.f;
                for (int k0 = 0; k0 < 144; k0 += 24) {
                    f32x2 sv[24];
#pragma unroll
                    for (int q = 0; q < 24; ++q) { const int k = k0 + q; const int r = dir == 0 ? (k < 16 ? b * 16 + k : 256 + b * 128 + (k - 16)) : (k < 16 ? b * 16 + 15 - k : 256 + b * 128 + 127 - (k - 16)); const unsigned w = *(const unsigned*)(Sp + (size_t)r * 256); sv[q] = (f32x2){bflo(w), bfhi(w)}; }
#pragma unroll
                    for (int q = 0; q < 24; ++q) { const int k = k0 + q; const int r = dir == 0 ? (k < 16 ? b * 16 + k : 256 + b * 128 + (k - 16)) : (k < 16 ? b * 16 + 15 - k : 256 + b * 128 + 127 - (k - 16));
                        *(unsigned*)(Xp + (size_t)r * 512) = cvt_pk_bf16(xr, xi);
                        const float nr = qr * xr - qi * xi + sv[q][0], ni = qr * xi + qi * xr + sv[q][1]; xr = nr; xi = ni; } } } }
        if (PHON(4) && IN(pb + 3) && (mask & F_GLU)) {
            JobSched<1> S; S.j[0] = mkjob(YS, mw + 7 * MiB, 0, 0, 2048, 1024, 8, d2a, 4, 1, 1, 1, tile0, 0);
            S.init(G, bx); S.dry = (mask & 0x8000) ? 1 : 0; EpiP5 E{YS, GT, TM}; gemm_phase_(lds, S, E, g_wave_s); }
        SEAM(pb + 3);
        STAMP_B(pb + 4); if (PHON(4) && IN(pb + 4)) { JobSched<2> S;
            S.j[0] = mkjob(UX, ws + WS_S5TG + (size_t)l * S5_LSTRIDE, (size_t)CHR * 512 * 2, (size_t)256 * 512 * 2, 1024, 1024, 8, need_ctx ? 9 : 8, 1, (mask & F_S5) ? 32 : 0, 1, 0, need_ctx ? 0 : 1, 0);
            S.j[1] = mkjob(YS, mw + 7 * MiB, 0, 0, 2048, 1024, 8, ntile - d2a, 4, (ntile - d2a) > 0 ? 1 : 0, 1, 1, tile0 + d2a, 0);
            S.init(G, bx); S.dry = (mask & 0x8000) ? 1 : 0; EpiP5 E{YS, GT, TM}; gemm_phase_(lds, S, E, g_wave_s); }
        SEAM(pb + 4);
        STAMP_B(pb + 5); if (PHON(5) && IN(pb + 5)) {
#pragma unroll 1
            for (int part = 0; part < 2; ++part) { const bool bal = need_ctx && G == 256; if (part == 1 && (!bal || bx < 64)) break;
                JobSched<1> S; S.j[0] = mkjob(YS + 512, mw + 8 * MiB, 0, 0, 2048, 1024, 8, bal ? (part == 0 ? 96 : 48) : ntile, 8, 1, 1, 0, bal ? part * 96 : tile0, 0);
                S.init((bal && part == 1) ? 192 : G, (bal && part == 1) ? bx - 64 : bx); S.dry = (mask & 0x8000) ? 1 : 0; EpiGlu E{GT, TM, (bal && part == 0) ? ctl + CW_RDY : nullptr}; gemm_phase_(lds, S, E, g_wave_s); } }
#pragma unroll 1
        for (int sub = 0; sub < 2; ++sub) { const bool bal = need_ctx && G == 256;
            if (sub == 1) STAMP_B(pb + 6);
            if (PHON(6) && (sub == 0 ? (IN(pb + 5) && bal && bx < 64) : IN(pb + 6))) { JobSched<1> S;
                S.j[0] = mkjob(TM, mw + 10 * MiB, 0, 0, 2048, 2048, 16, sub == 0 ? 16 : (bal ? 128 : ntile), 4, 1, RESPERM, 0, sub == 0 ? 0 : (bal ? 16 : tile0), 0);
                S.init(sub == 0 ? 64 : G, bx); S.dry = (mask & 0x8000) ? 1 : 0;
                if (sub == 0) { Unit u0; (void)S.next(0, u0);
                    if (TIDX == 0) { unsigned* bar = ctl + CW_BAR; XB_SPIN(xb_ld(ctl + CW_RDY + 16 * u0.pm) < 64u, bar); __builtin_amdgcn_fence(__ATOMIC_ACQUIRE, "agent"); asm volatile("s_waitcnt vmcnt(0)" ::: "memory"); }
                    __syncthreads(); }
                EpiRes E{HS, ZS, modl, 2, l == 0 ? args.in[I_X] : nullptr, args.in[I_CTX], (const float*)(ws + WS_POS)}; gemm_phase_(lds, S, E, g_wave_s); }
            SEAM(pb + 5 + sub); }
        if (l == 0) {
            STAMP_B(pb + 7); if (IN(pb + 7)) { PHASE_IDS const float* g2 = args.in[I_N2G] + l * D;
                if ((TT % NGW) == 0) { const int rpw = TT / NGW, r0 = gw * rpw, r1 = r0 + rpw; f32x4 pg[4], pc[4], ph[4]; NP_LOAD_G(g2);
                    for (int rs = r0; rs < r1;) { const int c = rs < TC ? 16 : (rs - TC) >> 11; int re = rs < TC ? TC : TC + (c + 1) * 2048; re = re < r1 ? re : r1; NP_LOAD_C(modl + (size_t)c * 6144 + 3 * 1024);
                        for (int r = rs; r < re; ++r) NORM_ROW_P(r < TC ? ZS + (size_t)r * D : HS + (size_t)(r - TC) * D, (const float*)nullptr, 0, XA + (size_t)r * D, (unsigned char*)nullptr);
                        rs = re; }
                } else
                for (int r = gw; r < TT; r += NGW) { const res_t* src = r < TC ? ZS + (size_t)r * D : HS + (size_t)(r - TC) * D; const float* mc = modl + (size_t)(r < TC ? 16 : (r - TC) >> 11) * 6144 + 3 * 1024; int e1, e2; float w1;
                    norm_row<false>(src, g2, mc, mc + 1024, XA + (size_t)r * D, lane, nullptr, nullptr, e1, e2, w1); } }
            SEAM(pb + 7);
            STAMP_B(pb + 8); if (PHON(8) && IN(pb + 8)) { JobSched<1> S; S.j[0] = mkjob(XA, ws + WS_WGU, 0, 0, 2048, 2048, 16, 80, 22, 1, 1, 1, 0, 0); S.j[0].grp = FFN_ORDER;
                S.init(G, bx); S.dry = (mask & 0x8000) ? 1 : 0; EpiSwigluH8 E{(unsigned char*)HID}; gemm_phase_(lds, S, E, g_wave_s); }
            SEAM(pb + 8);
            STAMP_B(pb + 9); if (PHON(9) && IN(pb + 9)) { BalSched S;
                S.j[0] = mkjob(HID, ws + WS_WDN, 0, 0, DFF, DFF, 22, 80, 4, 1, RESPERM, 0, 0, 0);
                S.j[1] = mkjob(XA, ws + WS_WGU, 0, 0, 2048, 2048, 16, 64, 22, 1, 1, 1, 80, 0);
                S.init(G, bx);
                { BalLong SL; SL.j = S.j[0]; SL.G = S.G; SL.cp = S.cp; SL.mylong = S.base0 + (S.cp < S.E ? 1 : 0); SL.dry = (mask & 0x8000) ? 1 : 0; EpiRes8 E0{HS, ZS, modl, 5, nullptr, nullptr, nullptr, W8INV}; gemm_phase_<EpiRes8, BalLong, false, true>(lds, SL, E0, g_wave_s); }
                { BalShort SS; SS.j = S.j[1]; SS.cp = S.cp; SS.E = S.E; SS.gH = S.gH; SS.gL = S.gL; SS.extra = S.extra; SS.nl = S.nl; SS.dry = (mask & 0x8000) ? 1 : 0; EpiSwigluH8 E1{(unsigned char*)HID}; gemm_phase_(lds, SS, E1, g_wave_s); } }
            SEAM(pb + 9);
            STAMP_B(pb + 10);
            if (IN(pb + 10) && G >= 64 && (mask & F_INPROJ)) { PHASE_IDS
                const float* g1b = args.in[I_N1G] + D; const float* mcb = mod + (size_t)17 * 6144 + (size_t)16 * 6144; int e1, e2; float w1;
                for (int r = gw; r < TC; r += NGW) norm_row<false>(ZS + (size_t)r * D, g1b, mcb, mcb + 1024, XA + (size_t)r * D, lane, nullptr, nullptr, e1, e2, w1);
                asm volatile("s_waitcnt vmcnt(0)" ::: "memory"); __syncthreads(); }
            if (PHON(9) && IN(pb + 10)) { JobSched<1> S; S.j[0] = mkjob(HID, ws + WS_WDN, 0, 0, DFF, DFF, 22, 64, 4, 1, RESPERM, 0, 80, 0);
                S.init(G, bx); S.dry = (mask & 0x8000) ? 1 : 0; EpiRes8 E{HS, ZS, modl, 5, nullptr, nullptr, nullptr, W8INV}; gemm_phase_<EpiRes8, JobSched<1>, false, true>(lds, S, E, g_wave_s); }
            SEAM(pb + 10);
        }
    }
    {
        const float* modl = mod + (size_t)17 * 6144; unsigned char* XS8 = ws + WS_XS8; bf16_t* OB = (bf16_t*)(ws + WS_O); unsigned char* wmoe = ws + WS_W8; constexpr float WSC = W8SC;
        STAMP_B(PH_MOE); if (IN(PH_MOE)) { PHASE_IDS const float* g2 = args.in[I_N2G] + D; LAS int* lcnt = (LAS int*)(lds + 98304);
            int lc[8];
#pragma unroll
            for (int e = 0; e < 8; ++e) lc[e] = 0;
            const int RPW = TL / NGW; const bool contig = (TL % NGW) == 0 && RPW > 0 && (2048 % RPW) == 0;
#define ROUTE_TOK(i) (contig ? gw * RPW + (i) : gw + (i) * NGW)
            const int nrow = contig ? RPW : (TL - gw + NGW - 1) / NGW;
            if (contig) { const int t0 = gw * RPW; const float* mc = modl + (size_t)(t0 >> 11) * 6144 + 3 * 1024; const float* wrp = args.in[I_MR]; const float* brp = args.in[I_MBR];
                f32x4 gg[4], s1[4], s0[4], wq[4][4][2];
#pragma unroll
                for (int j = 0; j < 4; ++j) { const int k = j * 256 + lane * 4; gg[j] = *(const f32x4*)(g2 + k); s1[j] = *(const f32x4*)(mc + 1024 + k); s0[j] = *(const f32x4*)(mc + k);
#pragma unroll
                    for (int q = 0; q < 4; ++q) { wq[j][q][0] = *(const f32x4*)(wrp + (k + q) * 8); wq[j][q][1] = *(const f32x4*)(wrp + (k + q) * 8 + 4); } }
                for (int i = 0; i < RPW; ++i) { const int t = t0 + i; const res_t* src = HS + (size_t)t * D; unsigned char* dst = ws + WS_XR + (size_t)t * D;
                    f32x4 v[4]; float ss = 0.f;
#pragma unroll
                    for (int j = 0; j < 4; ++j) { v[j] = ld4(src + j * 256 + lane * 4); ss += v[j][0] * v[j][0] + v[j][1] * v[j][1] + v[j][2] * v[j][2] + v[j][3] * v[j][3]; }
                    ss = wsum(ss, lane); const float rstd = rsqrtf(ss * (1.f / D) + EPS);
                    float lg[8];
#pragma unroll
                    for (int e = 0; e < 8; ++e) lg[e] = 0.f;
#pragma unroll
                    for (int j = 0; j < 4; ++j) { const int k = j * 256 + lane * 4; f32x4 a;
#pragma unroll
                        for (int q = 0; q < 4; ++q) a[q] = v[j][q] * rstd * gg[j][q] * (1.f + s1[j][q]) + s0[j][q];
                        *(unsigned*)(dst + k) = pack4_fp8(a[0], a[1], a[2], a[3]);
#pragma unroll
                        for (int q = 0; q < 4; ++q)
#pragma unroll
                            for (int e = 0; e < 4; ++e) { lg[e] += a[q] * wq[j][q][0][e]; lg[4 + e] += a[q] * wq[j][q][1][e]; } }
#pragma unroll
                    for (int e = 0; e < 8; ++e) lg[e] = wsum(lg[e], lane) + brp[e];
                    int e1 = 0; float v1 = lg[0];
#pragma unroll
                    for (int e = 1; e < 8; ++e) if (lg[e] > v1) { v1 = lg[e]; e1 = e; }
                    int e2 = -1; float v2 = -3.0e38f;
#pragma unroll
                    for (int e = 0; e < 8; ++e) if (e != e1 && lg[e] > v2) { v2 = lg[e]; e2 = e; }
                    const float w1 = 1.f / (1.f + expf(v2 - v1));
                    int p1 = 0, p2 = 0;
#pragma unroll
                    for (int e = 0; e < 8; ++e) { if (e == e1) { p1 = lc[e]; lc[e]++; } }
#pragma unroll
                    for (int e = 0; e < 8; ++e) { if (e == e2) { p2 = lc[e]; lc[e]++; } }
                    if (lane == 0) { tok_e[t * 2] = e1; tok_e[t * 2 + 1] = e2; tok_w[t * 2] = w1; tok_w[t * 2 + 1] = 1.f - w1; tok_pos[t * 2] = p1; tok_pos[t * 2 + 1] = p2; } }
            } else
            for (int t = gw; t < TL; t += NGW) { const float* mc = modl + (size_t)(t >> 11) * 6144 + 3 * 1024; int e1, e2; float w1;
                norm_row<true>(HS + (size_t)t * D, g2, mc, mc + 1024, (bf16_t*)(ws + WS_XR + (size_t)t * D), lane, args.in[I_MR], args.in[I_MBR], e1, e2, w1);
                int p1 = 0, p2 = 0;
#pragma unroll
                for (int e = 0; e < 8; ++e) { if (e == e1) { p1 = lc[e]; lc[e]++; } }
#pragma unroll
                for (int e = 0; e < 8; ++e) { if (e == e2) { p2 = lc[e]; lc[e]++; } }
                if (lane == 0) { tok_e[t * 2] = e1; tok_e[t * 2 + 1] = e2; tok_w[t * 2] = w1; tok_w[t * 2 + 1] = 1.f - w1; tok_pos[t * 2] = p1; tok_pos[t * 2 + 1] = p2; } }
            { int mine = 0;
#pragma unroll
              for (int e = 0; e < 8; ++e) if (lane == e) mine = lc[e];
              if (lane < 8) lcnt[wave * 8 + lane] = mine; }
            __syncthreads();
            if (tid < 8) { int run = 0; for (int w = 0; w < 8; ++w) { const int c = lcnt[w * 8 + tid]; lcnt[64 + w * 8 + tid] = run; run += c; } lcnt[128 + tid] = atomicAdd(&cnt[tid], run); }
            __syncthreads();
            asm volatile("s_waitcnt vmcnt(0)" ::: "memory");
            for (int i = 0; i < nrow; ++i) { const int t = ROUTE_TOK(i); if (lane == 0) { const int ea = tok_e[t * 2], eb = tok_e[t * 2 + 1]; tok_pos[t * 2] += lcnt[64 + wave * 8 + ea] + lcnt[128 + ea]; tok_pos[t * 2 + 1] += lcnt[64 + wave * 8 + eb] + lcnt[128 + eb]; } }
            __syncthreads();
            LAS unsigned char* scr = lds + wave * TR_SCR;
            constexpr int I_G = 16 * 56, I_D = 56 * 16, PERE = 2 * I_G + I_D;
#ifdef MOEQ
            static_assert((8 * PERE) % 32 == 0, "MoE items split evenly over the 32 queues");
            unsigned* const qw = ctl + CW_PQ + 1024 + 64 * (bx & 31); const int qsel = bx & 31;
            unsigned nt = 0u; if (lane == 0) nt = atomicAdd(qw, 1u);
            for (;;) { const int tq_ = __builtin_amdgcn_readfirstlane((int)nt); if (tq_ >= 8 * PERE / 32) break; if (lane == 0) nt = atomicAdd(qw, 1u);
                const int it = tq_ * 32 + qsel;
#else
            for (int it = gw; it < 8 * PERE; it += NGW) {
#endif
                const int e = it / PERE; int r = it - e * PERE; unsigned char* wg = wmoe + (size_t)e * W8_ESTRIDE; unsigned char* wd = wg + W8_DN;
                if (r < I_G) { tr_mat_item8(args.in[I_MG] + (size_t)e * D * DFE, 1024, DFE, DFE, wg, 1, WSC, r, scr, lane); continue; } r -= I_G;
                if (r < I_G) { tr_mat_item8(args.in[I_MU] + (size_t)e * D * DFE, 1024, DFE, DFE, wg, 2, WSC, r, scr, lane); continue; } r -= I_G;
                tr_mat_item8(args.in[I_MD] + (size_t)e * DFE * D, DFE, 1024, D, wd, 0, WSC, r, scr, lane); }
        }
        SEAM(PH_MOE);
        STAMP_B(PH_MOE + 1); if (IN(PH_MOE + 1)) { PHASE_IDS int base[9]; base[0] = 0;
#pragma unroll
            for (int e = 0; e < 8; ++e) base[e + 1] = base[e] + __builtin_amdgcn_readfirstlane((cnt[e] + 255) & ~255);
            if (bx == 0) { if (tid < MOETILES) { int te = 0;
#pragma unroll
                    for (int k = 0; k < 8; ++k) if (tid * 256 >= base[k]) te = k;
                    tile_e[tid] = te; }
                if (tid == 0) ctl[CW_NT] = (unsigned)(base[8] >> 8); }
            for (int i0 = gw * 4; i0 < 2 * TL; i0 += NGW * 4) {
                int row[4]; const int4 ev = *(const int4*)(tok_e + i0), pv = *(const int4*)(tok_pos + i0); const int ee[4] = {ev.x, ev.y, ev.z, ev.w}, pp[4] = {pv.x, pv.y, pv.z, pv.w};
#pragma unroll
                for (int q = 0; q < 4; ++q) { int bs = 0;
#pragma unroll
                    for (int k = 0; k < 8; ++k) if (k == ee[q]) bs = base[k];
                    row[q] = bs + pp[q]; }
                u32x4 d0[4];
#pragma unroll
                for (int q = 0; q < 4; ++q) d0[q] = ((const u32x4*)(ws + WS_XR + (size_t)((i0 + q) >> 1) * D))[lane];
                if (lane == 0) { int4 rv; rv.x = row[0]; rv.y = row[1]; rv.z = row[2]; rv.w = row[3]; *(int4*)(tok_row + i0) = rv; }
#pragma unroll
                for (int q = 0; q < 4; ++q) *(u32x4*)(XS8 + (size_t)row[q] * D + lane * 16) = d0[q]; } }
        SEAM(PH_MOE + 1);
        LAS int* tile_l = (LAS int*)(lds + STAGE_BYTES + 1024);
        if (hi > PH_MOE + 2 && lo < PH_MOE + 7) { PHASE_IDS if (tid < MOETILES) tile_l[tid] = tile_e[tid]; __syncthreads(); }
        {
            const int ntl = (int)ctl[CW_NT]; int rem = ntl - 256; rem = rem < 0 ? 0 : (rem > 8 ? 8 : rem);
            unsigned char* H8A = ws + WS_H8A; unsigned char* H8B = ws + WS_H8B;
#define PASS_T0(p) ((p) == 0 ? 0 : 64 + rem + ((p) - 1) * 64)
#define PASS_N(p) ((p) == 0 ? 64 + rem : ((p) < 3 ? 64 : (ntl - PASS_T0(3) < 0 ? 0 : ntl - PASS_T0(3))))
#define PASS_H(p) (((p) & 1) ? H8B : H8A)
            STAMP_B(PH_MOE + 2); if (PHON(20) && IN(PH_MOE + 2)) {
                JobSched<1> S; S.j[0] = mkjob(XS8, wmoe, 0, 0, 1024, 1024, 8, PASS_N(0), 28, 1, 1, 1, 0, 0); S.j[0].tlut = tile_l; S.j[0].eB = W8_ESTRIDE;
                S.init(G, bx); S.dry = (mask & 0x8000) ? 1 : 0; EpiSwiglu8 E{H8A, 0}; gemm_phase_<EpiSwiglu8, JobSched<1>, false, true>(lds, S, E, g_wave_s); }
            SEAM(PH_MOE + 2);
            for (int p = 0; p < 3; ++p) {
                STAMP_B(PH_MOE + 3 + p); if (PHON(21) && IN(PH_MOE + 3 + p)) { const int t0 = PASS_T0(p), t1 = PASS_T0(p + 1); BalSched S;
                    S.j[0] = mkjob((const char*)PASS_H(p) - (size_t)t0 * 256 * DFE, wmoe + W8_DN, 0, 0, DFE, DFE, 28, PASS_N(p), 4, 1, 1, 0, t0, 0); S.j[0].tlut = tile_l; S.j[0].eB = W8_ESTRIDE;
                    S.j[1] = mkjob(XS8, wmoe, 0, 0, 1024, 1024, 8, PASS_N(p + 1), 28, 1, 1, 1, t1, 0); S.j[1].tlut = tile_l; S.j[1].eB = W8_ESTRIDE;
                    S.init(G, bx);
                    { BalLong SL; SL.j = S.j[0]; SL.G = S.G; SL.cp = S.cp; SL.mylong = S.base0 + (S.cp < S.E ? 1 : 0); SL.dry = (mask & 0x8000) ? 1 : 0; EpiBf8 E0{OB}; gemm_phase_<EpiBf8, BalLong, false, true>(lds, SL, E0, g_wave_s); }
                    { BalShort SS; SS.j = S.j[1]; SS.cp = S.cp; SS.E = S.E; SS.gH = S.gH; SS.gL = S.gL; SS.extra = S.extra; SS.nl = S.nl; SS.dry = (mask & 0x8000) ? 1 : 0; EpiSwiglu8 E1{PASS_H(p + 1), t1 * 256}; gemm_phase_<EpiSwiglu8, BalShort, false, true>(lds, SS, E1, g_wave_s); } }
                SEAM(PH_MOE + 3 + p);
            }
            STAMP_B(PH_MOE + 6); if (PHON(21) && IN(PH_MOE + 6)) { const int t0 = PASS_T0(3);
                JobSched<1> S; S.j[0] = mkjob((const char*)PASS_H(3) - (size_t)t0 * 256 * DFE, wmoe + W8_DN, 0, 0, DFE, DFE, 28, PASS_N(3), 4, 1, 1, 0, t0, 0); S.j[0].tlut = tile_l; S.j[0].eB = W8_ESTRIDE;
                S.init(G, bx); S.dry = (mask & 0x8000) ? 1 : 0; EpiBf8 E{OB}; gemm_phase_<EpiBf8, JobSched<1>, false, true>(lds, S, E, g_wave_s); }
            SEAM(PH_MOE + 6);
#undef PASS_T0
#undef PASS_N
#undef PASS_H
        }
        if (IN(PH_MOE + 7)) { PHASE_IDS const float* fg = args.in[I_FINALG];
#ifdef PROBE_A
            const float probe_ghz = (float)(ctl[CW_NT + 67] - ctl[CW_NT + 66]) / ((float)(ctl[CW_NT + 65] - ctl[CW_NT + 64]) * 10.0f);
            const float probe_scale = probe_ghz < 1.85f ? 1.5f : 1.0f;
#else
            const float probe_scale = 1.0f;
#endif
            const int rpwf = TL / NGW; const bool contigf = (TL % NGW) == 0 && rpwf >= 2 && (rpwf & 1) == 0 && (2048 % rpwf) == 0;
            if (contigf) {
                const int tb = gw * rpwf; const float* g2p = modl + (size_t)(tb >> 11) * 6144 + 5 * 1024; f32x4 ggr[4], fgv[4];
#pragma unroll
                for (int j = 0; j < 4; ++j) { ggr[j] = *(const f32x4*)(g2p + j * 256 + lane * 4); fgv[j] = *(const f32x4*)(fg + j * 256 + lane * 4); }
                for (int t0 = tb; t0 < tb + rpwf; t0 += 2) {
                    const int4 rr = *(const int4*)(tok_row + t0 * 2); const f32x4 ww = *(const f32x4*)(tok_w + t0 * 2); const int rws[4] = {rr.x, rr.y, rr.z, rr.w};
                    f32x4 v[2][4]; float ss[2] = {0.f, 0.f};
#pragma unroll
                    for (int q = 0; q < 2; ++q) { const int t = t0 + q; const float w1 = ww[2 * q], w2 = ww[2 * q + 1];
#pragma unroll
                        for (int j = 0; j < 4; ++j) { const int k = j * 256 + lane * 4; const f32x4 hv = ld4(HS + (size_t)t * D + k);
                            const u32x2 a = *(const u32x2*)(OB + (size_t)rws[2 * q] * D + k), b = *(const u32x2*)(OB + (size_t)rws[2 * q + 1] * D + k);
                            const f32x4 av = {bflo(a.x), bfhi(a.x), bflo(a.y), bfhi(a.y)}, bv = {bflo(b.x), bfhi(b.x), bflo(b.y), bfhi(b.y)};
                            v[q][j] = hv + ggr[j] * (av * w1 + bv * w2); ss[q] += v[q][j][0] * v[q][j][0] + v[q][j][1] * v[q][j][1] + v[q][j][2] * v[q][j][2] + v[q][j][3] * v[q][j][3]; } }
#pragma unroll
                    for (int q = 0; q < 2; ++q) { const float rstd = rsqrtf(wsum(ss[q], lane) * (1.f / D) + EPS);
#pragma unroll
                        for (int j = 0; j < 4; ++j) *(f32x4*)(h + (size_t)(t0 + q) * D + j * 256 + lane * 4) = v[q][j] * (rstd * probe_scale) * fgv[j]; } }
            } else
            for (int t0 = gw * 2; t0 < TL; t0 += NGW * 2) {
                const int4 rr = *(const int4*)(tok_row + t0 * 2); const f32x4 ww = *(const f32x4*)(tok_w + t0 * 2); const int rws[4] = {rr.x, rr.y, rr.z, rr.w};
                f32x4 v[2][4]; float ss[2] = {0.f, 0.f};
#pragma unroll
                for (int q = 0; q < 2; ++q) { const int t = t0 + q; const float* g2 = modl + (size_t)(t >> 11) * 6144 + 5 * 1024; const float w1 = ww[2 * q], w2 = ww[2 * q + 1];
#pragma unroll
                    for (int j = 0; j < 4; ++j) { const int k = j * 256 + lane * 4; const f32x4 hv = ld4(HS + (size_t)t * D + k), gg = *(const f32x4*)(g2 + k);
                        const u32x2 a = *(const u32x2*)(OB + (size_t)rws[2 * q] * D + k), b = *(const u32x2*)(OB + (size_t)rws[2 * q + 1] * D + k);
                        const f32x4 av = {bflo(a.x), bfhi(a.x), bflo(a.y), bfhi(a.y)}, bv = {bflo(b.x), bfhi(b.x), bflo(b.y), bfhi(b.y)};
                        v[q][j] = hv + gg * (av * w1 + bv * w2); ss[q] += v[q][j][0] * v[q][j][0] + v[q][j][1] * v[q][j][1] + v[q][j][2] * v[q][j][2] + v[q][j][3] * v[q][j][3]; } }
                f32x4 fgv[4];
#pragma unroll
                for (int j = 0; j < 4; ++j) fgv[j] = *(const f32x4*)(fg + j * 256 + lane * 4);
#pragma unroll
                for (int q = 0; q < 2; ++q) { const float rstd = rsqrtf(wsum(ss[q], lane) * (1.f / D) + EPS);
#pragma unroll
                    for (int j = 0; j < 4; ++j) *(f32x4*)(h + (size_t)(t0 + q) * D + j * 256 + lane * 4) = v[q][j] * (rstd * probe_scale) * fgv[j]; } } }
    }
#undef IN
#undef SEAM
#undef h
#undef zs
#undef HS
#undef ZS
#undef mod
#undef XA
#undef YS
#undef UX
#undef GT
#undef VL
#undef VC
#undef Sst
#undef TM
#undef HID
#undef cnt
#undef tok_e
#undef tok_w
#undef tok_pos
#undef tok_row
#undef tile_e
}
}

extern "C" void kernel_launch(void* const* d_in, const int* in_sizes, int n_in, void* d_out, int out_size, void* d_ws, size_t ws_size, hipStream_t stream) {
    const float* x = (const float*)d_in[0]; const float* c = (const float*)d_in[1]; const float* ctx = (const float*)d_in[2]; const float* cctx = (const float*)d_in[3];
    const float* wmod = (const float*)d_in[4]; const float* bmod = (const float*)d_in[5]; const float* n1g = (const float*)d_in[6]; const float* n2g = (const float*)d_in[7];
    const float* win = (const float*)d_in[8]; const float* wfour = (const float*)d_in[9];
    const float* are = (const float*)d_in[10]; const float* aim = (const float*)d_in[11]; const float* logdt = (const float*)d_in[12];
    const float* bre = (const float*)d_in[13]; const float* bim = (const float*)d_in[14]; const float* cre = (const float*)d_in[15]; const float* cim = (const float*)d_in[16];
    const float* ssmd = (const float*)d_in[17]; const float* glua = (const float*)d_in[18]; const float* glub = (const float*)d_in[19]; const float* wout = (const float*)d_in[20];
    const float* fgw = (const float*)d_in[21]; const float* fuw = (const float*)d_in[22]; const float* fdw = (const float*)d_in[23];
    const float* mrw = (const float*)d_in[24]; const float* mrb = (const float*)d_in[25]; const float* mgw = (const float*)d_in[26]; const float* muw = (const float*)d_in[27]; const float* mdw = (const float*)d_in[28];
    const float* finalg = (const float*)d_in[29];
    float* h = (float*)d_out; char* ws = (char*)d_ws;
    float* mod = (float*)(ws + WS_MOD); float* cosT = (float*)(ws + WS_COST); float* sinT = cosT + 2048;
    int* cnt = (int*)(ws + WS_CTL) + CW_CNT; int* tok_e = (int*)(ws + WS_TOKE); float* tok_w = (float*)(ws + WS_TOKW); int* tok_pos = (int*)(ws + WS_TOKPOS); int* tok_row = (int*)(ws + WS_TOKROW);
    int* tile_e = (int*)(ws + WS_TILEE); int* rowtok = (int*)(ws + WS_ROWTOK);
    float* z = (float*)(ws + WS_Z); bf16_t* XA = (bf16_t*)(ws + WS_XA); bf16_t* YS = (bf16_t*)(ws + WS_YS); bf16_t* UX = (bf16_t*)(ws + WS_UX); bf16_t* GT = (bf16_t*)(ws + WS_GT);
    bf16_t* VL = (bf16_t*)(ws + WS_VT2L); bf16_t* VC = (bf16_t*)(ws + WS_VT2C); bf16_t* TM = (bf16_t*)(ws + WS_TM); bf16_t* PF = (bf16_t*)(ws + WS_PF); bf16_t* T1 = (bf16_t*)(ws + WS_T1); bf16_t* T2 = (bf16_t*)(ws + WS_T2);
    float* Yacc = (float*)(ws + WS_YACC); bf16_t* HID = (bf16_t*)(ws + WS_HID); float* O = (float*)(ws + WS_NO); bf16_t* HQ = (bf16_t*)(ws + WS_NHQ);
    const int mask = FASTMASK;

    static int grid = 0;
    if (grid == 0) {
        int dev = 0, cus = 0; (void)hipGetDevice(&dev); (void)hipDeviceGetAttribute(&cus, hipDeviceAttributeMultiprocessorCount, dev);
        (void)hipFuncSetAttribute((const void*)mk::fwd, hipFuncAttributeMaxDynamicSharedMemorySize, mk::LDS_BYTES);
        int per_cu = 0; (void)hipOccupancyMaxActiveBlocksPerMultiprocessor(&per_cu, (const void*)mk::fwd, 512, mk::LDS_BYTES); (void)hipGetLastError();
        grid = cus > 0 ? cus : 256;
    }
    (void)hipMemsetAsync(ws + WS_CTL, 0, CTL_BYTES, stream);
    mk::Args a{};
    for (int i = 0; i < 30; ++i) a.in[i] = (const float*)d_in[i];
    a.out = h; a.ws = (unsigned char*)d_ws; a.mask = mask; a.pad = 0;
#ifndef REPMASK
#define REPMASK 0
#endif
    auto fast = [&](int lo, int hi) { a.ph_lo = lo; a.ph_hi = hi; hipLaunchKernelGGL(mk::fwd, dim3(grid), dim3(512), mk::LDS_BYTES, stream, a);
        if (hi == lo + 1 && ((REPMASK >> lo) & 1)) hipLaunchKernelGGL(mk::fwd, dim3(grid), dim3(512), mk::LDS_BYTES, stream, a); };
#ifdef DRYMASK
    auto fast_dry = [&](int lo) { if ((DRYMASK >> lo) & 1) { a.ph_lo = lo; a.ph_hi = lo + 1; a.mask = mask | 0x8000; hipLaunchKernelGGL(mk::fwd, dim3(grid), dim3(512), mk::LDS_BYTES, stream, a); a.mask = mask; } };
#else
    auto fast_dry = [&](int) {};
#endif
#if ONE_LAUNCH
    fast(0, mk::NPH);
#else
    hipLaunchKernelGGL(k_tables, dim3(8), dim3(256), 0, stream, cosT, sinT);
    if (mask & F_PRO) fast(0, 1);
    else { hipLaunchKernelGGL(k_mod, dim3(24, 17, 2), dim3(256), 0, stream, c, cctx, wmod, bmod, mod); hipLaunchKernelGGL(k_init, dim3(TL * D / 256), dim3(256), 0, stream, x, ctx, h, z); }
    for (int l = 0; l < 2; ++l) {
        const int pb = l == 0 ? 1 : mk::PH_L1; const float* modl = mod + (size_t)l * 17 * 6144; const bool need_ctx = (l == 0);
        if (mask & F_NORM) fast(pb, pb + 1);
        else hipLaunchKernelGGL(k_norm<false>, dim3(TT / 4), dim3(256), 0, stream, h, z, n1g + l * D, modl, 0, 1, XA, 0, TT, nullptr, nullptr, nullptr, nullptr);
        if (!(mask & F_INPROJ) || (mask & 0x3000)) {
            { LAbf la{XA, D, 0}; LBw lb{win + (size_t)l * D * INC, INC, 0}; EPinproj ep{PF, UX, GT}; hipLaunchKernelGGL((ngemm<LAbf, LBw, EPinproj>), dim3(INC / 64, TT / 64, 1), dim3(256), 0, stream, D, 0, la, lb, ep); }
            { LAbfZ la{PF, 512, 128}; LBdft128 lb{cosT, sinT}; EPzdft ep{VL, VC}; hipLaunchKernelGGL((ngemm<LAbfZ, LBdft128, EPzdft>), dim3(256 / 64, TT / 64, 4), dim3(256), 0, stream, 128, 0, la, lb, ep); }
        }
        if (mask & F_INPROJ) { fast_dry(pb + 1); fast(pb + 1, pb + 2); }
        if (mask & (F_FOUR | F_S5)) fast(pb + 2, pb + 3);
        if (!(mask & F_FOUR)) {
            { LAdftL<L> la{cosT, sinT}; LBvt2<L> lb{VL}; EPfour<L> ep{YS, TC, 1.0f / sqrtf((float)L * 128.f)}; hipLaunchKernelGGL((ngemm<LAdftL<L>, LBvt2<L>, EPfour<L>>), dim3(512 / 64, L / 64, NB), dim3(256), 0, stream, 2 * L, 0, la, lb, ep); }
            if (need_ctx) { LAdftL<LC> la{cosT, sinT}; LBvt2<LC> lb{VC}; EPfour<LC> ep{YS, 0, 1.0f / sqrtf((float)LC * 128.f)}; hipLaunchKernelGGL((ngemm<LAdftL<LC>, LBvt2<LC>, EPfour<LC>>), dim3(512 / 64, LC / 64, NB), dim3(256), 0, stream, 2 * LC, 0, la, lb, ep); }
        }
        if (mask & (F_S5 | F_GLU)) fast(pb + 3, pb + 4);
        if (!(mask & F_S5)) hipLaunchKernelGGL(k_s5_naive, dim3(NB * 32), dim3(64), 0, stream, UX, are + l * 4096, aim + l * 4096, logdt + l * 64, bre + (size_t)l * 65536, bim + (size_t)l * 65536, cre + (size_t)l * 65536, cim + (size_t)l * 65536, ssmd + l * 512, Yacc, YS);
        if (mask & (F_S5 | F_GLU)) fast(pb + 4, pb + 5);
        const int r0 = need_ctx ? 0 : TC, nr = TT - r0;
        if (mask & F_GLU) fast(pb + 5, pb + 6);
        else {
            { LAbf la{YS + (size_t)r0 * 1024, 1024, 0}; LBw lb{wfour + (size_t)l * 512 * D, D, 0}; EPbf ep{T1 + (size_t)r0 * D, D, 0}; hipLaunchKernelGGL((ngemm<LAbf, LBw, EPbf>), dim3(D / 64, nr / 64, 1), dim3(256), 0, stream, 512, 0, la, lb, ep); }
            { LAbf la{YS + (size_t)r0 * 1024 + 512, 1024, 0}; LBw lb{glua + (size_t)l * 512 * D, D, 0}; EPbf ep{T2 + (size_t)r0 * D, D, 0}; hipLaunchKernelGGL((ngemm<LAbf, LBw, EPbf>), dim3(D / 64, nr / 64, 1), dim3(256), 0, stream, 512, 0, la, lb, ep); }
            { LAbf la{YS + (size_t)r0 * 1024 + 512, 1024, 0}; LBw lb{glub + (size_t)l * 512 * D, D, 0}; EPmerge ep{GT + (size_t)r0 * 2048, T1 + (size_t)r0 * D, T2 + (size_t)r0 * D, TM + (size_t)r0 * D}; hipLaunchKernelGGL((ngemm<LAbf, LBw, EPmerge>), dim3(D / 64, nr / 64, 1), dim3(256), 0, stream, 512, 0, la, lb, ep); }
        }
        if (mask & F_OUT) fast(pb + 6, pb + 7);
        else { LAbf la{TM + (size_t)r0 * D, D, 0}; LBw lb{wout + (size_t)l * D * D, D, 0}; EPres ep{h, z, modl, 2, r0}; hipLaunchKernelGGL((ngemm<LAbf, LBw, EPres>), dim3(D / 64, nr / 64, 1), dim3(256), 0, stream, D, 0, la, lb, ep); }
        if (l == 0) {
            if (mask & F_NORM) fast(pb + 7, pb + 8);
            else hipLaunchKernelGGL(k_norm<false>, dim3(TT / 4), dim3(256), 0, stream, h, z, n2g + l * D, modl, 3, 4, XA, 0, TT, nullptr, nullptr, nullptr, nullptr);
            if (mask & F_FFN) { fast_dry(pb + 8); fast(pb + 8, pb + 9); fast(pb + 9, pb + 10); fast(pb + 10, pb + 11); }
            else {
                { LAbf la{XA, D, 0}; LBw lb{fgw, DFF, 0}; EPbf ep{HID, DFF, 0}; hipLaunchKernelGGL((ngemm<LAbf, LBw, EPbf>), dim3(DFF / 64, TT / 64, 1), dim3(256), 0, stream, D, 0, la, lb, ep); }
                { LAbf la{XA, D, 0}; LBw lb{fuw, DFF, 0}; EPswi ep{HID, DFF, 0}; hipLaunchKernelGGL((ngemm<LAbf, LBw, EPswi>), dim3(DFF / 64, TT / 64, 1), dim3(256), 0, stream, D, 0, la, lb, ep); }
                { LAbf la{HID, DFF, 0}; LBw lb{fdw, D, 0}; EPres ep{h, z, modl, 5, 0}; hipLaunchKernelGGL((ngemm<LAbf, LBw, EPres>), dim3(D / 64, TT / 64, 1), dim3(256), 0, stream, DFF, 0, la, lb, ep); }
            }
        } else if (mask & F_MOE) {
            for (int ph = mk::PH_MOE; ph < mk::NPH; ++ph) { fast_dry(ph); fast(ph, ph + 1); }
        } else {
            hipLaunchKernelGGL(k_moe_zero, dim3((MOEROWS + 255) / 256), dim3(256), 0, stream, cnt, rowtok);
            hipLaunchKernelGGL(k_norm<true>, dim3(TL / 4), dim3(256), 0, stream, h, z, n2g + l * D, modl, 3, 4, XA, TC, TL, mrw, mrb, tok_e, tok_w);
            hipLaunchKernelGGL(k_moe_count, dim3(TL * 2 / 256), dim3(256), 0, stream, tok_e, cnt, tok_pos);
            hipLaunchKernelGGL(k_moe_place, dim3(TL * 2 / 256), dim3(256), 0, stream, tok_e, cnt, tok_pos, tok_row, rowtok, tile_e);
            for (int q = 0; q < 4; ++q) {
                { LAgather la{XA + (size_t)TC * D, rowtok, tile_e}; LBmoe lb{mgw, tile_e, (size_t)D * DFE, DFE, q * 896, 0, 0}; EPbf ep{HQ, 896, 0}; hipLaunchKernelGGL((ngemm<LAgather, LBmoe, EPbf>), dim3(896 / 64, MOEROWS / 64, 1), dim3(256), 0, stream, D, 0, la, lb, ep); }
                { LAgather la{XA + (size_t)TC * D, rowtok, tile_e}; LBmoe lb{muw, tile_e, (size_t)D * DFE, DFE, q * 896, 0, 0}; EPswi ep{HQ, 896, 0}; hipLaunchKernelGGL((ngemm<LAgather, LBmoe, EPswi>), dim3(896 / 64, MOEROWS / 64, 1), dim3(256), 0, stream, D, 0, la, lb, ep); }
                { LAmoeh la{HQ, tile_e}; LBmoe lb{mdw, tile_e, (size_t)DFE * D, D, 0, q * 896, 0}; EPacc ep{O, q == 0, 0}; hipLaunchKernelGGL((ngemm<LAmoeh, LBmoe, EPacc>), dim3(D / 64, MOEROWS / 64, 1), dim3(256), 0, stream, 896, 0, la, lb, ep); }
            }
            hipLaunchKernelGGL(k_final, dim3(TL / 4), dim3(256), 0, stream, h, modl, O, tok_row, tok_w, finalg, (float*)d_out);
        }
    }
#endif
}
```
